# Optimizing an MI355X kernel written in HIP

```python
import jax, jax.numpy as jnp
from jax import lax
import numpy as np

D_MODEL = 1024
BATCH = 8
SEQ = 4096
DEPTH = 4

BLOCK = 128
EPS = 1e-6
ROPE_BASE = 10000.0

MLA_HEADS = 8
MLA_NOPE = 64
MLA_ROPE = 32
MLA_V = 64
MLA_Q_RANK = 384
MLA_KV_RANK = 256
SB_HEADS = 8
SB_DIM = 64
RET_HEADS = 8
RET_DK = 64
RET_DV = 64

BRANCH_WIDTH = 512
N_BRANCH = 3
D_FF = 4 * D_MODEL

IN_SIZES = (MLA_Q_RANK, MLA_KV_RANK, MLA_ROPE,
            SB_HEADS * SB_DIM, SB_HEADS * SB_DIM, SB_HEADS * SB_DIM,
            RET_HEADS * RET_DK, RET_HEADS * RET_DK, RET_HEADS * RET_DV, RET_HEADS * RET_DV,
            N_BRANCH * D_MODEL)
D_IN = sum(IN_SIZES)

kernel_name = "hybrid_mla_stickbreak_retention_gated"


def rmsnorm(x, g):
    xf = x.astype(jnp.float32)
    y = xf * lax.rsqrt(jnp.mean(xf * xf, axis=-1, keepdims=True) + EPS)
    return (y * g.astype(jnp.float32)).astype(x.dtype)


def head_group_norm(y, g):
    yf = y.astype(jnp.float32)
    mu = jnp.mean(yf, axis=-1, keepdims=True)
    var = jnp.mean(jnp.square(yf - mu), axis=-1, keepdims=True)
    yn = ((yf - mu) * lax.rsqrt(var + EPS)).reshape(y.shape[0], y.shape[1], -1)
    return (yn * g.astype(jnp.float32)).astype(y.dtype)


def rope_tables(positions, dim):
    inv_freq = ROPE_BASE ** (-jnp.arange(0, dim, 2, dtype=jnp.float32) / dim)
    ang = positions.astype(jnp.float32)[..., None] * inv_freq
    return jnp.cos(ang)[:, :, None, :], jnp.sin(ang)[:, :, None, :]


def apply_rope(x, cos, sin):
    half = x.shape[-1] // 2
    xf = x.astype(jnp.float32)
    x1, x2 = xf[..., :half], xf[..., half:]
    return jnp.concatenate([x1 * cos - x2 * sin, x2 * cos + x1 * sin], axis=-1).astype(x.dtype)


def causal_softmax_attention(q, k, v, scale):
    S = q.shape[1]
    outs = []
    for start in range(0, S, BLOCK):
        end = start + BLOCK
        s = jnp.einsum('bqhd,bkhd->bhqk', q[:, start:end], k[:, :end]).astype(jnp.float32) * scale
        t_idx = start + jnp.arange(BLOCK)[:, None]
        s_idx = jnp.arange(end)[None, :]
        s = jnp.where(s_idx <= t_idx, s, -jnp.inf)
        p = jax.nn.softmax(s, axis=-1)
        outs.append(jnp.einsum('bhqk,bkhd->bqhd', p.astype(v.dtype), v[:, :end]))
    return jnp.concatenate(outs, axis=1)


def stick_breaking_attention(q, k, v):
    S = q.shape[1]
    scale = SB_DIM ** -0.5
    outs = []
    for start in range(0, S, BLOCK):
        end = start + BLOCK
        z = jnp.einsum('bqhd,bkhd->bhqk', q[:, start:end], k[:, :end]).astype(jnp.float32) * scale
        t_idx = start + jnp.arange(BLOCK)[:, None]
        s_idx = jnp.arange(end)[None, :]
        before = s_idx < t_idx
        log_not = jnp.where(before, jax.nn.log_sigmoid(-z), 0.0)
        between = lax.cumsum(log_not, axis=3, reverse=True) - log_not
        a = jnp.where(before, jnp.exp(jax.nn.log_sigmoid(z) + between), 0.0)
        outs.append(jnp.einsum('bhqk,bkhd->bqhd', a.astype(v.dtype), v[:, :end]))
    return jnp.concatenate(outs, axis=1)


def retention(q, k, v, log_gamma):
    B, S, H, dk = q.shape
    dv = v.shape[-1]
    C = BLOCK
    N = S // C
    qc = q.astype(jnp.float32).reshape(B, N, C, H, dk)
    kc = (k.astype(jnp.float32) * dk ** -0.5).reshape(B, N, C, H, dk)
    vc = v.astype(jnp.float32).reshape(B, N, C, H, dv)
    idx = jnp.arange(C, dtype=jnp.float32)
    diff = idx[:, None] - idx[None, :]
    intra_decay = jnp.where(diff[None] >= 0,
                            jnp.exp(jnp.maximum(diff, 0.0)[None] * log_gamma[:, None, None]), 0.0)
    scores = jnp.einsum('bnchd,bnmhd->bnhcm', qc, kc) * intra_decay
    y_intra = jnp.einsum('bnhcm,bnmhe->bnche', scores, vc)
    zeta = jnp.exp((C - 1 - idx)[:, None] * log_gamma[None, :])
    kv = jnp.einsum('bnchd,bnche->nbhde', kc * zeta[None, None, :, :, None], vc)
    chunk_decay = jnp.exp(C * log_gamma)[None, :, None, None]

    def step(state, kv_n):
        return state * chunk_decay + kv_n, state

    _, prev = lax.scan(step, jnp.zeros((B, H, dk, dv), jnp.float32), kv)
    xi = jnp.exp((idx + 1.0)[:, None] * log_gamma[None, :])
    y_cross = jnp.einsum('bnchd,nbhde->bnche', qc, prev) * xi[None, None, :, :, None]
    return (y_intra + y_cross).reshape(B, S, H, dv).astype(v.dtype)


def setup_inputs(seed: int = 0) -> dict:
    key = jax.random.key(seed)
    ks = jax.random.split(key, 16)
    f32 = jnp.float32

    def dense(k, shape, fan_in):
        return jax.random.normal(k, shape, f32) * fan_in ** -0.5

    def gain(k, shape):
        return 1.0 + 0.02 * jax.random.normal(k, shape, f32)

    x = jax.random.normal(ks[0], (BATCH, SEQ, D_MODEL), f32)
    offset = jax.random.randint(ks[1], (BATCH, 1), 0, 1024, dtype=jnp.int32)
    positions = offset + jnp.arange(SEQ, dtype=jnp.int32)[None, :]
    return {
        "x": x,
        "positions": positions,
        "norm_mix_g": gain(ks[2], (DEPTH, D_MODEL)),
        "w_in": dense(ks[3], (DEPTH, D_MODEL, D_IN), D_MODEL),
        "mla_q_norm_g": gain(ks[4], (DEPTH, MLA_Q_RANK)),
        "mla_w_uq": dense(ks[5], (DEPTH, MLA_Q_RANK, MLA_HEADS * (MLA_NOPE + MLA_ROPE)), MLA_Q_RANK),
        "mla_kv_norm_g": gain(ks[6], (DEPTH, MLA_KV_RANK)),
        "mla_w_ukv": dense(ks[7], (DEPTH, MLA_KV_RANK, MLA_HEADS * (MLA_NOPE + MLA_V)), MLA_KV_RANK),
        "ret_norm_g": gain(ks[8], (DEPTH, RET_HEADS * RET_DV)),
        "w_branch": dense(ks[9], (DEPTH, N_BRANCH, BRANCH_WIDTH, D_MODEL), BRANCH_WIDTH),
        "w_out": dense(ks[10], (DEPTH, D_MODEL, D_MODEL), D_MODEL),
        "norm_mlp_g": gain(ks[11], (DEPTH, D_MODEL)),
        "w_up": dense(ks[12], (DEPTH, D_MODEL, D_FF), D_MODEL),
        "w_down": dense(ks[13], (DEPTH, D_FF, D_MODEL), D_FF),
        "final_norm_g": gain(ks[14], (D_MODEL,)),
    }


def reference(x, positions, norm_mix_g, w_in, mla_q_norm_g, mla_w_uq, mla_kv_norm_g, mla_w_ukv,
              ret_norm_g, w_branch, w_out, norm_mlp_g, w_up, w_down, final_norm_g):
    B, S, _ = x.shape
    cos_m, sin_m = rope_tables(positions, MLA_ROPE)
    cos_r, sin_r = rope_tables(positions, RET_DK)
    log_gamma = jnp.log1p(-jnp.exp2(-5.0 - jnp.arange(RET_HEADS, dtype=jnp.float32)))
    splits = [int(v) for v in np.cumsum(IN_SIZES)[:-1]]

    for l in range(DEPTH):
        h = rmsnorm(x, norm_mix_g[l])
        proj = h @ w_in[l]
        (c_q, c_kv, k_pe, sb_q, sb_k, sb_v, r_q, r_k, r_v, r_g, gate_logits) = jnp.split(proj, splits, axis=-1)

        q = (rmsnorm(c_q, mla_q_norm_g[l]) @ mla_w_uq[l]).reshape(B, S, MLA_HEADS, MLA_NOPE + MLA_ROPE)
        kv = (rmsnorm(c_kv, mla_kv_norm_g[l]) @ mla_w_ukv[l]).reshape(B, S, MLA_HEADS, MLA_NOPE + MLA_V)
        k_rot = jnp.broadcast_to(apply_rope(k_pe[:, :, None, :], cos_m, sin_m), (B, S, MLA_HEADS, MLA_ROPE))
        q_a = jnp.concatenate([q[..., :MLA_NOPE], apply_rope(q[..., MLA_NOPE:], cos_m, sin_m)], axis=-1)
        k_a = jnp.concatenate([kv[..., :MLA_NOPE], k_rot], axis=-1)
        y_a = causal_softmax_attention(q_a, k_a, kv[..., MLA_NOPE:], (MLA_NOPE + MLA_ROPE) ** -0.5).reshape(B, S, -1)

        y_b = stick_breaking_attention(sb_q.reshape(B, S, SB_HEADS, SB_DIM),
                                       sb_k.reshape(B, S, SB_HEADS, SB_DIM),
                                       sb_v.reshape(B, S, SB_HEADS, SB_DIM)).reshape(B, S, -1)

        y_c = retention(apply_rope(r_q.reshape(B, S, RET_HEADS, RET_DK), cos_r, sin_r),
                        apply_rope(r_k.reshape(B, S, RET_HEADS, RET_DK), cos_r, sin_r),
                        r_v.reshape(B, S, RET_HEADS, RET_DV), log_gamma)
        y_c = jax.nn.silu(r_g) * head_group_norm(y_c, ret_norm_g[l])

        branches = jnp.stack([y_a, y_b, y_c], axis=2)
        up = jnp.einsum('bsnw,nwd->bsnd', branches, w_branch[l])
        gates = jax.nn.sigmoid(gate_logits.reshape(B, S, N_BRANCH, D_MODEL))
        x = x + jnp.einsum('bsnd,bsnd->bsd', gates, up) @ w_out[l]

        h = rmsnorm(x, norm_mlp_g[l])
        x = x + jnp.square(jax.nn.relu(h @ w_up[l])) @ w_down[l]

    return rmsnorm(x, final_norm_g)
```

```cpp
#define MK_ONE_LAUNCH 1
#include <hip/hip_runtime.h>
#include <cstdio>
#include <cstdint>
#include <cmath>

namespace pg8 {
#define PG8_LAS __attribute__((address_space(3)))
typedef unsigned short bf16_t;
typedef short bf16x8 __attribute__((ext_vector_type(8)));
typedef float f32x4 __attribute__((ext_vector_type(4)));
typedef unsigned u32x4 __attribute__((ext_vector_type(4)));
typedef unsigned u32x2 __attribute__((ext_vector_type(2)));
constexpr int BM = 256, BK = 64, HALF = 128, HTB = HALF * BK * 2  , STAGE_BYTES = 8 * HTB, NXCD = 8, WGM = 8;

__host__ __device__ __forceinline__ int lds_byte(int r, int c) { const int st = (r >> 4) * 2 + (c >> 5), rr = r & 15, cc = c & 31, ob = rr * 64 + cc * 2; return st * 1024 + (ob ^ (((ob >> 9) & 1) << 5)); }
__host__ __device__ __forceinline__ void stage_rc(int b, int& R, int& C) { const int st = b / 1024, sb = b % 1024, swz = sb ^ (((sb >> 9) & 1) << 5); R = (st >> 1) * 16 + swz / 64; C = (st & 1) * 32 + (swz % 64) / 2; }
__host__ __device__ __forceinline__ int perm32(int rho) { const int n = rho >> 4, i = rho & 15; return 8 * (i >> 2) + 4 * n + (i & 3); }

struct Unit { int pm, pn, ks; };
struct Gemm { const bf16_t* A; const bf16_t* Bt; int lda, ldb, K; };

struct StaticOrder {
    int nM, nN, nwg, G, c;
    __host__ __device__ void init(int M, int N, int G_, int c_) { nM = M / BM; nN = N / BM; nwg = nM * nN; G = G_; c = c_; }
    __host__ __device__ bool tile(int i, Unit& u) const {
        const long L = (long)i * G + c; if (L >= nwg) return false;
        int wgid = (int)L; { const int q = nwg / NXCD, r = nwg % NXCD, xcd = wgid % NXCD, off = wgid / NXCD; wgid = (xcd < r ? xcd * (q + 1) : r * (q + 1) + (xcd - r) * q) + off; }
        const int nig = WGM * nN, gid = wgid / nig, fm = gid * WGM, gsz = (nM - fm) < WGM ? (nM - fm) : WGM;
        u.pm = fm + ((wgid % nig) % gsz); u.pn = (wgid % nig) / gsz; u.ks = 0; return true;
    }
    __host__ __device__ bool next(int i, Unit& u) const { return tile(i, u); }
    __device__ __forceinline__ void a_ready(const Unit&) const {}
    __device__ __forceinline__ void done(const Unit&) const {}
};
template <int NSEG> struct SegOrder {
    StaticOrder b;
    __host__ __device__ bool next(int i, Unit& u) const { if (!b.tile(i / NSEG, u)) return false; u.ks = i % NSEG; return true; }
    __device__ __forceinline__ void a_ready(const Unit&) const {}
    __device__ __forceinline__ void done(const Unit&) const {}
};

__device__ __forceinline__ unsigned cvt_pk_bf16(float lo, float hi) { unsigned r; asm volatile("v_cvt_pk_bf16_f32 %0, %1, %2" : "=v"(r) : "v"(lo), "v"(hi)); return r; }

template <class Epi, class Sched, bool ALIGN_EPI>
__device__ __forceinline__ void gemm_phase(PG8_LAS unsigned char* lds, const Gemm g, const Sched& S, const Epi& E) {
    int tid_ = threadIdx.x; asm volatile("" : "+v"(tid_));
    const int tid = tid_, wid = __builtin_amdgcn_readfirstlane(tid >> 6), lane = tid & 63, wr = wid >> 2, wc = wid & 3, fr = lane & 15, fq = lane >> 4;
    const int K = g.K, nt = K / BK;
    unsigned voffA[2], voffB[2];
#pragma unroll
    for (int i = 0; i < 2; ++i) { int R, C; stage_rc(tid * 16 + i * 8192, R, C); const int Rb = Epi::PERM ? ((R & ~31) + perm32(R & 31)) : R;
        voffA[i] = (unsigned)(R * g.lda + C) * 2u; voffB[i] = (unsigned)(Rb * g.ldb + C) * 2u; }
    const size_t kstep = (size_t)(BK * 2);
    const size_t hstepA = (size_t)HALF * g.lda * 2, hstepB = (size_t)HALF * g.ldb * 2;
    const size_t tstepA = 2 * hstepA, tstepB = 2 * hstepB;
    const size_t ksb = (size_t)K * 2;
    const unsigned ldsw = (unsigned)wid * 1024u;
    const int aoff = lds_byte(wr * 64 + fr, fq * 8), boff = lds_byte(wc * 32 + fr, fq * 8);
#define PG8_SA(b, h) (((b) * 2 + (h)) * HTB)
#define PG8_SB(b, h) ((4 + (b) * 2 + (h)) * HTB)
#define PG8_STAGE(bufoff, gbase, voff) do { _Pragma("unroll") for (int _i = 0; _i < 2; ++_i) \
        __builtin_amdgcn_global_load_lds((const unsigned*)((const char*)(gbase) + (voff)[_i]), (PG8_LAS unsigned*)(lds + (bufoff) + ldsw + _i * 8192), 16, 0, 0); } while (0)
#define PG8_LDA(dst, b, h) do { _Pragma("unroll") for (int m = 0; m < 4; ++m) _Pragma("unroll") for (int k = 0; k < 2; ++k) dst[m][k] = *(const PG8_LAS bf16x8*)(lds + PG8_SA(b, h) + aoff + m * 2048 + k * 1024); } while (0)
#define PG8_LDB(dst, b, h) do { _Pragma("unroll") for (int n = 0; n < 2; ++n) _Pragma("unroll") for (int k = 0; k < 2; ++k) dst[n][k] = *(const PG8_LAS bf16x8*)(lds + PG8_SB(b, h) + boff + n * 2048 + k * 1024); } while (0)
#define PG8_MMA(ai, bj, At, Bt) do { __builtin_amdgcn_s_setprio(1); _Pragma("unroll") for (int m = 0; m < 4; ++m) _Pragma("unroll") for (int n = 0; n < 2; ++n) _Pragma("unroll") for (int k = 0; k < 2; ++k) \
        acc[ai][bj][m][n] = __builtin_amdgcn_mfma_f32_16x16x32_bf16(Bt[n][k], At[m][k], acc[ai][bj][m][n], 0, 0, 0); __builtin_amdgcn_s_setprio(0); } while (0)
#define PG8_WAIT_V(n) asm volatile("s_waitcnt vmcnt(" #n ")" ::: "memory")
#define PG8_WAIT_L(n) asm volatile("s_waitcnt lgkmcnt(" #n ")" ::: "memory")
#define PG8_BAR __builtin_amdgcn_s_barrier()
#define PG8_SCHED __builtin_amdgcn_sched_barrier(0)
    Unit cur, nxt; int ui = 0;
    if (!S.next(0, cur)) return;
    f32x4 acc[2][2][4][2];
#pragma unroll
    for (int a = 0; a < 2; ++a)
#pragma unroll
        for (int b = 0; b < 2; ++b)
#pragma unroll
            for (int m = 0; m < 4; ++m)
#pragma unroll
                for (int n = 0; n < 2; ++n) acc[a][b][m][n] = (f32x4){0.f, 0.f, 0.f, 0.f};
    bf16x8 At[4][2], B0[2][2], B1[2][2];
    const char* cA = (const char*)g.A + (size_t)cur.pm * tstepA + (size_t)cur.ks * ksb; const char* cB = (const char*)g.Bt + (size_t)cur.pn * tstepB + (size_t)cur.ks * ksb;
    S.a_ready(cur);
    PG8_STAGE(PG8_SB(0, 0), cB, voffB); PG8_STAGE(PG8_SB(0, 1), cB + hstepB, voffB); PG8_STAGE(PG8_SA(0, 0), cA, voffA); PG8_STAGE(PG8_SA(0, 1), cA + hstepA, voffA);
    if (wr == 1) PG8_BAR;
    PG8_WAIT_V(2); PG8_BAR;
    PG8_STAGE(PG8_SB(1, 0), cB + kstep, voffB); PG8_STAGE(PG8_SA(1, 0), cA + kstep, voffA); PG8_STAGE(PG8_SB(1, 1), cB + hstepB + kstep, voffB);
    PG8_WAIT_V(6); PG8_BAR;
    for (;;) {
        const bool has_next = S.next(ui + 1, nxt);
        const char* nA = has_next ? (const char*)g.A + (size_t)nxt.pm * tstepA + (size_t)nxt.ks * ksb : cA; const char* nB = has_next ? (const char*)g.Bt + (size_t)nxt.pn * tstepB + (size_t)nxt.ks * ksb : cB;
#pragma nounroll
        for (int t = 0; t < nt; t += 2) {
            const bool last = (t == nt - 2);
            const char* a1 = cA + (size_t)(t + 1) * kstep;
            const char* a2 = last ? nA : cA + (size_t)(t + 2) * kstep; const char* b2 = last ? nB : cB + (size_t)(t + 2) * kstep;
            const char* a3 = a2 + kstep; const char* b3 = b2 + kstep;
            if (last && has_next) S.a_ready(nxt);
            PG8_LDB(B0, 0, 0); PG8_LDB(B1, 0, 1); PG8_SCHED; PG8_LDA(At, 0, 0); PG8_STAGE(PG8_SA(1, 1), a1 + hstepA, voffA);
            PG8_WAIT_V(8); PG8_WAIT_L(0); PG8_BAR; PG8_MMA(0, 0, At, B0); PG8_MMA(0, 1, At, B1); PG8_BAR; PG8_SCHED;
            PG8_LDA(At, 0, 1); PG8_STAGE(PG8_SB(0, 0), b2, voffB); PG8_STAGE(PG8_SB(0, 1), b2 + hstepB, voffB); PG8_STAGE(PG8_SA(0, 0), a2, voffA);
            PG8_WAIT_V(8); PG8_WAIT_L(0); PG8_BAR; PG8_MMA(1, 0, At, B0); PG8_MMA(1, 1, At, B1); PG8_BAR; PG8_SCHED;
            PG8_LDB(B0, 1, 0); PG8_LDB(B1, 1, 1); PG8_SCHED; PG8_LDA(At, 1, 0); PG8_STAGE(PG8_SA(0, 1), a2 + hstepA, voffA);
            PG8_WAIT_V(8); PG8_WAIT_L(0); PG8_BAR; PG8_MMA(0, 0, At, B0); PG8_MMA(0, 1, At, B1); PG8_BAR; PG8_SCHED;
            PG8_LDA(At, 1, 1); PG8_STAGE(PG8_SB(1, 0), b3, voffB); PG8_STAGE(PG8_SB(1, 1), b3 + hstepB, voffB); PG8_STAGE(PG8_SA(1, 0), a3, voffA);
            PG8_WAIT_V(8); PG8_WAIT_L(0); PG8_BAR; PG8_MMA(1, 0, At, B0); PG8_MMA(1, 1, At, B1); PG8_BAR; PG8_SCHED;
        }
        if constexpr (ALIGN_EPI) { if (wr == 0) PG8_BAR; }
        E(acc, cur, wr, wc, fr, fq); S.done(cur);
        if (!has_next) break;
        if (!E.keep(cur)) {
#pragma unroll
        for (int a = 0; a < 2; ++a)
#pragma unroll
            for (int b = 0; b < 2; ++b)
#pragma unroll
                for (int m = 0; m < 4; ++m)
#pragma unroll
                    for (int n = 0; n < 2; ++n) acc[a][b][m][n] = (f32x4){0.f, 0.f, 0.f, 0.f};
        }
        cur = nxt; cA = nA; cB = nB; ++ui;
        if constexpr (ALIGN_EPI) { if (wr == 1) PG8_BAR; }
    }
    PG8_WAIT_V(0);
    if constexpr (!ALIGN_EPI) { if (wr == 0) PG8_BAR; }
    PG8_BAR;
#undef PG8_SA
#undef PG8_SB
#undef PG8_STAGE
#undef PG8_LDA
#undef PG8_LDB
#undef PG8_MMA
#undef PG8_WAIT_V
#undef PG8_WAIT_L
#undef PG8_BAR
#undef PG8_SCHED
}
}

constexpr int NWAVES = 8, NTHR = NWAVES * 64;
constexpr int BATCH = 8, SEQ = 4096, DM = 1024, DEPTH = 4, DFF = 4096;
constexpr int MTOT = BATCH * SEQ;
constexpr int NHALF = 2, MH = MTOT / NHALF, BH = BATCH / NHALF;
constexpr int NHEAD = 8;
constexpr int D_IN = 7328, NIN = 7424;
constexpr int NC = 768;
constexpr int NQ = 768, NKV = 1024;
constexpr float EPS = 1e-6f;
constexpr float QSCALE = 0.10206207261596575f * 1.4426950408889634f;

constexpr size_t MiB = 1u << 20;
constexpr size_t WS_CTL = 0, CTL_ZERO_BYTES = 1 * MiB;
constexpr size_t WS_SSQ = 488 * MiB, SSQ_ZERO_BYTES = 5 * MiB;
constexpr size_t WS_SSQX = WS_SSQ;
constexpr size_t WS_SSQQ = WS_SSQX + 9 * (size_t)MTOT * 8;
constexpr size_t WS_SSQKV = WS_SSQQ + 8 * (size_t)MH * 8;
static_assert(WS_SSQKV + 8 * (size_t)MH * 8 <= WS_SSQ + SSQ_ZERO_BYTES, "accumulators inside the memset region");
constexpr size_t WS_COSR = 4 * MiB, WS_SINR = 8 * MiB, WS_COSM = 12 * MiB, WS_SINM = 14 * MiB;
constexpr size_t WS_XB = 16 * MiB;
constexpr size_t WS_W = 80 * MiB;
constexpr size_t W_IN = 0, W_UQ = W_IN + (size_t)NIN * DM * 2, W_UKV = W_UQ + (size_t)NQ * 384 * 2, W_B = W_UKV + (size_t)NKV * 256 * 2,
                 W_OUT = W_B + (size_t)DM * 1536 * 2, W_UP = W_OUT + (size_t)DM * DM * 2, W_DN = W_UP + (size_t)DFF * DM * 2, W_END = W_DN + (size_t)DM * DFF * 2;
static_assert(W_END <= 40 * MiB, "weights region");
constexpr size_t WS_C = 120 * MiB;
constexpr size_t WS_QM = 144 * MiB;
constexpr size_t WS_KVM = 168 * MiB;
constexpr size_t WS_Y = 200 * MiB;
constexpr size_t WS_SBK = 248 * MiB, WS_SBV = 264 * MiB;
constexpr size_t WS_RK = 280 * MiB, WS_RV = 296 * MiB, WS_RG = 312 * MiB;
constexpr size_t WS_GATES = 328 * MiB;
constexpr size_t WS_MG = 424 * MiB;
constexpr size_t WS_RST = 456 * MiB;
constexpr size_t WS_H = 248 * MiB;
constexpr size_t WS_END = 493 * MiB;
static_assert(WS_H + (size_t)MH * DFF * 2 <= WS_MG, "H overlay");
constexpr int CW_BAR = 4096;

constexpr int RING_OFF = 0, RING_BYTES = 131072;
constexpr int LDSCTL_OFF = RING_BYTES, MISC_OFF = LDSCTL_OFF + 320;
constexpr int LDS_BYTES = 147456;

#define GAS __attribute__((address_space(1)))
#define LAS __attribute__((address_space(3)))
typedef unsigned short bf16;
typedef unsigned v4u __attribute__((ext_vector_type(4)));
typedef float f32x4 __attribute__((ext_vector_type(4)));
typedef GAS unsigned gu32;
#define RLX_AGENT __ATOMIC_RELAXED, __HIP_MEMORY_SCOPE_AGENT
#define LDS_WAIT() asm volatile("s_waitcnt lgkmcnt(0)" ::: "memory")
#define VM_WAIT() asm volatile("s_waitcnt vmcnt(0)" ::: "memory")
__device__ __forceinline__ unsigned f2bf(float f) { unsigned u = __builtin_bit_cast(unsigned, f); return (u + 0x7fffu + ((u >> 16) & 1u)) >> 16; }
__device__ __forceinline__ unsigned pk2(float lo, float hi) { return f2bf(lo) | (f2bf(hi) << 16); }
__device__ __forceinline__ float bflo(unsigned w) { return __uint_as_float(w << 16); }
__device__ __forceinline__ float bfhi(unsigned w) { return __uint_as_float(w & 0xffff0000u); }

#define XB_TMO      128
#define XB_XCNT(j)  (256  + 64 * (j))
#define XB_XSUB(j)  (1280 + 64 * (j))
#define XB_XGEN(j)  (2304 + 64 * (j))
#define XB_TOP      3328
#define XB_TOPGEN   3392
#define XCD_BAR_WORDS 3456
#define XB_SPIN_CAP (1u << 18)

__device__ __forceinline__ unsigned xb_ld(unsigned* p)              { return __hip_atomic_load(p, __ATOMIC_RELAXED, __HIP_MEMORY_SCOPE_AGENT); }
__device__ __forceinline__ unsigned xb_add(unsigned* p, unsigned v) { return __hip_atomic_fetch_add(p, v, __ATOMIC_RELAXED, __HIP_MEMORY_SCOPE_AGENT); }
__device__ __forceinline__ unsigned xb_xcc_id() { return (unsigned)__builtin_amdgcn_s_getreg((3 << 11) | 20) & 0xFu; }
#define XB_SPIN(cond, bar) do { unsigned _sp = 0; while (cond) { __builtin_amdgcn_s_sleep(1); \
    if ((++_sp & 255u) == 0u) { if (xb_ld(&(bar)[XB_TMO])) break; if (_sp > XB_SPIN_CAP) { atomicAdd(&(bar)[XB_TMO], 1u); break; } } } } while (0)

struct XcdBarrier {
    unsigned* bar; unsigned x;
    volatile LAS unsigned* st;
};
__device__ __forceinline__ XcdBarrier xcd_barrier_post(unsigned* bar, volatile LAS unsigned* st) {
    XcdBarrier b; b.bar = bar; b.x = xb_xcc_id(); b.st = st;
    if (threadIdx.x == 0) (void)xb_add(&bar[XB_XCNT(b.x)], 1u);
    return b;
}
__device__ __forceinline__ void xcd_barrier_complete(unsigned* bar, unsigned x, unsigned& nloc, unsigned& nx) {
    const unsigned G = gridDim.x * gridDim.y * gridDim.z;
    unsigned sum, cnt, mine, sp = 0u;
    for (;;) {
        sum = 0u; cnt = 0u; mine = 0u;
#pragma unroll
        for (unsigned j = 0; j < 16; ++j) { const unsigned c = xb_ld(&bar[XB_XCNT(j)]); sum += c; cnt += (c > 0u) ? 1u : 0u; mine = (j == x) ? c : mine; }
        if (sum == G) break;
        __builtin_amdgcn_s_sleep(1);
        if ((++sp & 255u) == 0u) { if (xb_ld(&bar[XB_TMO])) break; if (sp > XB_SPIN_CAP) { atomicAdd(&bar[XB_TMO], 1u); break; } }
    }
    nloc = mine > 0u ? mine : 1u; nx = cnt > 0u ? cnt : 1u;
}
__device__ __forceinline__ void xcd_barrier(const XcdBarrier& b) {
    asm volatile("s_waitcnt vmcnt(0)" ::: "memory");
    __syncthreads();
    if (threadIdx.x == 0) {
        unsigned* bar = b.bar;
        __builtin_amdgcn_s_waitcnt(0);
        unsigned nloc = b.st[0], nx = b.st[1];
        if (nloc == 0u) { xcd_barrier_complete(bar, b.x, nloc, nx); b.st[0] = nloc; b.st[1] = nx; }
        const unsigned old = xb_add(&bar[XB_XSUB(b.x)], 1u);
        const unsigned gen = old / nloc;
        if (old + 1u == (gen + 1u) * nloc) {
            __builtin_amdgcn_fence(__ATOMIC_RELEASE, "agent");
            asm volatile("s_waitcnt vmcnt(0)" ::: "memory");
            const unsigned og = xb_add(&bar[XB_TOP], 1u);
            const unsigned tg = og / nx;
            if (og + 1u == (tg + 1u) * nx) xb_add(&bar[XB_TOPGEN], 1u);
            else XB_SPIN(xb_ld(&bar[XB_TOPGEN]) == tg, bar);
            __builtin_amdgcn_fence(__ATOMIC_ACQUIRE, "agent");
            xb_add(&bar[XB_XGEN(b.x)], 1u);
            asm volatile("s_waitcnt vmcnt(0)" ::: "memory");
        } else {
            XB_SPIN(xb_ld(&bar[XB_XGEN(b.x)]) == gen, bar);
            __builtin_amdgcn_fence(__ATOMIC_ACQUIRE, "agent");
            asm volatile("s_waitcnt vmcnt(0)" ::: "memory");
        }
    }
    __syncthreads();
}

struct Args { const void* in[15]; float* out; unsigned char* ws; int ph_lo, ph_hi; };
struct Frame {
    LAS unsigned char* lds;
    int tid, lane, wave, G;
    unsigned char* ws;
};

__device__ __forceinline__ float wave_sum(float v) {
#pragma unroll
    for (int o = 1; o < 64; o <<= 1) v += __shfl_xor(v, o);
    return v;
}
typedef unsigned long long u64;
__device__ __forceinline__ void ssq_add(u64* p, float s) { atomicAdd(p, (u64)(s * 16777216.f + 0.5f)); }
__device__ __forceinline__ float ssq_get(const u64* p) { return (float)(*p) * (1.f / 16777216.f); }
__device__ __forceinline__ int vzero() { int z; asm volatile("v_mov_b32 %0, 0" : "=v"(z)); return z; }

template <int MAP> __device__ __forceinline__ int src_col(int n) {
    if constexpr (MAP == 0) return n;
    else if constexpr (MAP == 1) {
        if (n < 512) return 672 + n;
        if (n < 1024) return 1184 + (n - 512);
        if (n < 1536) return 1696 + (n - 1024);
        if (n < 2048) { const int c = n - 1536; return 2208 + (c & ~63) + ((c & 63) >> 1) + 32 * (c & 1); }
        if (n < 2560) { const int c = n - 2048; return 2720 + (c & ~63) + ((c & 63) >> 1) + 32 * (c & 1); }
        if (n < 3072) return 3232 + (n - 2560);
        if (n < 3584) return 3744 + (n - 3072);
        if (n < 6656) return 4256 + (n - 3584);
        if (n < 7040) return n - 6656;
        if (n < 7296) return 384 + (n - 7040);
        if (n < 7328) { const int j = n - 7296; return 640 + (j >> 1) + 16 * (j & 1); }
        return -1;
    } else {
        const int h = n / 96, hc = n % 96; if (hc < 64) return n; const int j = hc - 64; return h * 96 + 64 + (j >> 1) + 16 * (j & 1);
    }
}
template <int MAP> __device__ __forceinline__ void transpose_item(const float* W, int Nsrc, int Ndst, const float* gain, bf16* WT, int pitch, int koff, LAS float* scr, int item, int lane) {
    const int nblk = Ndst / 32, kb = item / nblk, nb = item % nblk, k0 = 64 * kb, n0 = 32 * nb;
    const int sc = src_col<MAP>(n0 + (lane & 31));
#pragma unroll 8
    for (int i = 0; i < 32; ++i) { const int kk = 2 * i + (lane >> 5); float w = (sc >= 0) ? W[(size_t)(k0 + kk) * Nsrc + sc] : 0.f; if (gain) w *= gain[k0 + kk]; scr[kk * 33 + (lane & 31)] = w; }
    LDS_WAIT(); asm volatile("" ::: "memory");
    const int c = lane & 7;
#pragma unroll
    for (int j = 0; j < 4; ++j) { const int n = (lane >> 3) + 8 * j; const LAS float* s = scr + (8 * c) * 33 + n;
        v4u o; o.x = pk2(s[0 * 33], s[1 * 33]); o.y = pk2(s[2 * 33], s[3 * 33]); o.z = pk2(s[4 * 33], s[5 * 33]); o.w = pk2(s[6 * 33], s[7 * 33]);
        *(GAS v4u*)(WT + (size_t)(n0 + n) * pitch + koff + k0 + 8 * c) = o; }
    LDS_WAIT(); asm volatile("" ::: "memory");
}

using pg8::Unit; using pg8::bf16_t; using pg8::u32x4; using pg8::cvt_pk_bf16;
typedef float accT[2][2][4][2] __attribute__((unused));
__device__ __forceinline__ u32x4 pack8(const float (&v)[8]) { u32x4 w; w.x = cvt_pk_bf16(v[0], v[1]); w.y = cvt_pk_bf16(v[2], v[3]); w.z = cvt_pk_bf16(v[4], v[5]); w.w = cvt_pk_bf16(v[6], v[7]); return w; }
__device__ __forceinline__ float sigmoidf_(float x) { return __builtin_amdgcn_rcpf(1.f + __expf(-x)); }

struct EpiIn {
    static constexpr bool PERM = true;
    const u64* ssq; int grow0;
    bf16_t *Y, *SBK, *SBV, *RK, *RV, *RG, *GATES, *C;
    const float *cosR, *sinR, *cosM, *sinM;
    u64 *ssqq, *ssqkv;
    __device__ __forceinline__ bool keep(const Unit&) const { return false; }
    __device__ __forceinline__ void operator()(pg8::f32x4 (&acc)[2][2][4][2], const Unit& u, int wr, int wc, int fr_, int fq_) const {
        int fr = fr_, fq = fq_; asm volatile("" : "+v"(fr), "+v"(fq));
        const int pn = u.pn;
        int mode, pitch, col0; bf16_t* dst; float scale = 1.f;
        if (pn < 14) { const int seg = pn >> 1; col0 = (pn & 1) * 256; pitch = 512; mode = 0;
            if (seg == 0) { dst = Y; pitch = 1536; col0 += 512; scale = 0.125f; }
            else if (seg == 1) { dst = SBK; }
            else if (seg == 2) { dst = SBV; }
            else if (seg == 3) { dst = Y; pitch = 1536; col0 += 1024; mode = 1; scale = 0.125f; }
            else if (seg == 4) { dst = RK; mode = 1; }
            else if (seg == 5) { dst = RV; }
            else { dst = RG; mode = 2; }
        } else if (pn < 26) { dst = GATES; pitch = 3072; col0 = (pn - 14) * 256; mode = 3; }
        else { dst = C; pitch = NC; col0 = (pn - 26) * 256; mode = 4; }
        const int lrow0 = u.pm * 256 + wr * 64 + fr, cw = wc * 32 + 8 * fq;
#pragma unroll
        for (int ai = 0; ai < 2; ++ai)
#pragma unroll
            for (int m = 0; m < 4; ++m) { asm volatile("" ::: "memory");
                const int lrow = lrow0 + ai * 128 + m * 16, grow = grow0 + lrow;
                const float rs = rsqrtf(ssq_get(ssq + grow) * (1.f / 1024.f) + EPS);
#pragma unroll
                for (int bj = 0; bj < 2; ++bj) {
                    const int ct = bj * 128 + cw;
                    float v[8];
#pragma unroll
                    for (int j = 0; j < 4; ++j) { v[j] = acc[ai][bj][m][0][j] * rs; v[4 + j] = acc[ai][bj][m][1][j] * rs; }
                    bf16_t* p = dst + (size_t)lrow * pitch + col0 + ct;
                    if (mode == 0) {
#pragma unroll
                        for (int j = 0; j < 8; ++j) v[j] *= scale;
                    } else if (mode == 1) {
                        const int i0 = (ct & 63) >> 1;
                        const pg8::f32x4 c4 = *(const pg8::f32x4*)(cosR + (size_t)grow * 32 + i0), s4 = *(const pg8::f32x4*)(sinR + (size_t)grow * 32 + i0);
#pragma unroll
                        for (int j = 0; j < 4; ++j) { const float x1 = v[2 * j], x2 = v[2 * j + 1]; v[2 * j] = (x1 * c4[j] - x2 * s4[j]) * scale; v[2 * j + 1] = (x2 * c4[j] + x1 * s4[j]) * scale; }
                    } else if (mode == 2) {
#pragma unroll
                        for (int j = 0; j < 8; ++j) v[j] = v[j] * sigmoidf_(v[j]);
                    } else if (mode == 3) {
#pragma unroll
                        for (int j = 0; j < 8; ++j) v[j] = sigmoidf_(fminf(fmaxf(v[j], -80.f), 80.f));
                    } else {
                        const int cb = col0 + bj * 128 + wc * 32;
                        if (cb < 640) {
                            float s = 0.f;
#pragma unroll
                            for (int j = 0; j < 8; ++j) s += v[j] * v[j];
                            s += __shfl_xor(s, 16); s += __shfl_xor(s, 32);
                            if (fq == 0) ssq_add((cb < 384 ? ssqq : ssqkv) + lrow, s);
                        } else if (cb < 672) {
                            const int i0 = 4 * fq;
                            const pg8::f32x4 c4 = *(const pg8::f32x4*)(cosM + (size_t)grow * 16 + i0), s4 = *(const pg8::f32x4*)(sinM + (size_t)grow * 16 + i0);
#pragma unroll
                            for (int j = 0; j < 4; ++j) { const float x1 = v[2 * j], x2 = v[2 * j + 1]; v[2 * j] = x1 * c4[j] - x2 * s4[j]; v[2 * j + 1] = x2 * c4[j] + x1 * s4[j]; }
                        } else continue;
                    }
                    *(u32x4*)p = pack8(v);
                }
            }
    }
};

struct EpiUq {
    static constexpr bool PERM = true;
    const u64* ssqq; int grow0; bf16_t* QM; const float *cosM, *sinM;
    __device__ __forceinline__ bool keep(const Unit&) const { return false; }
    __device__ __forceinline__ void operator()(pg8::f32x4 (&acc)[2][2][4][2], const Unit& u, int wr, int wc, int fr_, int fq_) const {
        int fr = fr_, fq = fq_; asm volatile("" : "+v"(fr), "+v"(fq));
        const int lrow0 = u.pm * 256 + wr * 64 + fr, cw = wc * 32 + 8 * fq;
#pragma unroll
        for (int ai = 0; ai < 2; ++ai)
#pragma unroll
            for (int m = 0; m < 4; ++m) { asm volatile("" ::: "memory");
                const int lrow = lrow0 + ai * 128 + m * 16, grow = grow0 + lrow;
                const float rs = rsqrtf(ssq_get(ssqq + lrow) * (1.f / 384.f) + EPS) * QSCALE;
#pragma unroll
                for (int bj = 0; bj < 2; ++bj) {
                    const int c = u.pn * 256 + bj * 128 + cw, hc = c % 96;
                    float v[8];
#pragma unroll
                    for (int j = 0; j < 4; ++j) { v[j] = acc[ai][bj][m][0][j] * rs; v[4 + j] = acc[ai][bj][m][1][j] * rs; }
                    if (hc >= 64) {
                        const int i0 = (hc - 64) >> 1;
                        const pg8::f32x4 c4 = *(const pg8::f32x4*)(cosM + (size_t)grow * 16 + i0), s4 = *(const pg8::f32x4*)(sinM + (size_t)grow * 16 + i0);
#pragma unroll
                        for (int j = 0; j < 4; ++j) { const float x1 = v[2 * j], x2 = v[2 * j + 1]; v[2 * j] = x1 * c4[j] - x2 * s4[j]; v[2 * j + 1] = x2 * c4[j] + x1 * s4[j]; }
                    }
                    *(u32x4*)(QM + (size_t)lrow * NQ + c) = pack8(v);
                }
            }
    }
};
struct EpiUkv {
    static constexpr bool PERM = true;
    const u64* ssqkv; bf16_t* KVM;
    __device__ __forceinline__ bool keep(const Unit&) const { return false; }
    __device__ __forceinline__ void operator()(pg8::f32x4 (&acc)[2][2][4][2], const Unit& u, int wr, int wc, int fr_, int fq_) const {
        int fr = fr_, fq = fq_; asm volatile("" : "+v"(fr), "+v"(fq));
        const int lrow0 = u.pm * 256 + wr * 64 + fr, cw = wc * 32 + 8 * fq;
#pragma unroll
        for (int ai = 0; ai < 2; ++ai)
#pragma unroll
            for (int m = 0; m < 4; ++m) { asm volatile("" ::: "memory");
                const int lrow = lrow0 + ai * 128 + m * 16;
                const float rs = rsqrtf(ssq_get(ssqkv + lrow) * (1.f / 256.f) + EPS);
#pragma unroll
                for (int bj = 0; bj < 2; ++bj) {
                    float v[8];
#pragma unroll
                    for (int j = 0; j < 4; ++j) { v[j] = acc[ai][bj][m][0][j] * rs; v[4 + j] = acc[ai][bj][m][1][j] * rs; }
                    *(u32x4*)(KVM + (size_t)lrow * NKV + u.pn * 256 + bj * 128 + cw) = pack8(v);
                }
            }
    }
};
struct EpiMerge {
    static constexpr bool PERM = true;
    const bf16_t* G; bf16_t* MG;
    __device__ __forceinline__ bool keep(const Unit& u) const { return u.ks < 2; }
    __device__ __forceinline__ void operator()(pg8::f32x4 (&acc)[2][2][4][2], const Unit& u, int wr, int wc, int fr_, int fq_) const {
        int fr = fr_, fq = fq_; asm volatile("" : "+v"(fr), "+v"(fq));
        const int lrow0 = u.pm * 256 + wr * 64 + fr, cw = wc * 32 + 8 * fq, ks = u.ks;
#pragma unroll
        for (int ai = 0; ai < 2; ++ai)
#pragma unroll
            for (int m = 0; m < 4; ++m) { asm volatile("" ::: "memory");
                const int lrow = lrow0 + ai * 128 + m * 16;
#pragma unroll
                for (int bj = 0; bj < 2; ++bj) {
                    const int d = u.pn * 256 + bj * 128 + cw;
                    const bf16_t* gp = G + (size_t)lrow * 3072 + ks * 1024 + d;
                    const u32x4 ga = *(const u32x4*)gp;
                    float f[8];
#pragma unroll
                    for (int j = 0; j < 4; ++j) { f[2 * j] = bflo(ga[j]); f[2 * j + 1] = bfhi(ga[j]); }
                    if (ks < 2) {
                        const u32x4 gb = *(const u32x4*)(gp + 1024);
#pragma unroll
                        for (int j = 0; j < 4; ++j) { f[2 * j] *= __builtin_amdgcn_rcpf(bflo(gb[j])); f[2 * j + 1] *= __builtin_amdgcn_rcpf(bfhi(gb[j])); }
                    }
#pragma unroll
                    for (int j = 0; j < 4; ++j) { acc[ai][bj][m][0][j] *= f[j]; acc[ai][bj][m][1][j] *= f[4 + j]; }
                    if (ks == 2) {
                        float v[8];
#pragma unroll
                        for (int j = 0; j < 4; ++j) { v[j] = acc[ai][bj][m][0][j]; v[4 + j] = acc[ai][bj][m][1][j]; }
                        *(u32x4*)(MG + (size_t)lrow * DM + d) = pack8(v);
                    }
                }
            }
    }
};
struct EpiResid {
    static constexpr bool PERM = true;
    const float* xin; float* xout; bf16_t* XB; u64* ssq_next; int grow0;
    __device__ __forceinline__ bool keep(const Unit&) const { return false; }
    __device__ __forceinline__ void operator()(pg8::f32x4 (&acc)[2][2][4][2], const Unit& u, int wr, int wc, int fr_, int fq_) const {
        int fr = fr_, fq = fq_; asm volatile("" : "+v"(fr), "+v"(fq));
        const int lrow0 = u.pm * 256 + wr * 64 + fr, cw = wc * 32 + 8 * fq;
#pragma unroll
        for (int ai = 0; ai < 2; ++ai)
#pragma unroll
            for (int m = 0; m < 4; ++m) { asm volatile("" ::: "memory");
                const int grow = grow0 + lrow0 + ai * 128 + m * 16;
                float sq = 0.f;
#pragma unroll
                for (int bj = 0; bj < 2; ++bj) {
                    const size_t off = (size_t)grow * DM + u.pn * 256 + bj * 128 + cw;
                    const pg8::f32x4 a = *(const pg8::f32x4*)(xin + off) + acc[ai][bj][m][0], b = *(const pg8::f32x4*)(xin + off + 4) + acc[ai][bj][m][1];
                    *(pg8::f32x4*)(xout + off) = a; *(pg8::f32x4*)(xout + off + 4) = b;
                    float v[8] = {a[0], a[1], a[2], a[3], b[0], b[1], b[2], b[3]};
#pragma unroll
                    for (int j = 0; j < 8; ++j) sq += v[j] * v[j];
                    *(u32x4*)(XB + off) = pack8(v);
                }
                sq += __shfl_xor(sq, 16); sq += __shfl_xor(sq, 32);
                if (fq == 0) ssq_add(ssq_next + grow, sq);
            }
    }
};
struct EpiUp {
    static constexpr bool PERM = true;
    const u64* ssq; int grow0; bf16_t* H;
    __device__ __forceinline__ bool keep(const Unit&) const { return false; }
    __device__ __forceinline__ void operator()(pg8::f32x4 (&acc)[2][2][4][2], const Unit& u, int wr, int wc, int fr_, int fq_) const {
        int fr = fr_, fq = fq_; asm volatile("" : "+v"(fr), "+v"(fq));
        const int lrow0 = u.pm * 256 + wr * 64 + fr, cw = wc * 32 + 8 * fq;
#pragma unroll
        for (int ai = 0; ai < 2; ++ai)
#pragma unroll
            for (int m = 0; m < 4; ++m) { asm volatile("" ::: "memory");
                const int lrow = lrow0 + ai * 128 + m * 16;
                const float rs = rsqrtf(ssq_get(ssq + grow0 + lrow) * (1.f / 1024.f) + EPS);
#pragma unroll
                for (int bj = 0; bj < 2; ++bj) {
                    float v[8];
#pragma unroll
                    for (int j = 0; j < 4; ++j) { v[j] = acc[ai][bj][m][0][j] * rs; v[4 + j] = acc[ai][bj][m][1][j] * rs; }
#pragma unroll
                    for (int j = 0; j < 8; ++j) { const float r = fmaxf(v[j], 0.f); v[j] = r * r; }
                    *(u32x4*)(H + (size_t)lrow * DFF + u.pn * 256 + bj * 128 + cw) = pack8(v);
                }
            }
    }
};

__device__ __forceinline__ void prologue_phase(Frame& F, const float* x, const int* pos, float* cosR, float* sinR, float* cosM, float* sinM, bf16* XB, u64* ssq0) {
    const int gt = blockIdx.x * NTHR + F.tid, NT = F.G * NTHR;
    for (int idx = gt; idx < MTOT * 32; idx += NT) {
        const int row = idx >> 5, i = idx & 31;
        const double inv = exp2(-(double)i * (13.287712379549449 / 32.0));
        const double ang = (double)pos[row] * inv;
        double s, c; sincos(ang, &s, &c);
        cosR[idx] = (float)c; sinR[idx] = (float)s;
        if ((i & 1) == 0) { cosM[row * 16 + (i >> 1)] = (float)c; sinM[row * 16 + (i >> 1)] = (float)s; }
    }
    const int gw = blockIdx.x * NWAVES + F.wave, NGW = F.G * NWAVES;
    for (int m = gw; m < MTOT; m += NGW) {
        const GAS f32x4* xr = (const GAS f32x4*)(x + (size_t)m * DM) + F.lane;
        f32x4 v[4]; float s = 0.f;
#pragma unroll
        for (int j = 0; j < 4; ++j) { v[j] = xr[64 * j]; s += (v[j].x * v[j].x + v[j].y * v[j].y) + (v[j].z * v[j].z + v[j].w * v[j].w); }
        s = wave_sum(s);
        GAS unsigned long long* o8 = (GAS unsigned long long*)(XB + (size_t)m * DM) + F.lane;
#pragma unroll
        for (int j = 0; j < 4; ++j) o8[64 * j] = (unsigned long long)pk2(v[j].x, v[j].y) | ((unsigned long long)pk2(v[j].z, v[j].w) << 32);
        if (F.lane == 0) ssq0[m] = (u64)(s * 16777216.f + 0.5f);
    }
}
__device__ __forceinline__ void final_phase(Frame& F, float* xo, const u64* ssq, const float* g) {
    const int gw = blockIdx.x * NWAVES + F.wave, NGW = F.G * NWAVES;
    for (int m = gw; m < MTOT; m += NGW) {
        const float rs = rsqrtf((float)__hip_atomic_load(ssq + m, RLX_AGENT) * (1.f / 16777216.f) * (1.f / 1024.f) + EPS);
        GAS f32x4* xr = (GAS f32x4*)(xo + (size_t)m * DM) + F.lane;
#pragma unroll
        for (int j = 0; j < 4; ++j) { const f32x4 gv = *((const f32x4*)g + F.lane + 64 * j); f32x4 v = xr[64 * j]; v = v * rs * gv; xr[64 * j] = v; }
    }
}
__device__ __forceinline__ void convert_phase(Frame& F, const Args& a, int l) {
    LAS float* scr = (LAS float*)(F.lds + RING_OFF + F.wave * 16384);
    unsigned char* W = F.ws + WS_W;
    const float* g_mix = (const float*)a.in[2] + (size_t)l * DM;
    const float* w_in = (const float*)a.in[3] + (size_t)l * DM * D_IN;
    const float* g_q = (const float*)a.in[4] + (size_t)l * 384;
    const float* w_uq = (const float*)a.in[5] + (size_t)l * 384 * NQ;
    const float* g_kv = (const float*)a.in[6] + (size_t)l * 256;
    const float* w_ukv = (const float*)a.in[7] + (size_t)l * 256 * NKV;
    const float* w_br = (const float*)a.in[9] + (size_t)l * 3 * 512 * DM;
    const float* w_out = (const float*)a.in[10] + (size_t)l * DM * DM;
    const float* g_mlp = (const float*)a.in[11] + (size_t)l * DM;
    const float* w_up = (const float*)a.in[12] + (size_t)l * DM * DFF;
    const float* w_dn = (const float*)a.in[13] + (size_t)l * DFF * DM;
    constexpr int I_IN = (DM / 64) * (NIN / 32), I_UQ = (384 / 64) * (NQ / 32), I_UKV = (256 / 64) * (NKV / 32), I_B = (512 / 64) * (DM / 32), I_OUT = (DM / 64) * (DM / 32),
                  I_UP = (DM / 64) * (DFF / 32), I_DN = (DFF / 64) * (DM / 32);
    constexpr int NITEMS = I_IN + I_UQ + I_UKV + 3 * I_B + I_OUT + I_UP + I_DN;
    const int gw = blockIdx.x * NWAVES + F.wave, NGW = F.G * NWAVES;
    for (int it = gw; it < NITEMS; it += NGW) {
        int r = it;
        if (r < I_IN) { transpose_item<1>(w_in, D_IN, NIN, g_mix, (bf16*)(W + W_IN), DM, 0, scr, r, F.lane); continue; } r -= I_IN;
        if (r < I_UQ) { transpose_item<2>(w_uq, NQ, NQ, g_q, (bf16*)(W + W_UQ), 384, 0, scr, r, F.lane); continue; } r -= I_UQ;
        if (r < I_UKV) { transpose_item<0>(w_ukv, NKV, NKV, g_kv, (bf16*)(W + W_UKV), 256, 0, scr, r, F.lane); continue; } r -= I_UKV;
        if (r < 3 * I_B) { const int s = r / I_B; transpose_item<0>(w_br + (size_t)s * 512 * DM, DM, DM, nullptr, (bf16*)(W + W_B), 1536, s * 512, scr, r % I_B, F.lane); continue; } r -= 3 * I_B;
        if (r < I_OUT) { transpose_item<0>(w_out, DM, DM, nullptr, (bf16*)(W + W_OUT), DM, 0, scr, r, F.lane); continue; } r -= I_OUT;
        if (r < I_UP) { transpose_item<0>(w_up, DFF, DFF, g_mlp, (bf16*)(W + W_UP), DM, 0, scr, r, F.lane); continue; } r -= I_UP;
        transpose_item<0>(w_dn, DM, DM, nullptr, (bf16*)(W + W_DN), DFF, 0, scr, r, F.lane);
    }
}

__device__ __forceinline__ void ld8(const bf16* p, float* f) { const v4u w = *(const GAS v4u*)p; f[0] = bflo(w.x); f[1] = bfhi(w.x); f[2] = bflo(w.y); f[3] = bfhi(w.y); f[4] = bflo(w.z); f[5] = bfhi(w.z); f[6] = bflo(w.w); f[7] = bfhi(w.w); }
__device__ __forceinline__ void st8(bf16* p, const float* f) { v4u w; w.x = pk2(f[0], f[1]); w.y = pk2(f[2], f[3]); w.z = pk2(f[4], f[5]); w.w = pk2(f[6], f[7]); *(GAS v4u*)p = w; }
__device__ __forceinline__ void item_bht(int it, int& bh, int& t) { bh = it >> 12; const int r = it & 4095; t = (r & 511) * 8 + (r >> 9); }

__device__ __forceinline__ void naive_mla(Frame& F) {
    const bf16* QM = (const bf16*)(F.ws + WS_QM); const bf16* KVM = (const bf16*)(F.ws + WS_KVM); const bf16* C = (const bf16*)(F.ws + WS_C); bf16* Y = (bf16*)(F.ws + WS_Y);
    const int vz = vzero();
    for (int it = blockIdx.x * NTHR + F.tid; it < BH * NHEAD * SEQ; it += F.G * NTHR) {
        int bh, t; item_bht(it, bh, t); const int b = bh >> 3, h = bh & 7; const size_t lrow = (size_t)b * SEQ + t;
        float q[96];
#pragma unroll
        for (int j = 0; j < 12; ++j) ld8(QM + lrow * NQ + h * 96 + 8 * j, q + 8 * j);
        float m = -INFINITY, l = 0.f, acc[64];
#pragma unroll
        for (int e = 0; e < 64; ++e) acc[e] = 0.f;
        for (int s = 0; s <= t; ++s) {
            const size_t krow = (size_t)b * SEQ + s + vz;
            const bf16* kn = KVM + krow * NKV + h * 128; const bf16* kr = C + krow * NC + 640;
            float z = 0.f, k[8];
#pragma unroll
            for (int j = 0; j < 8; ++j) { ld8(kn + 8 * j, k);
#pragma unroll
                for (int i = 0; i < 8; ++i) z += q[8 * j + i] * k[i]; }
#pragma unroll
            for (int j = 0; j < 4; ++j) { ld8(kr + 8 * j, k);
#pragma unroll
                for (int i = 0; i < 8; ++i) z += q[64 + 8 * j + i] * k[i]; }
            if (z > m) { const float al = exp2f(m - z); l *= al;
#pragma unroll
                for (int e = 0; e < 64; ++e) acc[e] *= al;
                m = z; }
            const float p = exp2f(z - m); l += p;
#pragma unroll
            for (int j = 0; j < 8; ++j) { ld8(kn + 64 + 8 * j, k);
#pragma unroll
                for (int i = 0; i < 8; ++i) acc[8 * j + i] += p * k[i]; }
        }
        const float il = 1.f / l;
#pragma unroll
        for (int e = 0; e < 64; ++e) acc[e] *= il;
#pragma unroll
        for (int j = 0; j < 8; ++j) st8(Y + lrow * 1536 + h * 64 + 8 * j, acc + 8 * j);
    }
}
__device__ __forceinline__ void naive_sb(Frame& F) {
    bf16* Y = (bf16*)(F.ws + WS_Y); const bf16* SK = (const bf16*)(F.ws + WS_SBK); const bf16* SV = (const bf16*)(F.ws + WS_SBV);
    const int vz = vzero();
    for (int it = blockIdx.x * NTHR + F.tid; it < BH * NHEAD * SEQ; it += F.G * NTHR) {
        int bh, t; item_bht(it, bh, t); const int b = bh >> 3, h = bh & 7; const size_t lrow = (size_t)b * SEQ + t;
        float q[64];
#pragma unroll
        for (int j = 0; j < 8; ++j) ld8(Y + lrow * 1536 + 512 + h * 64 + 8 * j, q + 8 * j);
        float run = 0.f, acc[64];
#pragma unroll
        for (int e = 0; e < 64; ++e) acc[e] = 0.f;
        for (int s = t - 1; s >= 0; --s) {
            const size_t krow = (size_t)b * SEQ + s + vz;
            const bf16* kp = SK + krow * 512 + h * 64; const bf16* vp = SV + krow * 512 + h * 64;
            float z = 0.f, k[8];
#pragma unroll
            for (int j = 0; j < 8; ++j) { ld8(kp + 8 * j, k);
#pragma unroll
                for (int i = 0; i < 8; ++i) z += q[8 * j + i] * k[i]; }
            const float sp = fmaxf(z, 0.f) + log1pf(__expf(-fabsf(z)));
            const float a = __expf(z - sp + run);
#pragma unroll
            for (int j = 0; j < 8; ++j) { ld8(vp + 8 * j, k);
#pragma unroll
                for (int i = 0; i < 8; ++i) acc[8 * j + i] += a * k[i]; }
            run -= sp;
            if (run < -105.f) break;
        }
#pragma unroll
        for (int j = 0; j < 8; ++j) st8(Y + lrow * 1536 + 512 + h * 64 + 8 * j, acc + 8 * j);
    }
}
__device__ __forceinline__ float log2_gamma(int h) {
    return h == 0 ? -4.5803689613e-02f : h == 1 ? -2.2720076500e-02f : h == 2 ? -1.1315313228e-02f : h == 3 ? -5.6465631411e-03f : h == 4 ? -2.8205190624e-03f : h == 5 ? -1.4095702547e-03f : h == 6 ? -7.0461297659e-04f : -3.5226347163e-04f;
}
__device__ __forceinline__ void naive_ret(Frame& F, const float* gn) {
    bf16* Y = (bf16*)(F.ws + WS_Y); const bf16* RK = (const bf16*)(F.ws + WS_RK); const bf16* RV = (const bf16*)(F.ws + WS_RV); const bf16* RG = (const bf16*)(F.ws + WS_RG);
    const int vz = vzero();
    for (int it = blockIdx.x * NTHR + F.tid; it < BH * NHEAD * SEQ; it += F.G * NTHR) {
        int bh, t; item_bht(it, bh, t); const int b = bh >> 3, h = bh & 7; const size_t lrow = (size_t)b * SEQ + t;
        const float lg2 = log2_gamma(h);
        float q[64];
#pragma unroll
        for (int j = 0; j < 8; ++j) ld8(Y + lrow * 1536 + 1024 + h * 64 + 8 * j, q + 8 * j);
        float acc[64];
#pragma unroll
        for (int e = 0; e < 64; ++e) acc[e] = 0.f;
        for (int s = 0; s <= t; ++s) {
            const size_t krow = (size_t)b * SEQ + s + vz;
            const bf16* kp = RK + krow * 512 + h * 64; const bf16* vp = RV + krow * 512 + h * 64;
            float z = 0.f, k[8];
#pragma unroll
            for (int j = 0; j < 8; ++j) { ld8(kp + 8 * j, k);
#pragma unroll
                for (int i = 0; i < 8; ++i) z += q[8 * j + i] * k[i]; }
            const float a = z * exp2f((float)(t - s) * lg2);
#pragma unroll
            for (int j = 0; j < 8; ++j) { ld8(vp + 8 * j, k);
#pragma unroll
                for (int i = 0; i < 8; ++i) acc[8 * j + i] += a * k[i]; }
        }
        float mu = 0.f;
#pragma unroll
        for (int e = 0; e < 64; ++e) mu += acc[e];
        mu *= (1.f / 64.f); float var = 0.f;
#pragma unroll
        for (int e = 0; e < 64; ++e) { acc[e] -= mu; var += acc[e] * acc[e]; }
        const float rstd = rsqrtf(var * (1.f / 64.f) + EPS);
#pragma unroll
        for (int j = 0; j < 8; ++j) { float g8[8]; ld8(RG + lrow * 512 + h * 64 + 8 * j, g8);
#pragma unroll
            for (int i = 0; i < 8; ++i) acc[8 * j + i] = acc[8 * j + i] * rstd * gn[h * 64 + 8 * j + i] * g8[i];
            st8(Y + lrow * 1536 + 1024 + h * 64 + 8 * j, acc + 8 * j); }
    }
}

constexpr int N_PHASES = 1 + DEPTH * (1 + NHALF * 7) + 1;
__global__ void __launch_bounds__(NTHR, 2) fwd(Args args) {
    extern __shared__ __attribute__((aligned(16))) unsigned char lds[];
    Frame F;
    F.lds = (LAS unsigned char*)lds; F.tid = threadIdx.x; F.lane = F.tid & 63; F.wave = __builtin_amdgcn_readfirstlane(F.tid >> 6); F.G = gridDim.x; F.ws = args.ws;
    volatile LAS unsigned* MISC = (volatile LAS unsigned*)(F.lds + MISC_OFF);
    for (int u = F.tid; u < (LDS_BYTES - LDSCTL_OFF) / 4; u += NTHR) ((LAS unsigned*)(F.lds + LDSCTL_OFF))[u] = 0u;
    __syncthreads();
    const int lo = args.ph_lo, hi = args.ph_hi;
    const bool multi = (hi - lo) > 1;
    XcdBarrier bar; bar.bar = (unsigned*)(F.ws + WS_CTL) + CW_BAR; bar.x = 0; bar.st = nullptr;
    if (multi) bar = xcd_barrier_post((unsigned*)(F.ws + WS_CTL) + CW_BAR, MISC + 8);
    int ph = 0;
#define PH_BEGIN if (ph >= lo && ph < hi) { { int t_ = threadIdx.x; asm volatile("" : "+v"(t_)); F.tid = t_; F.lane = t_ & 63; }
#define PH_END   if (ph + 1 < hi) xcd_barrier(bar); } ++ph;

    unsigned char* ws = F.ws;
    u64* ssqx = (u64*)(ws + WS_SSQX);
    float* cosR = (float*)(ws + WS_COSR); float* sinR = (float*)(ws + WS_SINR); float* cosM = (float*)(ws + WS_COSM); float* sinM = (float*)(ws + WS_SINM);
    bf16* XB = (bf16*)(ws + WS_XB);
    const float* x_in = (const float*)args.in[0];

    PH_BEGIN prologue_phase(F, x_in, (const int*)args.in[1], cosR, sinR, cosM, sinM, XB, ssqx); PH_END

    for (int l = 0; l < DEPTH; ++l) {
        PH_BEGIN convert_phase(F, args, l); PH_END
        for (int hf = 0; hf < NHALF; ++hf) {
            const int grow0 = hf * MH;
            u64* ssqq = (u64*)(ws + WS_SSQQ) + (size_t)(l * 2 + hf) * MH; u64* ssqkv = (u64*)(ws + WS_SSQKV) + (size_t)(l * 2 + hf) * MH;
            PH_BEGIN {
                pg8::Gemm g{XB + (size_t)grow0 * DM, (const bf16*)(ws + WS_W + W_IN), DM, DM, DM};
                pg8::StaticOrder S; S.init(MH, NIN, F.G, (int)blockIdx.x);
                EpiIn E{ssqx + (size_t)(2 * l) * MTOT, grow0, (bf16*)(ws + WS_Y), (bf16*)(ws + WS_SBK), (bf16*)(ws + WS_SBV), (bf16*)(ws + WS_RK), (bf16*)(ws + WS_RV), (bf16*)(ws + WS_RG),
                        (bf16*)(ws + WS_GATES), (bf16*)(ws + WS_C), cosR, sinR, cosM, sinM, ssqq, ssqkv};
                pg8::gemm_phase<EpiIn, pg8::StaticOrder, true>(F.lds + RING_OFF, g, S, E);
            } PH_END
            PH_BEGIN {
                { pg8::Gemm g{(const bf16*)(ws + WS_C), (const bf16*)(ws + WS_W + W_UQ), NC, 384, 384};
                  pg8::StaticOrder S; S.init(MH, NQ, F.G, (int)blockIdx.x);
                  EpiUq E{ssqq, grow0, (bf16*)(ws + WS_QM), cosM, sinM};
                  pg8::gemm_phase<EpiUq, pg8::StaticOrder, true>(F.lds + RING_OFF, g, S, E); }
                { pg8::Gemm g{(const bf16*)(ws + WS_C) + 384, (const bf16*)(ws + WS_W + W_UKV), NC, 256, 256};
                  pg8::StaticOrder S; S.init(MH, NKV, F.G, (int)blockIdx.x);
                  EpiUkv E{ssqkv, (bf16*)(ws + WS_KVM)};
                  pg8::gemm_phase<EpiUkv, pg8::StaticOrder, true>(F.lds + RING_OFF, g, S, E); }
                naive_sb(F);
                naive_ret(F, (const float*)args.in[8] + (size_t)l * 512);
            } PH_END
            PH_BEGIN naive_mla(F); PH_END
            PH_BEGIN {
                pg8::Gemm g{(const bf16*)(ws + WS_Y), (const bf16*)(ws + WS_W + W_B), 1536, 1536, 512};
                pg8::SegOrder<3> S; S.b.init(MH, DM, F.G, (int)blockIdx.x);
                EpiMerge E{(const bf16*)(ws + WS_GATES), (bf16*)(ws + WS_MG)};
                pg8::gemm_phase<EpiMerge, pg8::SegOrder<3>, true>(F.lds + RING_OFF, g, S, E);
            } PH_END
            PH_BEGIN {
                pg8::Gemm g{(const bf16*)(ws + WS_MG), (const bf16*)(ws + WS_W + W_OUT), DM, DM, DM};
                pg8::StaticOrder S; S.init(MH, DM, F.G, (int)blockIdx.x);
                EpiResid E{l == 0 ? x_in : (const float*)args.out, args.out, XB, ssqx + (size_t)(2 * l + 1) * MTOT, grow0};
                pg8::gemm_phase<EpiResid, pg8::StaticOrder, true>(F.lds + RING_OFF, g, S, E);
            } PH_END
            PH_BEGIN {
                pg8::Gemm g{XB + (size_t)grow0 * DM, (const bf16*)(ws + WS_W + W_UP), DM, DM, DM};
                pg8::StaticOrder S; S.init(MH, DFF, F.G, (int)blockIdx.x);
                EpiUp E{ssqx + (size_t)(2 * l + 1) * MTOT, grow0, (bf16*)(ws + WS_H)};
                pg8::gemm_phase<EpiUp, pg8::StaticOrder, true>(F.lds + RING_OFF, g, S, E);
            } PH_END
            PH_BEGIN {
                pg8::Gemm g{(const bf16*)(ws + WS_H), (const bf16*)(ws + WS_W + W_DN), DFF, DFF, DFF};
                pg8::StaticOrder S; S.init(MH, DM, F.G, (int)blockIdx.x);
                EpiResid E{(const float*)args.out, args.out, XB, ssqx + (size_t)(2 * l + 2) * MTOT, grow0};
                pg8::gemm_phase<EpiResid, pg8::StaticOrder, true>(F.lds + RING_OFF, g, S, E);
            } PH_END
        }
    }
    PH_BEGIN final_phase(F, args.out, ssqx + (size_t)(2 * DEPTH) * MTOT, (const float*)args.in[14]); PH_END
#undef PH_BEGIN
#undef PH_END
}


#ifdef DBG_STOP
struct DumpItem { size_t off; int where; int is_f32; int rows; int width; int pitch; };
__global__ void __launch_bounds__(512) dbg_rowsum(Args a, float* dst, size_t off, int where, int is_f32, int rows, int width, int pitch) {
    const unsigned char* base = (where == 0) ? (const unsigned char*)a.ws : (where == 1) ? (const unsigned char*)a.out : (const unsigned char*)a.in[0];
    base += off;
    const int lane = threadIdx.x & 63, gw = blockIdx.x * 8 + (threadIdx.x >> 6), ngw = gridDim.x * 8;
    for (int r = gw; r < rows; r += ngw) {
        float s = 0.f;
        if (is_f32) { const float* p = (const float*)base + (size_t)r * pitch; for (int c = lane; c < width; c += 64) s += p[c] * (1.f + 0.001f * (c & 15)); }
        else { const unsigned short* p = (const unsigned short*)base + (size_t)r * pitch; for (int c = lane; c < width; c += 64) s += __uint_as_float((unsigned)p[c] << 16) * (1.f + 0.001f * (c & 15)); }
        for (int o = 1; o < 64; o <<= 1) s += __shfl_xor(s, o);
        if (lane == 0) dst[r] = s;
    }
}
__global__ void __launch_bounds__(512) dbg_copy(const float* src, float* out, int n, int total) {
    for (int i = blockIdx.x * 512 + threadIdx.x; i < total; i += gridDim.x * 512) out[i] = (i < n) ? src[i] : 0.f;
}
#endif
#ifndef MK_ONE_LAUNCH
#define MK_ONE_LAUNCH 0
#endif
extern "C" void kernel_launch(void* const* d_in, const int* in_sizes, int n_in, void* d_out, int out_size, void* d_ws, size_t ws_size, hipStream_t stream) {
    static int grid = 0;
    if (grid == 0) {
        if (n_in != 15 || in_sizes[0] != MTOT * DM || out_size != MTOT * DM || ws_size < WS_END) { fprintf(stderr, "kernel_launch: unexpected shapes (n_in %d, in0 %d, out %d, ws %zu < %zu); nothing launched\n", n_in, n_in > 0 ? in_sizes[0] : -1, out_size, ws_size, (size_t)WS_END); grid = -1; return; }
        int dev = 0, cus = 0, per_cu = 0;
        if (hipGetDevice(&dev) != hipSuccess || hipDeviceGetAttribute(&cus, hipDeviceAttributeMultiprocessorCount, dev) != hipSuccess) { grid = -1; return; }
        if (hipFuncSetAttribute((const void*)fwd, hipFuncAttributeMaxDynamicSharedMemorySize, LDS_BYTES) != hipSuccess) { fprintf(stderr, "kernel_launch: hipFuncSetAttribute failed\n"); grid = -1; return; }
        if (hipOccupancyMaxActiveBlocksPerMultiprocessor(&per_cu, (const void*)fwd, NTHR, LDS_BYTES) != hipSuccess || per_cu < 1) { fprintf(stderr, "kernel_launch: occupancy query reports %d blocks per CU\n", per_cu); }
        (void)hipGetLastError();
        grid = cus;
    }
    if (grid < 0) return;
    if (hipMemsetAsync((char*)d_ws + WS_CTL, 0, CTL_ZERO_BYTES, stream) != hipSuccess) return;
    if (hipMemsetAsync((char*)d_ws + WS_SSQ, 0, SSQ_ZERO_BYTES, stream) != hipSuccess) return;
    Args a{};
    for (int i = 0; i < 15; ++i) a.in[i] = d_in[i];
    a.out = (float*)d_out; a.ws = (unsigned char*)d_ws;
#ifdef DBG_STOP
    for (int p = 0; p < DBG_STOP; ++p) { a.ph_lo = p; a.ph_hi = p + 1; hipLaunchKernelGGL(fwd, dim3(grid), dim3(NTHR), LDS_BYTES, stream, a); }
    {   const DumpItem items[] = { DBG_ITEMS };
        float* scratch = (float*)((unsigned char*)d_ws + WS_RST); int n = 0;
        for (const DumpItem& it : items) { hipLaunchKernelGGL(dbg_rowsum, dim3(256), dim3(512), 0, stream, a, scratch + n, it.off, it.where, it.is_f32, it.rows, it.width, it.pitch); n += it.rows; }
        hipLaunchKernelGGL(dbg_copy, dim3(1024), dim3(512), 0, stream, (const float*)scratch, (float*)d_out, n, out_size); }
#elif MK_ONE_LAUNCH
    a.ph_lo = 0; a.ph_hi = N_PHASES;
    hipLaunchKernelGGL(fwd, dim3(grid), dim3(NTHR), LDS_BYTES, stream, a);
#else
    for (int p = 0; p < N_PHASES; ++p) { a.ph_lo = p; a.ph_hi = p + 1; hipLaunchKernelGGL(fwd, dim3(grid), dim3(NTHR), LDS_BYTES, stream, a); }
#endif
}
```

```cpp
#define MK_ONE_LAUNCH 1
#include <hip/hip_runtime.h>
#include <cstdio>
#include <cstdint>
#include <cmath>

namespace pg8 {
#define PG8_LAS __attribute__((address_space(3)))
typedef unsigned short bf16_t;
typedef short bf16x8 __attribute__((ext_vector_type(8)));
typedef float f32x4 __attribute__((ext_vector_type(4)));
typedef unsigned u32x4 __attribute__((ext_vector_type(4)));
typedef unsigned u32x2 __attribute__((ext_vector_type(2)));
constexpr int BM = 256, BK = 64, HALF = 128, HTB = HALF * BK * 2  , STAGE_BYTES = 8 * HTB, NXCD = 8, WGM = 8;

__host__ __device__ __forceinline__ int lds_byte(int r, int c) { const int st = (r >> 4) * 2 + (c >> 5), rr = r & 15, cc = c & 31, ob = rr * 64 + cc * 2; return st * 1024 + (ob ^ (((ob >> 9) & 1) << 5)); }
__host__ __device__ __forceinline__ void stage_rc(int b, int& R, int& C) { const int st = b / 1024, sb = b % 1024, swz = sb ^ (((sb >> 9) & 1) << 5); R = (st >> 1) * 16 + swz / 64; C = (st & 1) * 32 + (swz % 64) / 2; }
__host__ __device__ __forceinline__ int perm32(int rho) { const int n = rho >> 4, i = rho & 15; return 8 * (i >> 2) + 4 * n + (i & 3); }

struct Unit { int pm, pn, ks; };
struct Gemm { const bf16_t* A; const bf16_t* Bt; int lda, ldb, K; };

struct StaticOrder {
    int nM, nN, nwg, G, c;
    __host__ __device__ void init(int M, int N, int G_, int c_) { nM = M / BM; nN = N / BM; nwg = nM * nN; G = G_; c = c_; }
    __host__ __device__ bool tile(int i, Unit& u) const {
        const long L = (long)i * G + c; if (L >= nwg) return false;
        int wgid = (int)L; { const int q = nwg / NXCD, r = nwg % NXCD, xcd = wgid % NXCD, off = wgid / NXCD; wgid = (xcd < r ? xcd * (q + 1) : r * (q + 1) + (xcd - r) * q) + off; }
        const int nig = WGM * nN, gid = wgid / nig, fm = gid * WGM, gsz = (nM - fm) < WGM ? (nM - fm) : WGM;
        u.pm = fm + ((wgid % nig) % gsz); u.pn = (wgid % nig) / gsz; u.ks = 0; return true;
    }
    __host__ __device__ bool next(int i, Unit& u) const { return tile(i, u); }
    __device__ __forceinline__ void a_ready(const Unit&) const {}
    __device__ __forceinline__ void done(const Unit&) const {}
};
template <int NSEG> struct SegOrder {
    StaticOrder b;
    __host__ __device__ bool next(int i, Unit& u) const { if (!b.tile(i / NSEG, u)) return false; u.ks = i % NSEG; return true; }
    __device__ __forceinline__ void a_ready(const Unit&) const {}
    __device__ __forceinline__ void done(const Unit&) const {}
};

__device__ __forceinline__ unsigned cvt_pk_bf16(float lo, float hi) { unsigned r; asm volatile("v_cvt_pk_bf16_f32 %0, %1, %2" : "=v"(r) : "v"(lo), "v"(hi)); return r; }

template <class Epi, class Sched, bool ALIGN_EPI>
__device__ __forceinline__ void gemm_phase(PG8_LAS unsigned char* lds, const Gemm g, const Sched& S, const Epi& E) {
    int tid_ = threadIdx.x; asm volatile("" : "+v"(tid_));
    const int tid = tid_, wid = __builtin_amdgcn_readfirstlane(tid >> 6), lane = tid & 63, wr = wid >> 2, wc = wid & 3, fr = lane & 15, fq = lane >> 4;
    const int K = g.K, nt = K / BK;
    unsigned voffA[2], voffB[2];
#pragma unroll
    for (int i = 0; i < 2; ++i) { int R, C; stage_rc(tid * 16 + i * 8192, R, C); const int Rb = Epi::PERM ? ((R & ~31) + perm32(R & 31)) : R;
        voffA[i] = (unsigned)(R * g.lda + C) * 2u; voffB[i] = (unsigned)(Rb * g.ldb + C) * 2u; }
    const size_t kstep = (size_t)(BK * 2);
    const size_t hstepA = (size_t)HALF * g.lda * 2, hstepB = (size_t)HALF * g.ldb * 2;
    const size_t tstepA = 2 * hstepA, tstepB = 2 * hstepB;
    const size_t ksb = (size_t)K * 2;
    const unsigned ldsw = (unsigned)wid * 1024u;
    const int aoff = lds_byte(wr * 64 + fr, fq * 8), boff = lds_byte(wc * 32 + fr, fq * 8);
#define PG8_SA(b, h) (((b) * 2 + (h)) * HTB)
#define PG8_SB(b, h) ((4 + (b) * 2 + (h)) * HTB)
#define PG8_STAGE(bufoff, gbase, voff) do { _Pragma("unroll") for (int _i = 0; _i < 2; ++_i) \
        __builtin_amdgcn_global_load_lds((const unsigned*)((const char*)(gbase) + (voff)[_i]), (PG8_LAS unsigned*)(lds + (bufoff) + ldsw + _i * 8192), 16, 0, 0); } while (0)
#define PG8_LDA(dst, b, h) do { _Pragma("unroll") for (int m = 0; m < 4; ++m) _Pragma("unroll") for (int k = 0; k < 2; ++k) dst[m][k] = *(const PG8_LAS bf16x8*)(lds + PG8_SA(b, h) + aoff + m * 2048 + k * 1024); } while (0)
#define PG8_LDB(dst, b, h) do { _Pragma("unroll") for (int n = 0; n < 2; ++n) _Pragma("unroll") for (int k = 0; k < 2; ++k) dst[n][k] = *(const PG8_LAS bf16x8*)(lds + PG8_SB(b, h) + boff + n * 2048 + k * 1024); } while (0)
#define PG8_MMA(ai, bj, At, Bt) do { __builtin_amdgcn_s_setprio(1); _Pragma("unroll") for (int m = 0; m < 4; ++m) _Pragma("unroll") for (int n = 0; n < 2; ++n) _Pragma("unroll") for (int k = 0; k < 2; ++k) \
        acc[ai][bj][m][n] = __builtin_amdgcn_mfma_f32_16x16x32_bf16(Bt[n][k], At[m][k], acc[ai][bj][m][n], 0, 0, 0); __builtin_amdgcn_s_setprio(0); } while (0)
#define PG8_WAIT_V(n) asm volatile("s_waitcnt vmcnt(" #n ")" ::: "memory")
#define PG8_WAIT_L(n) asm volatile("s_waitcnt lgkmcnt(" #n ")" ::: "memory")
#define PG8_BAR __builtin_amdgcn_s_barrier()
#define PG8_SCHED __builtin_amdgcn_sched_barrier(0)
    Unit cur, nxt; int ui = 0;
    if (!S.next(0, cur)) return;
    f32x4 acc[2][2][4][2];
#pragma unroll
    for (int a = 0; a < 2; ++a)
#pragma unroll
        for (int b = 0; b < 2; ++b)
#pragma unroll
            for (int m = 0; m < 4; ++m)
#pragma unroll
                for (int n = 0; n < 2; ++n) acc[a][b][m][n] = (f32x4){0.f, 0.f, 0.f, 0.f};
    bf16x8 At[4][2], B0[2][2], B1[2][2];
    const char* cA = (const char*)g.A + (size_t)cur.pm * tstepA + (size_t)cur.ks * ksb; const char* cB = (const char*)g.Bt + (size_t)cur.pn * tstepB + (size_t)cur.ks * ksb;
    S.a_ready(cur);
    PG8_STAGE(PG8_SB(0, 0), cB, voffB); PG8_STAGE(PG8_SB(0, 1), cB + hstepB, voffB); PG8_STAGE(PG8_SA(0, 0), cA, voffA); PG8_STAGE(PG8_SA(0, 1), cA + hstepA, voffA);
    if (wr == 1) PG8_BAR;
    PG8_WAIT_V(2); PG8_BAR;
    PG8_STAGE(PG8_SB(1, 0), cB + kstep, voffB); PG8_STAGE(PG8_SA(1, 0), cA + kstep, voffA); PG8_STAGE(PG8_SB(1, 1), cB + hstepB + kstep, voffB);
    PG8_WAIT_V(6); PG8_BAR;
    for (;;) {
        const bool has_next = S.next(ui + 1, nxt);
        const char* nA = has_next ? (const char*)g.A + (size_t)nxt.pm * tstepA + (size_t)nxt.ks * ksb : cA; const char* nB = has_next ? (const char*)g.Bt + (size_t)nxt.pn * tstepB + (size_t)nxt.ks * ksb : cB;
#pragma nounroll
        for (int t = 0; t < nt; t += 2) {
            const bool last = (t == nt - 2);
            const char* a1 = cA + (size_t)(t + 1) * kstep;
            const char* a2 = last ? nA : cA + (size_t)(t + 2) * kstep; const char* b2 = last ? nB : cB + (size_t)(t + 2) * kstep;
            const char* a3 = a2 + kstep; const char* b3 = b2 + kstep;
            if (last && has_next) S.a_ready(nxt);
            PG8_LDB(B0, 0, 0); PG8_LDB(B1, 0, 1); PG8_SCHED; PG8_LDA(At, 0, 0); PG8_STAGE(PG8_SA(1, 1), a1 + hstepA, voffA);
            PG8_WAIT_V(8); PG8_WAIT_L(0); PG8_BAR; PG8_MMA(0, 0, At, B0); PG8_MMA(0, 1, At, B1); PG8_BAR; PG8_SCHED;
            PG8_LDA(At, 0, 1); PG8_STAGE(PG8_SB(0, 0), b2, voffB); PG8_STAGE(PG8_SB(0, 1), b2 + hstepB, voffB); PG8_STAGE(PG8_SA(0, 0), a2, voffA);
            PG8_WAIT_V(8); PG8_WAIT_L(0); PG8_BAR; PG8_MMA(1, 0, At, B0); PG8_MMA(1, 1, At, B1); PG8_BAR; PG8_SCHED;
            PG8_LDB(B0, 1, 0); PG8_LDB(B1, 1, 1); PG8_SCHED; PG8_LDA(At, 1, 0); PG8_STAGE(PG8_SA(0, 1), a2 + hstepA, voffA);
            PG8_WAIT_V(8); PG8_WAIT_L(0); PG8_BAR; PG8_MMA(0, 0, At, B0); PG8_MMA(0, 1, At, B1); PG8_BAR; PG8_SCHED;
            PG8_LDA(At, 1, 1); PG8_STAGE(PG8_SB(1, 0), b3, voffB); PG8_STAGE(PG8_SB(1, 1), b3 + hstepB, voffB); PG8_STAGE(PG8_SA(1, 0), a3, voffA);
            PG8_WAIT_V(8); PG8_WAIT_L(0); PG8_BAR; PG8_MMA(1, 0, At, B0); PG8_MMA(1, 1, At, B1); PG8_BAR; PG8_SCHED;
        }
        if constexpr (ALIGN_EPI) { if (wr == 0) PG8_BAR; }
        E(acc, cur, wr, wc, fr, fq); S.done(cur);
        if (!has_next) break;
        if (!E.keep(cur)) {
#pragma unroll
        for (int a = 0; a < 2; ++a)
#pragma unroll
            for (int b = 0; b < 2; ++b)
#pragma unroll
                for (int m = 0; m < 4; ++m)
#pragma unroll
                    for (int n = 0; n < 2; ++n) acc[a][b][m][n] = (f32x4){0.f, 0.f, 0.f, 0.f};
        }
        cur = nxt; cA = nA; cB = nB; ++ui;
        if constexpr (ALIGN_EPI) { if (wr == 1) PG8_BAR; }
    }
    PG8_WAIT_V(0);
    if constexpr (!ALIGN_EPI) { if (wr == 0) PG8_BAR; }
    PG8_BAR;
#undef PG8_SA
#undef PG8_SB
#undef PG8_STAGE
#undef PG8_LDA
#undef PG8_LDB
#undef PG8_MMA
#undef PG8_WAIT_V
#undef PG8_WAIT_L
#undef PG8_BAR
#undef PG8_SCHED
}
}

constexpr int NWAVES = 8, NTHR = NWAVES * 64;
constexpr int BATCH = 8, SEQ = 4096, DM = 1024, DEPTH = 4, DFF = 4096;
constexpr int MTOT = BATCH * SEQ;
constexpr int NHALF = 2, MH = MTOT / NHALF, BH = BATCH / NHALF;
constexpr int NHEAD = 8;
constexpr int D_IN = 7328, NIN = 7424;
constexpr int NC = 768;
constexpr int NQ = 768, NKV = 1024;
constexpr float EPS = 1e-6f;
constexpr float QSCALE = 0.10206207261596575f * 1.4426950408889634f;

constexpr size_t MiB = 1u << 20;
constexpr size_t WS_CTL = 0, CTL_ZERO_BYTES = 1 * MiB;
constexpr size_t WS_SSQ = 488 * MiB, SSQ_ZERO_BYTES = 5 * MiB;
constexpr size_t WS_SSQX = WS_SSQ;
constexpr size_t WS_SSQQ = WS_SSQX + 9 * (size_t)MTOT * 8;
constexpr size_t WS_SSQKV = WS_SSQQ + 8 * (size_t)MH * 8;
static_assert(WS_SSQKV + 8 * (size_t)MH * 8 <= WS_SSQ + SSQ_ZERO_BYTES, "accumulators inside the memset region");
constexpr size_t WS_COSR = 4 * MiB, WS_SINR = 8 * MiB, WS_COSM = 12 * MiB, WS_SINM = 14 * MiB;
constexpr size_t WS_XB = 16 * MiB;
constexpr size_t WS_W = 80 * MiB;
constexpr size_t W_IN = 0, W_UQ = W_IN + (size_t)NIN * DM * 2, W_UKV = W_UQ + (size_t)NQ * 384 * 2, W_B = W_UKV + (size_t)NKV * 256 * 2,
                 W_OUT = W_B + (size_t)DM * 1536 * 2, W_UP = W_OUT + (size_t)DM * DM * 2, W_DN = W_UP + (size_t)DFF * DM * 2, W_END = W_DN + (size_t)DM * DFF * 2;
static_assert(W_END <= 40 * MiB, "weights region");
constexpr size_t WS_C = 120 * MiB;
constexpr size_t WS_QM = 144 * MiB;
constexpr size_t WS_KVM = 168 * MiB;
constexpr size_t WS_Y = 200 * MiB;
constexpr size_t WS_SBK = 248 * MiB, WS_SBV = 264 * MiB;
constexpr size_t WS_RK = 280 * MiB, WS_RV = 296 * MiB, WS_RG = 312 * MiB;
constexpr size_t WS_GATES = 328 * MiB;
constexpr size_t WS_MG = 424 * MiB;
constexpr size_t WS_RST = 456 * MiB;
constexpr size_t WS_H = 248 * MiB;
constexpr size_t WS_END = 493 * MiB;
static_assert(WS_H + (size_t)MH * DFF * 2 <= WS_MG, "H overlay");
constexpr int CW_BAR = 4096;

constexpr int RING_OFF = 0, RING_BYTES = 131072;
constexpr int LDSCTL_OFF = RING_BYTES, MISC_OFF = LDSCTL_OFF + 320;
constexpr int LDS_BYTES = 147456;

#define GAS __attribute__((address_space(1)))
#define LAS __attribute__((address_space(3)))
typedef unsigned short bf16;
typedef unsigned v4u __attribute__((ext_vector_type(4)));
typedef float f32x4 __attribute__((ext_vector_type(4)));
typedef GAS unsigned gu32;
#define RLX_AGENT __ATOMIC_RELAXED, __HIP_MEMORY_SCOPE_AGENT
#define LDS_WAIT() asm volatile("s_waitcnt lgkmcnt(0)" ::: "memory")
#define VM_WAIT() asm volatile("s_waitcnt vmcnt(0)" ::: "memory")
__device__ __forceinline__ unsigned f2bf(float f) { unsigned u = __builtin_bit_cast(unsigned, f); return (u + 0x7fffu + ((u >> 16) & 1u)) >> 16; }
__device__ __forceinline__ unsigned pk2(float lo, float hi) { return f2bf(lo) | (f2bf(hi) << 16); }
__device__ __forceinline__ float bflo(unsigned w) { return __uint_as_float(w << 16); }
__device__ __forceinline__ float bfhi(unsigned w) { return __uint_as_float(w & 0xffff0000u); }

#define XB_TMO      128
#define XB_XCNT(j)  (256  + 64 * (j))
#define XB_XSUB(j)  (1280 + 64 * (j))
#define XB_XGEN(j)  (2304 + 64 * (j))
#define XB_TOP      3328
#define XB_TOPGEN   3392
#define XCD_BAR_WORDS 3456
#define XB_SPIN_CAP (1u << 18)

__device__ __forceinline__ unsigned xb_ld(unsigned* p)              { return __hip_atomic_load(p, __ATOMIC_RELAXED, __HIP_MEMORY_SCOPE_AGENT); }
__device__ __forceinline__ unsigned xb_add(unsigned* p, unsigned v) { return __hip_atomic_fetch_add(p, v, __ATOMIC_RELAXED, __HIP_MEMORY_SCOPE_AGENT); }
__device__ __forceinline__ unsigned xb_xcc_id() { return (unsigned)__builtin_amdgcn_s_getreg((3 << 11) | 20) & 0xFu; }
#define XB_SPIN(cond, bar) do { unsigned _sp = 0; while (cond) { __builtin_amdgcn_s_sleep(1); \
    if ((++_sp & 255u) == 0u) { if (xb_ld(&(bar)[XB_TMO])) break; if (_sp > XB_SPIN_CAP) { atomicAdd(&(bar)[XB_TMO], 1u); break; } } } } while (0)

struct XcdBarrier {
    unsigned* bar; unsigned x;
    volatile LAS unsigned* st;
};
__device__ __forceinline__ XcdBarrier xcd_barrier_post(unsigned* bar, volatile LAS unsigned* st) {
    XcdBarrier b; b.bar = bar; b.x = xb_xcc_id(); b.st = st;
    if (threadIdx.x == 0) (void)xb_add(&bar[XB_XCNT(b.x)], 1u);
    return b;
}
__device__ __forceinline__ void xcd_barrier_complete(unsigned* bar, unsigned x, unsigned& nloc, unsigned& nx) {
    const unsigned G = gridDim.x * gridDim.y * gridDim.z;
    unsigned sum, cnt, mine, sp = 0u;
    for (;;) {
        sum = 0u; cnt = 0u; mine = 0u;
#pragma unroll
        for (unsigned j = 0; j < 16; ++j) { const unsigned c = xb_ld(&bar[XB_XCNT(j)]); sum += c; cnt += (c > 0u) ? 1u : 0u; mine = (j == x) ? c : mine; }
        if (sum == G) break;
        __builtin_amdgcn_s_sleep(1);
        if ((++sp & 255u) == 0u) { if (xb_ld(&bar[XB_TMO])) break; if (sp > XB_SPIN_CAP) { atomicAdd(&bar[XB_TMO], 1u); break; } }
    }
    nloc = mine > 0u ? mine : 1u; nx = cnt > 0u ? cnt : 1u;
}
__device__ __forceinline__ void xcd_barrier(const XcdBarrier& b) {
    asm volatile("s_waitcnt vmcnt(0)" ::: "memory");
    __syncthreads();
    if (threadIdx.x == 0) {
        unsigned* bar = b.bar;
        __builtin_amdgcn_s_waitcnt(0);
        unsigned nloc = b.st[0], nx = b.st[1];
        if (nloc == 0u) { xcd_barrier_complete(bar, b.x, nloc, nx); b.st[0] = nloc; b.st[1] = nx; }
        const unsigned old = xb_add(&bar[XB_XSUB(b.x)], 1u);
        const unsigned gen = old / nloc;
        if (old + 1u == (gen + 1u) * nloc) {
            __builtin_amdgcn_fence(__ATOMIC_RELEASE, "agent");
            asm volatile("s_waitcnt vmcnt(0)" ::: "memory");
            const unsigned og = xb_add(&bar[XB_TOP], 1u);
            const unsigned tg = og / nx;
            if (og + 1u == (tg + 1u) * nx) xb_add(&bar[XB_TOPGEN], 1u);
            else XB_SPIN(xb_ld(&bar[XB_TOPGEN]) == tg, bar);
            __builtin_amdgcn_fence(__ATOMIC_ACQUIRE, "agent");
            xb_add(&bar[XB_XGEN(b.x)], 1u);
            asm volatile("s_waitcnt vmcnt(0)" ::: "memory");
        } else {
            XB_SPIN(xb_ld(&bar[XB_XGEN(b.x)]) == gen, bar);
            __builtin_amdgcn_fence(__ATOMIC_ACQUIRE, "agent");
            asm volatile("s_waitcnt vmcnt(0)" ::: "memory");
        }
    }
    __syncthreads();
}

struct Args { const void* in[15]; float* out; unsigned char* ws; int ph_lo, ph_hi; };
struct Frame {
    LAS unsigned char* lds;
    int tid, lane, wave, G;
    unsigned char* ws;
};

__device__ __forceinline__ float wave_sum(float v) {
#pragma unroll
    for (int o = 1; o < 64; o <<= 1) v += __shfl_xor(v, o);
    return v;
}
typedef unsigned long long u64;
__device__ __forceinline__ void ssq_add(u64* p, float s) { atomicAdd(p, (u64)(s * 16777216.f + 0.5f)); }
__device__ __forceinline__ float ssq_get(const u64* p) { return (float)(*p) * (1.f / 16777216.f); }
__device__ __forceinline__ int vzero() { int z; asm volatile("v_mov_b32 %0, 0" : "=v"(z)); return z; }

template <int MAP> __device__ __forceinline__ int src_col(int n) {
    if constexpr (MAP == 0) return n;
    else if constexpr (MAP == 1) {
        if (n < 512) return 672 + n;
        if (n < 1024) return 1184 + (n - 512);
        if (n < 1536) return 1696 + (n - 1024);
        if (n < 2048) { const int c = n - 1536; return 2208 + (c & ~63) + ((c & 63) >> 1) + 32 * (c & 1); }
        if (n < 2560) { const int c = n - 2048; return 2720 + (c & ~63) + ((c & 63) >> 1) + 32 * (c & 1); }
        if (n < 3072) return 3232 + (n - 2560);
        if (n < 3584) return 3744 + (n - 3072);
        if (n < 6656) return 4256 + (n - 3584);
        if (n < 7040) return n - 6656;
        if (n < 7296) return 384 + (n - 7040);
        if (n < 7328) { const int j = n - 7296; return 640 + (j >> 1) + 16 * (j & 1); }
        return -1;
    } else {
        const int h = n / 96, hc = n % 96; if (hc < 64) return n; const int j = hc - 64; return h * 96 + 64 + (j >> 1) + 16 * (j & 1);
    }
}
template <int MAP> __device__ __forceinline__ void transpose_item(const float* W, int Nsrc, int Ndst, const float* gain, bf16* WT, int pitch, int koff, LAS float* scr, int item, int lane) {
    const int nblk = Ndst / 32, kb = item / nblk, nb = item % nblk, k0 = 64 * kb, n0 = 32 * nb;
    const int sc = src_col<MAP>(n0 + (lane & 31));
#pragma unroll 8
    for (int i = 0; i < 32; ++i) { const int kk = 2 * i + (lane >> 5); float w = (sc >= 0) ? W[(size_t)(k0 + kk) * Nsrc + sc] : 0.f; if (gain) w *= gain[k0 + kk]; scr[kk * 33 + (lane & 31)] = w; }
    LDS_WAIT(); asm volatile("" ::: "memory");
    const int c = lane & 7;
#pragma unroll
    for (int j = 0; j < 4; ++j) { const int n = (lane >> 3) + 8 * j; const LAS float* s = scr + (8 * c) * 33 + n;
        v4u o; o.x = pk2(s[0 * 33], s[1 * 33]); o.y = pk2(s[2 * 33], s[3 * 33]); o.z = pk2(s[4 * 33], s[5 * 33]); o.w = pk2(s[6 * 33], s[7 * 33]);
        *(GAS v4u*)(WT + (size_t)(n0 + n) * pitch + koff + k0 + 8 * c) = o; }
    LDS_WAIT(); asm volatile("" ::: "memory");
}

using pg8::Unit; using pg8::bf16_t; using pg8::u32x4; using pg8::cvt_pk_bf16;
typedef float accT[2][2][4][2] __attribute__((unused));
__device__ __forceinline__ u32x4 pack8(const float (&v)[8]) { u32x4 w; w.x = cvt_pk_bf16(v[0], v[1]); w.y = cvt_pk_bf16(v[2], v[3]); w.z = cvt_pk_bf16(v[4], v[5]); w.w = cvt_pk_bf16(v[6], v[7]); return w; }
__device__ __forceinline__ float sigmoidf_(float x) { return __builtin_amdgcn_rcpf(1.f + __expf(-x)); }

struct EpiIn {
    static constexpr bool PERM = true;
    const u64* ssq; int grow0;
    bf16_t *Y, *SBK, *SBV, *RK, *RV, *RG, *GATES, *C;
    const float *cosR, *sinR, *cosM, *sinM;
    u64 *ssqq, *ssqkv;
    __device__ __forceinline__ bool keep(const Unit&) const { return false; }
    __device__ __forceinline__ void operator()(pg8::f32x4 (&acc)[2][2][4][2], const Unit& u, int wr, int wc, int fr_, int fq_) const {
        int fr = fr_, fq = fq_; asm volatile("" : "+v"(fr), "+v"(fq));
        const int pn = u.pn;
        int mode, pitch, col0; bf16_t* dst; float scale = 1.f;
        if (pn < 14) { const int seg = pn >> 1; col0 = (pn & 1) * 256; pitch = 512; mode = 0;
            if (seg == 0) { dst = Y; pitch = 1536; col0 += 512; scale = 0.125f; }
            else if (seg == 1) { dst = SBK; }
            else if (seg == 2) { dst = SBV; }
            else if (seg == 3) { dst = Y; pitch = 1536; col0 += 1024; mode = 1; scale = 0.125f; }
            else if (seg == 4) { dst = RK; mode = 1; }
            else if (seg == 5) { dst = RV; }
            else { dst = RG; mode = 2; }
        } else if (pn < 26) { dst = GATES; pitch = 3072; col0 = (pn - 14) * 256; mode = 3; }
        else { dst = C; pitch = NC; col0 = (pn - 26) * 256; mode = 4; }
        const int lrow0 = u.pm * 256 + wr * 64 + fr, cw = wc * 32 + 8 * fq;
#pragma unroll
        for (int ai = 0; ai < 2; ++ai)
#pragma unroll
            for (int m = 0; m < 4; ++m) { asm volatile("" ::: "memory");
                const int lrow = lrow0 + ai * 128 + m * 16, grow = grow0 + lrow;
                const float rs = rsqrtf(ssq_get(ssq + grow) * (1.f / 1024.f) + EPS);
#pragma unroll
                for (int bj = 0; bj < 2; ++bj) {
                    const int ct = bj * 128 + cw;
                    float v[8];
#pragma unroll
                    for (int j = 0; j < 4; ++j) { v[j] = acc[ai][bj][m][0][j] * rs; v[4 + j] = acc[ai][bj][m][1][j] * rs; }
                    bf16_t* p = dst + (size_t)lrow * pitch + col0 + ct;
                    if (mode == 0) {
#pragma unroll
                        for (int j = 0; j < 8; ++j) v[j] *= scale;
                    } else if (mode == 1) {
                        const int i0 = (ct & 63) >> 1;
                        const pg8::f32x4 c4 = *(const pg8::f32x4*)(cosR + (size_t)grow * 32 + i0), s4 = *(const pg8::f32x4*)(sinR + (size_t)grow * 32 + i0);
#pragma unroll
                        for (int j = 0; j < 4; ++j) { const float x1 = v[2 * j], x2 = v[2 * j + 1]; v[2 * j] = (x1 * c4[j] - x2 * s4[j]) * scale; v[2 * j + 1] = (x2 * c4[j] + x1 * s4[j]) * scale; }
                    } else if (mode == 2) {
#pragma unroll
                        for (int j = 0; j < 8; ++j) v[j] = v[j] * sigmoidf_(v[j]);
                    } else if (mode == 3) {
#pragma unroll
                        for (int j = 0; j < 8; ++j) v[j] = sigmoidf_(fminf(fmaxf(v[j], -80.f), 80.f));
                    } else {
                        const int cb = col0 + bj * 128 + wc * 32;
                        if (cb < 640) {
                            float s = 0.f;
#pragma unroll
                            for (int j = 0; j < 8; ++j) s += v[j] * v[j];
                            s += __shfl_xor(s, 16); s += __shfl_xor(s, 32);
                            if (fq == 0) ssq_add((cb < 384 ? ssqq : ssqkv) + lrow, s);
                        } else if (cb < 672) {
                            const int i0 = 4 * fq;
                            const pg8::f32x4 c4 = *(const pg8::f32x4*)(cosM + (size_t)grow * 16 + i0), s4 = *(const pg8::f32x4*)(sinM + (size_t)grow * 16 + i0);
#pragma unroll
                            for (int j = 0; j < 4; ++j) { const float x1 = v[2 * j], x2 = v[2 * j + 1]; v[2 * j] = x1 * c4[j] - x2 * s4[j]; v[2 * j + 1] = x2 * c4[j] + x1 * s4[j]; }
                        } else continue;
                    }
                    *(u32x4*)p = pack8(v);
                }
            }
    }
};

struct EpiUq {
    static constexpr bool PERM = true;
    const u64* ssqq; int grow0; bf16_t* QM; const float *cosM, *sinM;
    __device__ __forceinline__ bool keep(const Unit&) const { return false; }
    __device__ __forceinline__ void operator()(pg8::f32x4 (&acc)[2][2][4][2], const Unit& u, int wr, int wc, int fr_, int fq_) const {
        int fr = fr_, fq = fq_; asm volatile("" : "+v"(fr), "+v"(fq));
        const int lrow0 = u.pm * 256 + wr * 64 + fr, cw = wc * 32 + 8 * fq;
#pragma unroll
        for (int ai = 0; ai < 2; ++ai)
#pragma unroll
            for (int m = 0; m < 4; ++m) { asm volatile("" ::: "memory");
                const int lrow = lrow0 + ai * 128 + m * 16, grow = grow0 + lrow;
                const float rs = rsqrtf(ssq_get(ssqq + lrow) * (1.f / 384.f) + EPS) * QSCALE;
#pragma unroll
                for (int bj = 0; bj < 2; ++bj) {
                    const int c = u.pn * 256 + bj * 128 + cw, hc = c % 96;
                    float v[8];
#pragma unroll
                    for (int j = 0; j < 4; ++j) { v[j] = acc[ai][bj][m][0][j] * rs; v[4 + j] = acc[ai][bj][m][1][j] * rs; }
                    if (hc >= 64) {
                        const int i0 = (hc - 64) >> 1;
                        const pg8::f32x4 c4 = *(const pg8::f32x4*)(cosM + (size_t)grow * 16 + i0), s4 = *(const pg8::f32x4*)(sinM + (size_t)grow * 16 + i0);
#pragma unroll
                        for (int j = 0; j < 4; ++j) { const float x1 = v[2 * j], x2 = v[2 * j + 1]; v[2 * j] = x1 * c4[j] - x2 * s4[j]; v[2 * j + 1] = x2 * c4[j] + x1 * s4[j]; }
                    }
                    *(u32x4*)(QM + (size_t)lrow * NQ + c) = pack8(v);
                }
            }
    }
};
struct EpiUkv {
    static constexpr bool PERM = true;
    const u64* ssqkv; bf16_t* KVM;
    __device__ __forceinline__ bool keep(const Unit&) const { return false; }
    __device__ __forceinline__ void operator()(pg8::f32x4 (&acc)[2][2][4][2], const Unit& u, int wr, int wc, int fr_, int fq_) const {
        int fr = fr_, fq = fq_; asm volatile("" : "+v"(fr), "+v"(fq));
        const int lrow0 = u.pm * 256 + wr * 64 + fr, cw = wc * 32 + 8 * fq;
#pragma unroll
        for (int ai = 0; ai < 2; ++ai)
#pragma unroll
            for (int m = 0; m < 4; ++m) { asm volatile("" ::: "memory");
                const int lrow = lrow0 + ai * 128 + m * 16;
                const float rs = rsqrtf(ssq_get(ssqkv + lrow) * (1.f / 256.f) + EPS);
#pragma unroll
                for (int bj = 0; bj < 2; ++bj) {
                    float v[8];
#pragma unroll
                    for (int j = 0; j < 4; ++j) { v[j] = acc[ai][bj][m][0][j] * rs; v[4 + j] = acc[ai][bj][m][1][j] * rs; }
                    *(u32x4*)(KVM + (size_t)lrow * NKV + u.pn * 256 + bj * 128 + cw) = pack8(v);
                }
            }
    }
};
struct EpiMerge {
    static constexpr bool PERM = true;
    const bf16_t* G; bf16_t* MG;
    __device__ __forceinline__ bool keep(const Unit& u) const { return u.ks < 2; }
    __device__ __forceinline__ void operator()(pg8::f32x4 (&acc)[2][2][4][2], const Unit& u, int wr, int wc, int fr_, int fq_) const {
        int fr = fr_, fq = fq_; asm volatile("" : "+v"(fr), "+v"(fq));
        const int lrow0 = u.pm * 256 + wr * 64 + fr, cw = wc * 32 + 8 * fq, ks = u.ks;
#pragma unroll
        for (int ai = 0; ai < 2; ++ai)
#pragma unroll
            for (int m = 0; m < 4; ++m) { asm volatile("" ::: "memory");
                const int lrow = lrow0 + ai * 128 + m * 16;
#pragma unroll
                for (int bj = 0; bj < 2; ++bj) {
                    const int d = u.pn * 256 + bj * 128 + cw;
                    const bf16_t* gp = G + (size_t)lrow * 3072 + ks * 1024 + d;
                    const u32x4 ga = *(const u32x4*)gp;
                    float f[8];
#pragma unroll
                    for (int j = 0; j < 4; ++j) { f[2 * j] = bflo(ga[j]); f[2 * j + 1] = bfhi(ga[j]); }
                    if (ks < 2) {
                        const u32x4 gb = *(const u32x4*)(gp + 1024);
#pragma unroll
                        for (int j = 0; j < 4; ++j) { f[2 * j] *= __builtin_amdgcn_rcpf(bflo(gb[j])); f[2 * j + 1] *= __builtin_amdgcn_rcpf(bfhi(gb[j])); }
                    }
#pragma unroll
                    for (int j = 0; j < 4; ++j) { acc[ai][bj][m][0][j] *= f[j]; acc[ai][bj][m][1][j] *= f[4 + j]; }
                    if (ks == 2) {
                        float v[8];
#pragma unroll
                        for (int j = 0; j < 4; ++j) { v[j] = acc[ai][bj][m][0][j]; v[4 + j] = acc[ai][bj][m][1][j]; }
                        *(u32x4*)(MG + (size_t)lrow * DM + d) = pack8(v);
                    }
                }
            }
    }
};
struct EpiResid {
    static constexpr bool PERM = true;
    const float* xin; float* xout; bf16_t* XB; u64* ssq_next; int grow0;
    __device__ __forceinline__ bool keep(const Unit&) const { return false; }
    __device__ __forceinline__ void operator()(pg8::f32x4 (&acc)[2][2][4][2], const Unit& u, int wr, int wc, int fr_, int fq_) const {
        int fr = fr_, fq = fq_; asm volatile("" : "+v"(fr), "+v"(fq));
        const int lrow0 = u.pm * 256 + wr * 64 + fr, cw = wc * 32 + 8 * fq;
#pragma unroll
        for (int ai = 0; ai < 2; ++ai)
#pragma unroll
            for (int m = 0; m < 4; ++m) { asm volatile("" ::: "memory");
                const int grow = grow0 + lrow0 + ai * 128 + m * 16;
                float sq = 0.f;
#pragma unroll
                for (int bj = 0; bj < 2; ++bj) {
                    const size_t off = (size_t)grow * DM + u.pn * 256 + bj * 128 + cw;
                    const pg8::f32x4 a = *(const pg8::f32x4*)(xin + off) + acc[ai][bj][m][0], b = *(const pg8::f32x4*)(xin + off + 4) + acc[ai][bj][m][1];
                    *(pg8::f32x4*)(xout + off) = a; *(pg8::f32x4*)(xout + off + 4) = b;
                    float v[8] = {a[0], a[1], a[2], a[3], b[0], b[1], b[2], b[3]};
#pragma unroll
                    for (int j = 0; j < 8; ++j) sq += v[j] * v[j];
                    *(u32x4*)(XB + off) = pack8(v);
                }
                sq += __shfl_xor(sq, 16); sq += __shfl_xor(sq, 32);
                if (fq == 0) ssq_add(ssq_next + grow, sq);
            }
    }
};
struct EpiUp {
    static constexpr bool PERM = true;
    const u64* ssq; int grow0; bf16_t* H;
    __device__ __forceinline__ bool keep(const Unit&) const { return false; }
    __device__ __forceinline__ void operator()(pg8::f32x4 (&acc)[2][2][4][2], const Unit& u, int wr, int wc, int fr_, int fq_) const {
        int fr = fr_, fq = fq_; asm volatile("" : "+v"(fr), "+v"(fq));
        const int lrow0 = u.pm * 256 + wr * 64 + fr, cw = wc * 32 + 8 * fq;
#pragma unroll
        for (int ai = 0; ai < 2; ++ai)
#pragma unroll
            for (int m = 0; m < 4; ++m) { asm volatile("" ::: "memory");
                const int lrow = lrow0 + ai * 128 + m * 16;
                const float rs = rsqrtf(ssq_get(ssq + grow0 + lrow) * (1.f / 1024.f) + EPS);
#pragma unroll
                for (int bj = 0; bj < 2; ++bj) {
                    float v[8];
#pragma unroll
                    for (int j = 0; j < 4; ++j) { v[j] = acc[ai][bj][m][0][j] * rs; v[4 + j] = acc[ai][bj][m][1][j] * rs; }
#pragma unroll
                    for (int j = 0; j < 8; ++j) { const float r = fmaxf(v[j], 0.f); v[j] = r * r; }
                    *(u32x4*)(H + (size_t)lrow * DFF + u.pn * 256 + bj * 128 + cw) = pack8(v);
                }
            }
    }
};

namespace att {
typedef short bf16x8 __attribute__((ext_vector_type(8)));
typedef short s16x4 __attribute__((ext_vector_type(4)));
typedef float f32x16 __attribute__((ext_vector_type(16)));
typedef unsigned u32x4 __attribute__((ext_vector_type(4)));
constexpr int KP96 = 208, KP64 = 144, VP = 192;
constexpr int TK = 128;
constexpr int KBUF = TK * KP96, VBUF = TK * VP;
constexpr int OFF_K0 = 0, OFF_K1 = KBUF, OFF_V0 = 2 * KBUF, OFF_V1 = 2 * KBUF + VBUF, OFF_FLAG = 2 * KBUF + 2 * VBUF, ATT_LDS = OFF_FLAG + 64;
static_assert(ATT_LDS <= RING_BYTES, "attention LDS");
__device__ __forceinline__ int crow(int r, int h) { return (r & 3) + 8 * (r >> 2) + 4 * h; }
__device__ __forceinline__ s16x4 tr16(const LAS unsigned char* p) { typedef short v4i16_t __attribute__((ext_vector_type(4))); return __builtin_bit_cast(s16x4, __builtin_amdgcn_ds_read_tr16_b64_v4i16((LAS v4i16_t*)p)); }
__device__ __forceinline__ bf16x8 pack8s(const f32x16& p, int s) {
    u32x4 w; w.x = pg8::cvt_pk_bf16(p[8 * s + 0], p[8 * s + 1]); w.y = pg8::cvt_pk_bf16(p[8 * s + 2], p[8 * s + 3]); w.z = pg8::cvt_pk_bf16(p[8 * s + 4], p[8 * s + 5]); w.w = pg8::cvt_pk_bf16(p[8 * s + 6], p[8 * s + 7]);
    return __builtin_bit_cast(bf16x8, w);
}
template <int NKS> __device__ __forceinline__ f32x16 qk_block(const LAS unsigned char* krows, int pitch, const bf16x8 (&qf)[NKS], int r32, int hh) {
    f32x16 p;
#pragma unroll
    for (int i = 0; i < 16; ++i) p[i] = 0.f;
    const LAS unsigned char* kp = krows + r32 * pitch + hh * 16;
#pragma unroll
    for (int ks = 0; ks < NKS; ++ks) { const bf16x8 kf = *(const LAS bf16x8*)(kp + ks * 32); p = __builtin_amdgcn_mfma_f32_32x32x16_bf16(kf, qf[ks], p, 0, 0, 0); }
    return p;
}
__device__ __forceinline__ void pv_block(f32x16 (&o)[2], const LAS unsigned char* vrows, bf16x8 pb0, bf16x8 pb1, int lane) {
    const int hh = lane >> 5, g1 = (lane >> 4) & 1, q4 = (lane >> 2) & 3, p = lane & 3;
    const LAS unsigned char* base = vrows + (4 * hh + q4) * VP + (16 * g1 + 4 * p) * 2;
#pragma unroll
    for (int db = 0; db < 2; ++db)
#pragma unroll
        for (int s = 0; s < 2; ++s) {
            const s16x4 lo = tr16(base + (16 * s) * VP + db * 64), hi = tr16(base + (16 * s + 8) * VP + db * 64);
            const bf16x8 vf = {lo[0], lo[1], lo[2], lo[3], hi[0], hi[1], hi[2], hi[3]};
            o[db] = __builtin_amdgcn_mfma_f32_32x32x16_bf16(vf, s == 0 ? pb0 : pb1, o[db], 0, 0, 0);
        }
}
__device__ __forceinline__ void store_ot(bf16* dst, const f32x16 (&o)[2], float sc, int hh) {
#pragma unroll
    for (int db = 0; db < 2; ++db)
#pragma unroll
        for (int g = 0; g < 4; ++g) {
            pg8::u32x2 w; w.x = pg8::cvt_pk_bf16(o[db][4 * g] * sc, o[db][4 * g + 1] * sc); w.y = pg8::cvt_pk_bf16(o[db][4 * g + 2] * sc, o[db][4 * g + 3] * sc);
            *(GAS pg8::u32x2*)(dst + db * 32 + 8 * g + 4 * hh) = w;
        }
}
}

__device__ __forceinline__ void mla_unit(Frame& F, int bh, int qb) {
    using namespace att;
    const bf16* QM = (const bf16*)(F.ws + WS_QM); const bf16* KVM = (const bf16*)(F.ws + WS_KVM); const bf16* C = (const bf16*)(F.ws + WS_C); bf16* Y = (bf16*)(F.ws + WS_Y);
    const int b = bh >> 3, h = bh & 7, q0 = qb * 256, w = F.wave, lane = F.lane, r32 = lane & 31, hh = lane >> 5, tid = F.tid;
    const int qmin = q0 + 32 * w, qg = qmin + r32;
    const size_t rowb = (size_t)b * SEQ;
    bf16x8 qf[6];
#pragma unroll
    for (int ks = 0; ks < 6; ++ks) qf[ks] = *(const GAS bf16x8*)(QM + (rowb + qg) * NQ + h * 96 + ks * 16 + hh * 8);
    float m = -INFINITY, l = 0.f; f32x16 o[2];
#pragma unroll
    for (int i = 0; i < 16; ++i) { o[0][i] = 0.f; o[1][i] = 0.f; }
    const int NT = 2 * qb + 2;
    const int kr0 = tid >> 3, kc0 = tid & 7, rr = tid >> 2, rc = tid & 3;
    const bf16* gkn = KVM + (rowb + kr0) * NKV + h * 128 + kc0 * 8;
    const bf16* gkr = C + (rowb + rr) * NC + 640 + rc * 8;
    const int lk0 = kr0 * KP96 + kc0 * 16, lkr = rr * KP96 + 128 + rc * 16, lv0 = kr0 * VP + kc0 * 16;
    v4u R0, R1, R2, R3, R4;
#define MLA_LOAD(j) do { const size_t o_ = (size_t)(j) * TK; R0 = *(const GAS v4u*)(gkn + o_ * NKV); R1 = *(const GAS v4u*)(gkn + (o_ + 64) * NKV); R2 = *(const GAS v4u*)(gkr + o_ * NC); \
        R3 = *(const GAS v4u*)(gkn + o_ * NKV + 64); R4 = *(const GAS v4u*)(gkn + (o_ + 64) * NKV + 64); } while (0)
#define MLA_STORE(kb, vb) do { *(LAS v4u*)(F.lds + (kb) + lk0) = R0; *(LAS v4u*)(F.lds + (kb) + lk0 + 64 * KP96) = R1; *(LAS v4u*)(F.lds + (kb) + lkr) = R2; \
        *(LAS v4u*)(F.lds + (vb) + lv0) = R3; *(LAS v4u*)(F.lds + (vb) + lv0 + 64 * VP) = R4; } while (0)
    MLA_LOAD(0); MLA_STORE(OFF_K0, OFF_V0);
    __syncthreads();
    for (int j = 0; j < NT; ++j) {
        const int kb = (j & 1) ? OFF_K1 : OFF_K0, vb = (j & 1) ? OFF_V1 : OFF_V0;
        if (j + 1 < NT) MLA_LOAD(j + 1);
#pragma unroll
        for (int sub = 0; sub < 2; ++sub) {
            const int base = j * TK + sub * 64;
            if (base <= qmin + 31) {
                const LAS unsigned char* Kb = F.lds + kb + sub * 64 * KP96; const LAS unsigned char* Vb = F.lds + vb + sub * 64 * VP;
                f32x16 p0 = qk_block<6>(Kb, KP96, qf, r32, hh), p1 = qk_block<6>(Kb + 32 * KP96, KP96, qf, r32, hh);
                if (base + 63 > qmin) {
#pragma unroll
                    for (int r = 0; r < 16; ++r) { const int key = base + crow(r, hh); if (key > qg) p0[r] = -INFINITY; if (key + 32 > qg) p1[r] = -INFINITY; }
                }
                float mx = fmaxf(p0[0], p1[0]);
#pragma unroll
                for (int r = 1; r < 16; ++r) mx = fmaxf(mx, fmaxf(p0[r], p1[r]));
                mx = fmaxf(mx, __shfl_xor(mx, 32));
                const float mn = fmaxf(m, mx), al = __builtin_amdgcn_exp2f(m - mn);
                m = mn;
                float sum = 0.f;
#pragma unroll
                for (int r = 0; r < 16; ++r) { p0[r] = __builtin_amdgcn_exp2f(p0[r] - mn); p1[r] = __builtin_amdgcn_exp2f(p1[r] - mn); sum += p0[r] + p1[r]; }
                sum += __shfl_xor(sum, 32);
                l = l * al + sum;
#pragma unroll
                for (int r = 0; r < 16; ++r) { o[0][r] *= al; o[1][r] *= al; }
                pv_block(o, Vb, pack8s(p0, 0), pack8s(p0, 1), lane);
                pv_block(o, Vb + 32 * VP, pack8s(p1, 0), pack8s(p1, 1), lane);
            }
        }
        if (j + 1 < NT) { if (j & 1) MLA_STORE(OFF_K0, OFF_V0); else MLA_STORE(OFF_K1, OFF_V1); }
        __syncthreads();
    }
#undef MLA_LOAD
#undef MLA_STORE
    store_ot(Y + (rowb + qg) * 1536 + h * 64, o, 1.f / l, hh);
}
__device__ __forceinline__ void mla_phase(Frame& F) {
    const int vcu = (F.G % 8 == 0) ? (int)(blockIdx.x % 8) * (F.G / 8) + (int)blockIdx.x / 8 : (int)blockIdx.x;
    for (int u = vcu; u < BH * NHEAD * 8; u += F.G) {
        const int bh = u >> 3, s = u & 7;
        mla_unit(F, bh, 15 - s);
        mla_unit(F, bh, s);
    }
}

__device__ __forceinline__ void sb_block(att::f32x16& z, float& run, int kbase, int t, bool masked, int hh) {
    using namespace att;
    constexpr float L2E = 1.4426950408889634f, LN2 = 0.6931471805599453f;
    float ln[16];
#pragma unroll
    for (int r = 0; r < 16; ++r) {
        const float zz = z[r];
        const float sp = fmaxf(zz, 0.f) + LN2 * __builtin_amdgcn_logf(1.f + __builtin_amdgcn_exp2f(-fabsf(zz) * L2E));
        const bool valid = !masked || (kbase + crow(r, hh) < t);
        ln[r] = valid ? -sp : 0.f;
    }
    float Gs[4], Go[4];
#pragma unroll
    for (int g = 0; g < 4; ++g) { Gs[g] = (ln[4 * g] + ln[4 * g + 1]) + (ln[4 * g + 2] + ln[4 * g + 3]); Go[g] = __shfl_xor(Gs[g], 32); }
    float T = 0.f;
#pragma unroll
    for (int g = 3; g >= 0; --g) {
        const float bb = run + T + (hh == 0 ? Go[g] : 0.f);
        float c = 0.f;
#pragma unroll
        for (int i = 3; i >= 0; --i) { const int r = 4 * g + i;
            const bool valid = !masked || (kbase + crow(r, hh) < t);
            const float a = __builtin_amdgcn_exp2f((z[r] + ln[r] + bb + c) * L2E);
            c += ln[r]; z[r] = valid ? a : 0.f; }
        T += Gs[g] + Go[g];
    }
    run += T;
}
__device__ __forceinline__ void sb_unit(Frame& F, int bh, int qb) {
    using namespace att;
    bf16* Y = (bf16*)(F.ws + WS_Y); const bf16* SK = (const bf16*)(F.ws + WS_SBK); const bf16* SV = (const bf16*)(F.ws + WS_SBV);
    const int b = bh >> 3, h = bh & 7, q0 = qb * 256, w = F.wave, lane = F.lane, r32 = lane & 31, hh = lane >> 5, tid = F.tid;
    const int qmin = q0 + 32 * w, qg = qmin + r32;
    const size_t rowb = (size_t)b * SEQ;
    bf16x8 qf[4];
#pragma unroll
    for (int ks = 0; ks < 4; ++ks) qf[ks] = *(const GAS bf16x8*)(Y + (rowb + qg) * 1536 + 512 + h * 64 + ks * 16 + hh * 8);
    float run = 0.f; f32x16 o[2];
#pragma unroll
    for (int i = 0; i < 16; ++i) { o[0][i] = 0.f; o[1][i] = 0.f; }
    volatile LAS unsigned* fl = (volatile LAS unsigned*)(F.lds + OFF_FLAG);
    if (tid < 3) fl[tid] = 0u;
    const int kr0 = tid >> 3, kc0 = tid & 7;
    const bf16* gk = SK + (rowb + kr0) * 512 + h * 64 + kc0 * 8; const bf16* gv = SV + (rowb + kr0) * 512 + h * 64 + kc0 * 8;
    const int lk0 = kr0 * KP64 + kc0 * 16, lv0 = kr0 * VP + kc0 * 16;
    v4u R0, R1, R2, R3;
#define SB_LOAD(j) do { const size_t o_ = (size_t)(j) * TK * 512; R0 = *(const GAS v4u*)(gk + o_); R1 = *(const GAS v4u*)(gk + o_ + 64 * 512); R2 = *(const GAS v4u*)(gv + o_); R3 = *(const GAS v4u*)(gv + o_ + 64 * 512); } while (0)
#define SB_STORE(kb, vb) do { *(LAS v4u*)(F.lds + (kb) + lk0) = R0; *(LAS v4u*)(F.lds + (kb) + lk0 + 64 * KP64) = R1; *(LAS v4u*)(F.lds + (vb) + lv0) = R2; *(LAS v4u*)(F.lds + (vb) + lv0 + 64 * VP) = R3; } while (0)
    const int jtop = 2 * qb + 1;
    SB_LOAD(jtop); SB_STORE(OFF_K0, OFF_V0);
    __syncthreads();
    int it = 0;
    for (int j = jtop; j >= 0; --j, ++it) {
        const int kb = (it & 1) ? OFF_K1 : OFF_K0, vb = (it & 1) ? OFF_V1 : OFF_V0;
        if (j > 0) SB_LOAD(j - 1);
        if (tid == 0) fl[(it + 1) % 3] = 0u;
        if (__ballot(run >= -105.f) != 0ull) {
#pragma unroll
            for (int sub = 1; sub >= 0; --sub) {
                const int base = j * TK + sub * 64;
                if (base < qmin + 31) {
                    const LAS unsigned char* Kb = F.lds + kb + sub * 64 * KP64; const LAS unsigned char* Vb = F.lds + vb + sub * 64 * VP;
                    f32x16 p0 = qk_block<4>(Kb, KP64, qf, r32, hh), p1 = qk_block<4>(Kb + 32 * KP64, KP64, qf, r32, hh);
                    const bool masked = (base + 63 >= qmin);
                    sb_block(p1, run, base + 32, qg, masked, hh);
                    sb_block(p0, run, base, qg, masked, hh);
                    pv_block(o, Vb, pack8s(p0, 0), pack8s(p0, 1), lane);
                    pv_block(o, Vb + 32 * VP, pack8s(p1, 0), pack8s(p1, 1), lane);
                }
            }
        }
        if (__ballot(run >= -105.f) != 0ull && lane == 0) fl[it % 3] = 1u;
        if (j > 0) { if (it & 1) SB_STORE(OFF_K0, OFF_V0); else SB_STORE(OFF_K1, OFF_V1); }
        __syncthreads();
        if (fl[it % 3] == 0u) break;
    }
#undef SB_LOAD
#undef SB_STORE
    __syncthreads();
    store_ot(Y + (rowb + qg) * 1536 + 512 + h * 64, o, 1.f, hh);
}
__device__ __forceinline__ void sb_phase(Frame& F) {
    const int vcu = (F.G % 8 == 0) ? (int)(blockIdx.x % 8) * (F.G / 8) + (int)blockIdx.x / 8 : (int)blockIdx.x;
    for (int u = vcu; u < BH * NHEAD * 8; u += F.G) { const int bh = u >> 3, s = u & 7; sb_unit(F, bh, 15 - s); sb_unit(F, bh, s); }
}

__device__ __forceinline__ float log2_gamma(int h) {
    return h == 0 ? -4.5803689613e-02f : h == 1 ? -2.2720076500e-02f : h == 2 ? -1.1315313228e-02f : h == 3 ? -5.6465631411e-03f : h == 4 ? -2.8205190624e-03f : h == 5 ? -1.4095702547e-03f : h == 6 ? -7.0461297659e-04f : -3.5226347163e-04f;
}
constexpr size_t WS_KVS = WS_RST, WS_PREV = WS_RST + 16 * MiB;
__device__ __forceinline__ void ret_stage(Frame& F, const bf16* RK, const bf16* RV, size_t row0, int h, float lg2, int kp, int voff) {
    using namespace att;
    const int tid = F.tid, r0 = tid >> 3, ch = tid & 7;
    v4u Rk[4], Rv[4];
#pragma unroll
    for (int i = 0; i < 4; ++i) { const size_t go = (row0 + r0 + 64 * i) * 512 + h * 64 + ch * 8; Rk[i] = *(const GAS v4u*)(RK + go); Rv[i] = *(const GAS v4u*)(RV + go); }
#pragma unroll
    for (int i = 0; i < 4; ++i) { const int row = r0 + 64 * i; const float z = __builtin_amdgcn_exp2f((float)(127 - (row & 127)) * lg2);
        v4u k; k.x = pg8::cvt_pk_bf16(bflo(Rk[i].x) * z, bfhi(Rk[i].x) * z); k.y = pg8::cvt_pk_bf16(bflo(Rk[i].y) * z, bfhi(Rk[i].y) * z);
        k.z = pg8::cvt_pk_bf16(bflo(Rk[i].z) * z, bfhi(Rk[i].z) * z); k.w = pg8::cvt_pk_bf16(bflo(Rk[i].w) * z, bfhi(Rk[i].w) * z);
        *(LAS v4u*)(F.lds + row * kp + ch * 16) = k; *(LAS v4u*)(F.lds + voff + row * VP + ch * 16) = Rv[i]; }
}
__device__ __forceinline__ void ret_r1_phase(Frame& F) {
    using namespace att;
    const bf16* RK = (const bf16*)(F.ws + WS_RK); const bf16* RV = (const bf16*)(F.ws + WS_RV); float* KVS = (float*)(F.ws + WS_KVS);
    const int lane = F.lane, w = F.wave, r32 = lane & 31, hh = lane >> 5, g1 = (lane >> 4) & 1, q4 = (lane >> 2) & 3, p4 = lane & 3;
    constexpr int VOFF = 256 * VP;
    for (int u = blockIdx.x; u < BH * NHEAD * 16; u += F.G) {
        const int bh = u >> 4, cp = u & 15, b = bh >> 3, h = bh & 7;
        ret_stage(F, RK, RV, (size_t)b * SEQ + cp * 256, h, log2_gamma(h), VP, VOFF);
        __syncthreads();
        const int c2 = w >> 2, eb = (w >> 1) & 1, db = w & 1;
        f32x16 acc;
#pragma unroll
        for (int i = 0; i < 16; ++i) acc[i] = 0.f;
        const LAS unsigned char* vb = F.lds + VOFF + (c2 * 128 + 8 * hh + q4) * VP + (eb * 32 + 16 * g1 + 4 * p4) * 2;
        const LAS unsigned char* kb = F.lds + (c2 * 128 + 8 * hh + q4) * VP + (db * 32 + 16 * g1 + 4 * p4) * 2;
#pragma unroll
        for (int ks = 0; ks < 8; ++ks) {
            const s16x4 al = tr16(vb + ks * 16 * VP), ah = tr16(vb + (ks * 16 + 4) * VP), bl = tr16(kb + ks * 16 * VP), bhi = tr16(kb + (ks * 16 + 4) * VP);
            const bf16x8 af = {al[0], al[1], al[2], al[3], ah[0], ah[1], ah[2], ah[3]}, bf = {bl[0], bl[1], bl[2], bl[3], bhi[0], bhi[1], bhi[2], bhi[3]};
            acc = __builtin_amdgcn_mfma_f32_32x32x16_bf16(af, bf, acc, 0, 0, 0);
        }
        float* dst = KVS + ((size_t)(bh * 32 + 2 * cp + c2) * 64 + eb * 32) * 64 + db * 32 + r32;
#pragma unroll
        for (int r = 0; r < 16; ++r) dst[crow(r, hh) * 64] = acc[r];
        __syncthreads();
    }
}
__device__ __forceinline__ void ret_scan_phase(Frame& F) {
    const float* KVS = (const float*)(F.ws + WS_KVS); bf16* PREV = (bf16*)(F.ws + WS_PREV);
    for (int idx = blockIdx.x * NTHR + F.tid; idx < BH * NHEAD * 4096; idx += F.G * NTHR) {
        const int bh = idx >> 12, ed = idx & 4095;
        const float dec = __builtin_amdgcn_exp2f(128.f * log2_gamma(bh & 7));
        float S = 0.f;
        for (int n = 0; n < 32; ++n) { const size_t o = ((size_t)(bh * 32 + n) << 12) + ed; PREV[o] = (bf16)f2bf(S); S = S * dec + KVS[o]; }
    }
}
__device__ __forceinline__ void ret_r3_phase(Frame& F, const float* gn) {
    using namespace att;
    const bf16* RK = (const bf16*)(F.ws + WS_RK); const bf16* RV = (const bf16*)(F.ws + WS_RV); const bf16* RG = (const bf16*)(F.ws + WS_RG); bf16* Y = (bf16*)(F.ws + WS_Y);
    const bf16* PREV = (const bf16*)(F.ws + WS_PREV);
    const int lane = F.lane, w = F.wave, r32 = lane & 31, hh = lane >> 5;
    constexpr int VOFF = 40960;
    for (int u = blockIdx.x; u < BH * NHEAD * 16; u += F.G) {
        const int bh = u >> 4, cp = u & 15, b = bh >> 3, h = bh & 7;
        const float lg2 = log2_gamma(h);
        const size_t row0 = (size_t)b * SEQ + cp * 256;
        const int c2 = w >> 2, wq = w & 3, it = 32 * wq + r32;
        const size_t trow = row0 + c2 * 128 + it;
        bf16x8 qf[4];
#pragma unroll
        for (int ks = 0; ks < 4; ++ks) qf[ks] = *(const GAS bf16x8*)(Y + trow * 1536 + 1024 + h * 64 + ks * 16 + hh * 8);
        ret_stage(F, RK, RV, row0, h, lg2, KP64, VOFF);
        __syncthreads();
        f32x16 o[2];
#pragma unroll
        for (int i = 0; i < 16; ++i) { o[0][i] = 0.f; o[1][i] = 0.f; }
        const float xi = __builtin_amdgcn_exp2f((float)(it - 127) * lg2);
        for (int kb = 0; kb <= wq; ++kb) {
            f32x16 p = qk_block<4>(F.lds + (c2 * 128 + kb * 32) * KP64, KP64, qf, r32, hh);
#pragma unroll
            for (int r = 0; r < 16; ++r) { const int is = kb * 32 + crow(r, hh); p[r] = (is <= it) ? p[r] * xi : 0.f; }
            pv_block(o, F.lds + VOFF + (c2 * 128 + kb * 32) * VP, pack8s(p, 0), pack8s(p, 1), lane);
        }
        { const bf16* pv = PREV + ((size_t)(bh * 32 + 2 * cp + c2) << 12) + r32 * 64 + hh * 8;
          const float xc = __builtin_amdgcn_exp2f((float)(it + 1) * lg2);
#pragma unroll
          for (int eb = 0; eb < 2; ++eb) { f32x16 oc;
#pragma unroll
              for (int i = 0; i < 16; ++i) oc[i] = 0.f;
#pragma unroll
              for (int ks = 0; ks < 4; ++ks) { const bf16x8 af = *(const GAS bf16x8*)(pv + eb * 32 * 64 + ks * 16); oc = __builtin_amdgcn_mfma_f32_32x32x16_bf16(af, qf[ks], oc, 0, 0, 0); }
#pragma unroll
              for (int i = 0; i < 16; ++i) o[eb][i] += oc[i] * xc; } }
        float s1 = 0.f;
#pragma unroll
        for (int i = 0; i < 16; ++i) s1 += o[0][i] + o[1][i];
        s1 += __shfl_xor(s1, 32);
        const float mu = s1 * (1.f / 64.f); float s2 = 0.f;
#pragma unroll
        for (int i = 0; i < 16; ++i) { o[0][i] -= mu; o[1][i] -= mu; s2 += o[0][i] * o[0][i] + o[1][i] * o[1][i]; }
        s2 += __shfl_xor(s2, 32);
        const float rstd = rsqrtf(s2 * (1.f / 64.f) + EPS);
#pragma unroll
        for (int eb = 0; eb < 2; ++eb)
#pragma unroll
            for (int g = 0; g < 4; ++g) { const int e = eb * 32 + 8 * g + 4 * hh;
                const f32x4 gv = *(const f32x4*)(gn + h * 64 + e); const pg8::u32x2 rg = *(const GAS pg8::u32x2*)(RG + trow * 512 + h * 64 + e);
                pg8::u32x2 wv; wv.x = pg8::cvt_pk_bf16(o[eb][4 * g] * rstd * gv[0] * bflo(rg.x), o[eb][4 * g + 1] * rstd * gv[1] * bfhi(rg.x));
                wv.y = pg8::cvt_pk_bf16(o[eb][4 * g + 2] * rstd * gv[2] * bflo(rg.y), o[eb][4 * g + 3] * rstd * gv[3] * bfhi(rg.y));
                *(GAS pg8::u32x2*)(Y + trow * 1536 + 1024 + h * 64 + e) = wv; }
        __syncthreads();
    }
}

__device__ __forceinline__ void prologue_phase(Frame& F, const float* x, const int* pos, float* cosR, float* sinR, float* cosM, float* sinM, bf16* XB, u64* ssq0) {
    const int gt = blockIdx.x * NTHR + F.tid, NT = F.G * NTHR;
    for (int idx = gt; idx < MTOT * 32; idx += NT) {
        const int row = idx >> 5, i = idx & 31;
        const double inv = exp2(-(double)i * (13.287712379549449 / 32.0));
        const double ang = (double)pos[row] * inv;
        double s, c; sincos(ang, &s, &c);
        cosR[idx] = (float)c; sinR[idx] = (float)s;
        if ((i & 1) == 0) { cosM[row * 16 + (i >> 1)] = (float)c; sinM[row * 16 + (i >> 1)] = (float)s; }
    }
    const int gw = blockIdx.x * NWAVES + F.wave, NGW = F.G * NWAVES;
    for (int m = gw; m < MTOT; m += NGW) {
        const GAS f32x4* xr = (const GAS f32x4*)(x + (size_t)m * DM) + F.lane;
        f32x4 v[4]; float s = 0.f;
#pragma unroll
        for (int j = 0; j < 4; ++j) { v[j] = xr[64 * j]; s += (v[j].x * v[j].x + v[j].y * v[j].y) + (v[j].z * v[j].z + v[j].w * v[j].w); }
        s = wave_sum(s);
        GAS unsigned long long* o8 = (GAS unsigned long long*)(XB + (size_t)m * DM) + F.lane;
#pragma unroll
        for (int j = 0; j < 4; ++j) o8[64 * j] = (unsigned long long)pk2(v[j].x, v[j].y) | ((unsigned long long)pk2(v[j].z, v[j].w) << 32);
        if (F.lane == 0) ssq0[m] = (u64)(s * 16777216.f + 0.5f);
    }
}
__device__ __forceinline__ void final_phase(Frame& F, float* xo, const u64* ssq, const float* g) {
    const int gw = blockIdx.x * NWAVES + F.wave, NGW = F.G * NWAVES;
    for (int m = gw; m < MTOT; m += NGW) {
        const float rs = rsqrtf((float)__hip_atomic_load(ssq + m, RLX_AGENT) * (1.f / 16777216.f) * (1.f / 1024.f) + EPS);
        GAS f32x4* xr = (GAS f32x4*)(xo + (size_t)m * DM) + F.lane;
#pragma unroll
        for (int j = 0; j < 4; ++j) { const f32x4 gv = *((const f32x4*)g + F.lane + 64 * j); f32x4 v = xr[64 * j]; v = v * rs * gv; xr[64 * j] = v; }
    }
}
__device__ __forceinline__ void convert_phase(Frame& F, const Args& a, int l) {
    LAS float* scr = (LAS float*)(F.lds + RING_OFF + F.wave * 16384);
    unsigned char* W = F.ws + WS_W;
    const float* g_mix = (const float*)a.in[2] + (size_t)l * DM;
    const float* w_in = (const float*)a.in[3] + (size_t)l * DM * D_IN;
    const float* g_q = (const float*)a.in[4] + (size_t)l * 384;
    const float* w_uq = (const float*)a.in[5] + (size_t)l * 384 * NQ;
    const float* g_kv = (const float*)a.in[6] + (size_t)l * 256;
    const float* w_ukv = (const float*)a.in[7] + (size_t)l * 256 * NKV;
    const float* w_br = (const float*)a.in[9] + (size_t)l * 3 * 512 * DM;
    const float* w_out = (const float*)a.in[10] + (size_t)l * DM * DM;
    const float* g_mlp = (const float*)a.in[11] + (size_t)l * DM;
    const float* w_up = (const float*)a.in[12] + (size_t)l * DM * DFF;
    const float* w_dn = (const float*)a.in[13] + (size_t)l * DFF * DM;
    constexpr int I_IN = (DM / 64) * (NIN / 32), I_UQ = (384 / 64) * (NQ / 32), I_UKV = (256 / 64) * (NKV / 32), I_B = (512 / 64) * (DM / 32), I_OUT = (DM / 64) * (DM / 32),
                  I_UP = (DM / 64) * (DFF / 32), I_DN = (DFF / 64) * (DM / 32);
    constexpr int NITEMS = I_IN + I_UQ + I_UKV + 3 * I_B + I_OUT + I_UP + I_DN;
    const int gw = blockIdx.x * NWAVES + F.wave, NGW = F.G * NWAVES;
    for (int it = gw; it < NITEMS; it += NGW) {
        int r = it;
        if (r < I_IN) { transpose_item<1>(w_in, D_IN, NIN, g_mix, (bf16*)(W + W_IN), DM, 0, scr, r, F.lane); continue; } r -= I_IN;
        if (r < I_UQ) { transpose_item<2>(w_uq, NQ, NQ, g_q, (bf16*)(W + W_UQ), 384, 0, scr, r, F.lane); continue; } r -= I_UQ;
        if (r < I_UKV) { transpose_item<0>(w_ukv, NKV, NKV, g_kv, (bf16*)(W + W_UKV), 256, 0, scr, r, F.lane); continue; } r -= I_UKV;
        if (r < 3 * I_B) { const int s = r / I_B; transpose_item<0>(w_br + (size_t)s * 512 * DM, DM, DM, nullptr, (bf16*)(W + W_B), 1536, s * 512, scr, r % I_B, F.lane); continue; } r -= 3 * I_B;
        if (r < I_OUT) { transpose_item<0>(w_out, DM, DM, nullptr, (bf16*)(W + W_OUT), DM, 0, scr, r, F.lane); continue; } r -= I_OUT;
        if (r < I_UP) { transpose_item<0>(w_up, DFF, DFF, g_mlp, (bf16*)(W + W_UP), DM, 0, scr, r, F.lane); continue; } r -= I_UP;
        transpose_item<0>(w_dn, DM, DM, nullptr, (bf16*)(W + W_DN), DFF, 0, scr, r, F.lane);
    }
}

__device__ __forceinline__ void ld8(const bf16* p, float* f) { const v4u w = *(const GAS v4u*)p; f[0] = bflo(w.x); f[1] = bfhi(w.x); f[2] = bflo(w.y); f[3] = bfhi(w.y); f[4] = bflo(w.z); f[5] = bfhi(w.z); f[6] = bflo(w.w); f[7] = bfhi(w.w); }
__device__ __forceinline__ void st8(bf16* p, const float* f) { v4u w; w.x = pk2(f[0], f[1]); w.y = pk2(f[2], f[3]); w.z = pk2(f[4], f[5]); w.w = pk2(f[6], f[7]); *(GAS v4u*)p = w; }
__device__ __forceinline__ void item_bht(int it, int& bh, int& t) { bh = it >> 12; const int r = it & 4095; t = (r & 511) * 8 + (r >> 9); }

__device__ __forceinline__ void naive_mla(Frame& F) {
    const bf16* QM = (const bf16*)(F.ws + WS_QM); const bf16* KVM = (const bf16*)(F.ws + WS_KVM); const bf16* C = (const bf16*)(F.ws + WS_C); bf16* Y = (bf16*)(F.ws + WS_Y);
    const int vz = vzero();
    for (int it = blockIdx.x * NTHR + F.tid; it < BH * NHEAD * SEQ; it += F.G * NTHR) {
        int bh, t; item_bht(it, bh, t); const int b = bh >> 3, h = bh & 7; const size_t lrow = (size_t)b * SEQ + t;
        float q[96];
#pragma unroll
        for (int j = 0; j < 12; ++j) ld8(QM + lrow * NQ + h * 96 + 8 * j, q + 8 * j);
        float m = -INFINITY, l = 0.f, acc[64];
#pragma unroll
        for (int e = 0; e < 64; ++e) acc[e] = 0.f;
        for (int s = 0; s <= t; ++s) {
            const size_t krow = (size_t)b * SEQ + s + vz;
            const bf16* kn = KVM + krow * NKV + h * 128; const bf16* kr = C + krow * NC + 640;
            float z = 0.f, k[8];
#pragma unroll
            for (int j = 0; j < 8; ++j) { ld8(kn + 8 * j, k);
#pragma unroll
                for (int i = 0; i < 8; ++i) z += q[8 * j + i] * k[i]; }
#pragma unroll
            for (int j = 0; j < 4; ++j) { ld8(kr + 8 * j, k);
#pragma unroll
                for (int i = 0; i < 8; ++i) z += q[64 + 8 * j + i] * k[i]; }
            if (z > m) { const float al = exp2f(m - z); l *= al;
#pragma unroll
                for (int e = 0; e < 64; ++e) acc[e] *= al;
                m = z; }
            const float p = exp2f(z - m); l += p;
#pragma unroll
            for (int j = 0; j < 8; ++j) { ld8(kn + 64 + 8 * j, k);
#pragma unroll
                for (int i = 0; i < 8; ++i) acc[8 * j + i] += p * k[i]; }
        }
        const float il = 1.f / l;
#pragma unroll
        for (int e = 0; e < 64; ++e) acc[e] *= il;
#pragma unroll
        for (int j = 0; j < 8; ++j) st8(Y + lrow * 1536 + h * 64 + 8 * j, acc + 8 * j);
    }
}
__device__ __forceinline__ void naive_sb(Frame& F) {
    bf16* Y = (bf16*)(F.ws + WS_Y); const bf16* SK = (const bf16*)(F.ws + WS_SBK); const bf16* SV = (const bf16*)(F.ws + WS_SBV);
    const int vz = vzero();
    for (int it = blockIdx.x * NTHR + F.tid; it < BH * NHEAD * SEQ; it += F.G * NTHR) {
        int bh, t; item_bht(it, bh, t); const int b = bh >> 3, h = bh & 7; const size_t lrow = (size_t)b * SEQ + t;
        float q[64];
#pragma unroll
        for (int j = 0; j < 8; ++j) ld8(Y + lrow * 1536 + 512 + h * 64 + 8 * j, q + 8 * j);
        float run = 0.f, acc[64];
#pragma unroll
        for (int e = 0; e < 64; ++e) acc[e] = 0.f;
        for (int s = t - 1; s >= 0; --s) {
            const size_t krow = (size_t)b * SEQ + s + vz;
            const bf16* kp = SK + krow * 512 + h * 64; const bf16* vp = SV + krow * 512 + h * 64;
            float z = 0.f, k[8];
#pragma unroll
            for (int j = 0; j < 8; ++j) { ld8(kp + 8 * j, k);
#pragma unroll
                for (int i = 0; i < 8; ++i) z += q[8 * j + i] * k[i]; }
            const float sp = fmaxf(z, 0.f) + log1pf(__expf(-fabsf(z)));
            const float a = __expf(z - sp + run);
#pragma unroll
            for (int j = 0; j < 8; ++j) { ld8(vp + 8 * j, k);
#pragma unroll
                for (int i = 0; i < 8; ++i) acc[8 * j + i] += a * k[i]; }
            run -= sp;
            if (run < -105.f) break;
        }
#pragma unroll
        for (int j = 0; j < 8; ++j) st8(Y + lrow * 1536 + 512 + h * 64 + 8 * j, acc + 8 * j);
    }
}
__device__ __forceinline__ void naive_ret(Frame& F, const float* gn) {
    bf16* Y = (bf16*)(F.ws + WS_Y); const bf16* RK = (const bf16*)(F.ws + WS_RK); const bf16* RV = (const bf16*)(F.ws + WS_RV); const bf16* RG = (const bf16*)(F.ws + WS_RG);
    const int vz = vzero();
    for (int it = blockIdx.x * NTHR + F.tid; it < BH * NHEAD * SEQ; it += F.G * NTHR) {
        int bh, t; item_bht(it, bh, t); const int b = bh >> 3, h = bh & 7; const size_t lrow = (size_t)b * SEQ + t;
        const float lg2 = log2_gamma(h);
        float q[64];
#pragma unroll
        for (int j = 0; j < 8; ++j) ld8(Y + lrow * 1536 + 1024 + h * 64 + 8 * j, q + 8 * j);
        float acc[64];
#pragma unroll
        for (int e = 0; e < 64; ++e) acc[e] = 0.f;
        for (int s = 0; s <= t; ++s) {
            const size_t krow = (size_t)b * SEQ + s + vz;
            const bf16* kp = RK + krow * 512 + h * 64; const bf16* vp = RV + krow * 512 + h * 64;
            float z = 0.f, k[8];
#pragma unroll
            for (int j = 0; j < 8; ++j) { ld8(kp + 8 * j, k);
#pragma unroll
                for (int i = 0; i < 8; ++i) z += q[8 * j + i] * k[i]; }
            const float a = z * exp2f((float)(t - s) * lg2);
#pragma unroll
            for (int j = 0; j < 8; ++j) { ld8(vp + 8 * j, k);
#pragma unroll
                for (int i = 0; i < 8; ++i) acc[8 * j + i] += a * k[i]; }
        }
        float mu = 0.f;
#pragma unroll
        for (int e = 0; e < 64; ++e) mu += acc[e];
        mu *= (1.f / 64.f); float var = 0.f;
#pragma unroll
        for (int e = 0; e < 64; ++e) { acc[e] -= mu; var += acc[e] * acc[e]; }
        const float rstd = rsqrtf(var * (1.f / 64.f) + EPS);
#pragma unroll
        for (int j = 0; j < 8; ++j) { float g8[8]; ld8(RG + lrow * 512 + h * 64 + 8 * j, g8);
#pragma unroll
            for (int i = 0; i < 8; ++i) acc[8 * j + i] = acc[8 * j + i] * rstd * gn[h * 64 + 8 * j + i] * g8[i];
            st8(Y + lrow * 1536 + 1024 + h * 64 + 8 * j, acc + 8 * j); }
    }
}

constexpr int N_PHASES = 1 + DEPTH * (1 + NHALF * 8) + 1;
__global__ void __launch_bounds__(NTHR, 2) fwd(Args args) {
    extern __shared__ __attribute__((aligned(16))) unsigned char lds[];
    Frame F;
    F.lds = (LAS unsigned char*)lds; F.tid = threadIdx.x; F.lane = F.tid & 63; F.wave = __builtin_amdgcn_readfirstlane(F.tid >> 6); F.G = gridDim.x; F.ws = args.ws;
    volatile LAS unsigned* MISC = (volatile LAS unsigned*)(F.lds + MISC_OFF);
    for (int u = F.tid; u < (LDS_BYTES - LDSCTL_OFF) / 4; u += NTHR) ((LAS unsigned*)(F.lds + LDSCTL_OFF))[u] = 0u;
    __syncthreads();
    const int lo = args.ph_lo, hi = args.ph_hi;
    const bool multi = (hi - lo) > 1;
    XcdBarrier bar; bar.bar = (unsigned*)(F.ws + WS_CTL) + CW_BAR; bar.x = 0; bar.st = nullptr;
    if (multi) bar = xcd_barrier_post((unsigned*)(F.ws + WS_CTL) + CW_BAR, MISC + 8);
    int ph = 0;
#define PH_BEGIN if (ph >= lo && ph < hi) { { int t_ = threadIdx.x; asm volatile("" : "+v"(t_)); F.tid = t_; F.lane = t_ & 63; }
#define PH_END   if (ph + 1 < hi) xcd_barrier(bar); } ++ph;

    unsigned char* ws = F.ws;
    u64* ssqx = (u64*)(ws + WS_SSQX);
    float* cosR = (float*)(ws + WS_COSR); float* sinR = (float*)(ws + WS_SINR); float* cosM = (float*)(ws + WS_COSM); float* sinM = (float*)(ws + WS_SINM);
    bf16* XB = (bf16*)(ws + WS_XB);
    const float* x_in = (const float*)args.in[0];

    PH_BEGIN prologue_phase(F, x_in, (const int*)args.in[1], cosR, sinR, cosM, sinM, XB, ssqx); PH_END

    for (int l = 0; l < DEPTH; ++l) {
        PH_BEGIN convert_phase(F, args, l); PH_END
        for (int hf = 0; hf < NHALF; ++hf) {
            const int grow0 = hf * MH;
            u64* ssqq = (u64*)(ws + WS_SSQQ) + (size_t)(l * 2 + hf) * MH; u64* ssqkv = (u64*)(ws + WS_SSQKV) + (size_t)(l * 2 + hf) * MH;
            PH_BEGIN {
                pg8::Gemm g{XB + (size_t)grow0 * DM, (const bf16*)(ws + WS_W + W_IN), DM, DM, DM};
                pg8::StaticOrder S; S.init(MH, NIN, F.G, (int)blockIdx.x);
                EpiIn E{ssqx + (size_t)(2 * l) * MTOT, grow0, (bf16*)(ws + WS_Y), (bf16*)(ws + WS_SBK), (bf16*)(ws + WS_SBV), (bf16*)(ws + WS_RK), (bf16*)(ws + WS_RV), (bf16*)(ws + WS_RG),
                        (bf16*)(ws + WS_GATES), (bf16*)(ws + WS_C), cosR, sinR, cosM, sinM, ssqq, ssqkv};
                pg8::gemm_phase<EpiIn, pg8::StaticOrder, true>(F.lds + RING_OFF, g, S, E);
            } PH_END
            PH_BEGIN {
                { pg8::Gemm g{(const bf16*)(ws + WS_C), (const bf16*)(ws + WS_W + W_UQ), NC, 384, 384};
                  pg8::StaticOrder S; S.init(MH, NQ, F.G, (int)blockIdx.x);
                  EpiUq E{ssqq, grow0, (bf16*)(ws + WS_QM), cosM, sinM};
                  pg8::gemm_phase<EpiUq, pg8::StaticOrder, true>(F.lds + RING_OFF, g, S, E); }
                { pg8::Gemm g{(const bf16*)(ws + WS_C) + 384, (const bf16*)(ws + WS_W + W_UKV), NC, 256, 256};
                  pg8::StaticOrder S; S.init(MH, NKV, F.G, (int)blockIdx.x);
                  EpiUkv E{ssqkv, (bf16*)(ws + WS_KVM)};
                  pg8::gemm_phase<EpiUkv, pg8::StaticOrder, true>(F.lds + RING_OFF, g, S, E); }
#ifdef NAIVE_SB
                naive_sb(F);
#else
                sb_phase(F);
#endif
#ifdef NAIVE_RET
                naive_ret(F, (const float*)args.in[8] + (size_t)l * 512);
#else
                ret_r1_phase(F);
#endif
            } PH_END
            PH_BEGIN {
#ifndef NAIVE_RET
                ret_scan_phase(F);
#endif
#ifdef NAIVE_MLA
                naive_mla(F);
#else
                mla_phase(F);
#endif
            } PH_END
            PH_BEGIN {
#ifndef NAIVE_RET
                ret_r3_phase(F, (const float*)args.in[8] + (size_t)l * 512);
#endif
            } PH_END
            PH_BEGIN {
                pg8::Gemm g{(const bf16*)(ws + WS_Y), (const bf16*)(ws + WS_W + W_B), 1536, 1536, 512};
                pg8::SegOrder<3> S; S.b.init(MH, DM, F.G, (int)blockIdx.x);
                EpiMerge E{(const bf16*)(ws + WS_GATES), (bf16*)(ws + WS_MG)};
                pg8::gemm_phase<EpiMerge, pg8::SegOrder<3>, true>(F.lds + RING_OFF, g, S, E);
            } PH_END
            PH_BEGIN {
                pg8::Gemm g{(const bf16*)(ws + WS_MG), (const bf16*)(ws + WS_W + W_OUT), DM, DM, DM};
                pg8::StaticOrder S; S.init(MH, DM, F.G, (int)blockIdx.x);
                EpiResid E{l == 0 ? x_in : (const float*)args.out, args.out, XB, ssqx + (size_t)(2 * l + 1) * MTOT, grow0};
                pg8::gemm_phase<EpiResid, pg8::StaticOrder, true>(F.lds + RING_OFF, g, S, E);
            } PH_END
            PH_BEGIN {
                pg8::Gemm g{XB + (size_t)grow0 * DM, (const bf16*)(ws + WS_W + W_UP), DM, DM, DM};
                pg8::StaticOrder S; S.init(MH, DFF, F.G, (int)blockIdx.x);
                EpiUp E{ssqx + (size_t)(2 * l + 1) * MTOT, grow0, (bf16*)(ws + WS_H)};
                pg8::gemm_phase<EpiUp, pg8::StaticOrder, true>(F.lds + RING_OFF, g, S, E);
            } PH_END
            PH_BEGIN {
                pg8::Gemm g{(const bf16*)(ws + WS_H), (const bf16*)(ws + WS_W + W_DN), DFF, DFF, DFF};
                pg8::StaticOrder S; S.init(MH, DM, F.G, (int)blockIdx.x);
                EpiResid E{(const float*)args.out, args.out, XB, ssqx + (size_t)(2 * l + 2) * MTOT, grow0};
                pg8::gemm_phase<EpiResid, pg8::StaticOrder, true>(F.lds + RING_OFF, g, S, E);
            } PH_END
        }
    }
    PH_BEGIN final_phase(F, args.out, ssqx + (size_t)(2 * DEPTH) * MTOT, (const float*)args.in[14]); PH_END
#undef PH_BEGIN
#undef PH_END
}


#ifdef DBG_STOP
struct DumpItem { size_t off; int where; int is_f32; int rows; int width; int pitch; };
__global__ void __launch_bounds__(512) dbg_rowsum(Args a, float* dst, size_t off, int where, int is_f32, int rows, int width, int pitch) {
    const unsigned char* base = (where == 0) ? (const unsigned char*)a.ws : (where == 1) ? (const unsigned char*)a.out : (const unsigned char*)a.in[0];
    base += off;
    const int lane = threadIdx.x & 63, gw = blockIdx.x * 8 + (threadIdx.x >> 6), ngw = gridDim.x * 8;
    for (int r = gw; r < rows; r += ngw) {
        float s = 0.f;
        if (is_f32) { const float* p = (const float*)base + (size_t)r * pitch; for (int c = lane; c < width; c += 64) s += p[c] * (1.f + 0.001f * (c & 15)); }
        else { const unsigned short* p = (const unsigned short*)base + (size_t)r * pitch; for (int c = lane; c < width; c += 64) s += __uint_as_float((unsigned)p[c] << 16) * (1.f + 0.001f * (c & 15)); }
        for (int o = 1; o < 64; o <<= 1) s += __shfl_xor(s, o);
        if (lane == 0) dst[r] = s;
    }
}
__global__ void __launch_bounds__(512) dbg_copy(const float* src, float* out, int n, int total) {
    for (int i = blockIdx.x * 512 + threadIdx.x; i < total; i += gridDim.x * 512) out[i] = (i < n) ? src[i] : 0.f;
}
#endif
#ifndef MK_ONE_LAUNCH
#define MK_ONE_LAUNCH 0
#endif
extern "C" void kernel_launch(void* const* d_in, const int* in_sizes, int n_in, void* d_out, int out_size, void* d_ws, size_t ws_size, hipStream_t stream) {
    static int grid = 0;
    if (grid == 0) {
        if (n_in != 15 || in_sizes[0] != MTOT * DM || out_size != MTOT * DM || ws_size < WS_END) { fprintf(stderr, "kernel_launch: unexpected shapes (n_in %d, in0 %d, out %d, ws %zu < %zu); nothing launched\n", n_in, n_in > 0 ? in_sizes[0] : -1, out_size, ws_size, (size_t)WS_END); grid = -1; return; }
        int dev = 0, cus = 0, per_cu = 0;
        if (hipGetDevice(&dev) != hipSuccess || hipDeviceGetAttribute(&cus, hipDeviceAttributeMultiprocessorCount, dev) != hipSuccess) { grid = -1; return; }
        if (hipFuncSetAttribute((const void*)fwd, hipFuncAttributeMaxDynamicSharedMemorySize, LDS_BYTES) != hipSuccess) { fprintf(stderr, "kernel_launch: hipFuncSetAttribute failed\n"); grid = -1; return; }
        if (hipOccupancyMaxActiveBlocksPerMultiprocessor(&per_cu, (const void*)fwd, NTHR, LDS_BYTES) != hipSuccess || per_cu < 1) { fprintf(stderr, "kernel_launch: occupancy query reports %d blocks per CU\n", per_cu); }
        (void)hipGetLastError();
        grid = cus;
    }
    if (grid < 0) return;
    if (hipMemsetAsync((char*)d_ws + WS_CTL, 0, CTL_ZERO_BYTES, stream) != hipSuccess) return;
    if (hipMemsetAsync((char*)d_ws + WS_SSQ, 0, SSQ_ZERO_BYTES, stream) != hipSuccess) return;
    Args a{};
    for (int i = 0; i < 15; ++i) a.in[i] = d_in[i];
    a.out = (float*)d_out; a.ws = (unsigned char*)d_ws;
#ifdef DBG_STOP
    for (int p = 0; p < DBG_STOP; ++p) { a.ph_lo = p; a.ph_hi = p + 1; hipLaunchKernelGGL(fwd, dim3(grid), dim3(NTHR), LDS_BYTES, stream, a); }
    {   const DumpItem items[] = { DBG_ITEMS };
        float* scratch = (float*)((unsigned char*)d_ws + WS_RST); int n = 0;
        for (const DumpItem& it : items) { hipLaunchKernelGGL(dbg_rowsum, dim3(256), dim3(512), 0, stream, a, scratch + n, it.off, it.where, it.is_f32, it.rows, it.width, it.pitch); n += it.rows; }
        hipLaunchKernelGGL(dbg_copy, dim3(1024), dim3(512), 0, stream, (const float*)scratch, (float*)d_out, n, out_size); }
#elif MK_ONE_LAUNCH
    a.ph_lo = 0; a.ph_hi = N_PHASES;
    hipLaunchKernelGGL(fwd, dim3(grid), dim3(NTHR), LDS_BYTES, stream, a);
#else
    for (int p = 0; p < N_PHASES; ++p) { a.ph_lo = p; a.ph_hi = p + 1; hipLaunchKernelGGL(fwd, dim3(grid), dim3(NTHR), LDS_BYTES, stream, a); }
#endif
}
```

```cpp
#define MK_ONE_LAUNCH 1
#include <hip/hip_runtime.h>
#include <cstdio>
#include <cstdint>
#include <cmath>

namespace pg8 {
#define PG8_LAS __attribute__((address_space(3)))
typedef unsigned short bf16_t;
typedef short bf16x8 __attribute__((ext_vector_type(8)));
typedef float f32x4 __attribute__((ext_vector_type(4)));
typedef unsigned u32x4 __attribute__((ext_vector_type(4)));
typedef unsigned u32x2 __attribute__((ext_vector_type(2)));
constexpr int BM = 256, BK = 64, HALF = 128, HTB = HALF * BK * 2  , STAGE_BYTES = 8 * HTB, NXCD = 8, WGM = 8;

__host__ __device__ __forceinline__ int lds_byte(int r, int c) { const int st = (r >> 4) * 2 + (c >> 5), rr = r & 15, cc = c & 31, ob = rr * 64 + cc * 2; return st * 1024 + (ob ^ (((ob >> 9) & 1) << 5)); }
__host__ __device__ __forceinline__ void stage_rc(int b, int& R, int& C) { const int st = b / 1024, sb = b % 1024, swz = sb ^ (((sb >> 9) & 1) << 5); R = (st >> 1) * 16 + swz / 64; C = (st & 1) * 32 + (swz % 64) / 2; }
__host__ __device__ __forceinline__ int perm32(int rho) { const int n = rho >> 4, i = rho & 15; return 8 * (i >> 2) + 4 * n + (i & 3); }

struct Unit { int pm, pn, ks, par, ty; };
struct Gemm { const bf16_t* A; const bf16_t* Bt; int lda, ldb, K; };

struct StaticOrder {
    int nM, nN, nwg, G, c;
    __host__ __device__ void init(int M, int N, int G_, int c_) { nM = M / BM; nN = N / BM; nwg = nM * nN; G = G_; c = c_; }
    __host__ __device__ bool tile(int i, Unit& u) const {
        const long L = (long)i * G + c; if (L >= nwg) return false;
        int wgid = (int)L; { const int q = nwg / NXCD, r = nwg % NXCD, xcd = wgid % NXCD, off = wgid / NXCD; wgid = (xcd < r ? xcd * (q + 1) : r * (q + 1) + (xcd - r) * q) + off; }
        const int nig = WGM * nN, gid = wgid / nig, fm = gid * WGM, gsz = (nM - fm) < WGM ? (nM - fm) : WGM;
        u.pm = fm + ((wgid % nig) % gsz); u.pn = (wgid % nig) / gsz; u.ks = 0; u.ty = 0; return true;
    }
    __host__ __device__ bool next(int i, Unit& u) const { return tile(i, u); }
    __device__ __forceinline__ void a_ready(const Unit&) const {}
    __device__ __forceinline__ void done(const Unit&) const {}
};
struct MapOrder {
    StaticOrder b; int from, add;
    __host__ __device__ bool next(int i, Unit& u) const { if (!b.tile(i, u)) return false; if (u.pn >= from) u.pn += add; return true; }
    __device__ __forceinline__ void a_ready(const Unit&) const {}
    __device__ __forceinline__ void done(const Unit&) const {}
};
struct GateOrder {
    StaticOrder b;
    __host__ __device__ bool next(int i, Unit& u) const { if (!b.tile(i / 3, u)) return false; u.pn = 14 + 4 * (i % 3) + u.pn; u.ty = i; return true; }
    __device__ __forceinline__ void a_ready(const Unit&) const {}
    __device__ __forceinline__ void done(const Unit&) const {}
};
template <int NSEG> struct SegOrder {
    StaticOrder b;
    __host__ __device__ bool next(int i, Unit& u) const { if (!b.tile(i / NSEG, u)) return false; u.ks = i % NSEG; u.ty = i / NSEG; return true; }
    __device__ __forceinline__ void a_ready(const Unit&) const {}
    __device__ __forceinline__ void done(const Unit&) const {}
};

__device__ __forceinline__ unsigned cvt_pk_bf16(float lo, float hi) { unsigned r; asm volatile("s_nop 0\n\tv_cvt_pk_bf16_f32 %0, %1, %2" : "=v"(r) : "v"(lo), "v"(hi)); return r; }

template <class Epi, class Sched, bool ALIGN_EPI>
__device__ __forceinline__ void gemm_phase(PG8_LAS unsigned char* lds, const Gemm g, const Sched& S, const Epi& E) {
    int tid_ = threadIdx.x; asm volatile("" : "+v"(tid_));
    const int tid = tid_, wid = __builtin_amdgcn_readfirstlane(tid >> 6), lane = tid & 63, wr = wid >> 2, wc = wid & 3, fr = lane & 15, fq = lane >> 4;
    const int K = g.K, nt = K / BK;
    unsigned voffA[2], voffB[2];
#pragma unroll
    for (int i = 0; i < 2; ++i) { int R, C; stage_rc(tid * 16 + i * 8192, R, C); const int Rb = Epi::PERM ? ((R & ~31) + perm32(R & 31)) : R;
        voffA[i] = (unsigned)(R * g.lda + C) * 2u; voffB[i] = (unsigned)(Rb * g.ldb + C) * 2u; }
    const size_t kstep = (size_t)(BK * 2);
    const size_t hstepA = (size_t)HALF * g.lda * 2, hstepB = (size_t)HALF * g.ldb * 2;
    const size_t tstepA = 2 * hstepA, tstepB = 2 * hstepB;
    const size_t ksb = (size_t)K * 2;
    const unsigned ldsw = (unsigned)wid * 1024u;
    const int aoff = lds_byte(wr * 64 + fr, fq * 8), boff = lds_byte(wc * 32 + fr, fq * 8);
#define PG8_SA(b, h) (((b) * 2 + (h)) * HTB)
#define PG8_SB(b, h) ((4 + (b) * 2 + (h)) * HTB)
#define PG8_STAGE(bufoff, gbase, voff) do { _Pragma("unroll") for (int _i = 0; _i < 2; ++_i) \
        __builtin_amdgcn_global_load_lds((const unsigned*)((const char*)(gbase) + (voff)[_i]), (PG8_LAS unsigned*)(lds + (bufoff) + ldsw + _i * 8192), 16, 0, 0); } while (0)
#define PG8_LDA(dst, b, h) do { _Pragma("unroll") for (int m = 0; m < 4; ++m) _Pragma("unroll") for (int k = 0; k < 2; ++k) dst[m][k] = *(const PG8_LAS bf16x8*)(lds + PG8_SA(b, h) + aoff + m * 2048 + k * 1024); } while (0)
#define PG8_LDB(dst, b, h) do { _Pragma("unroll") for (int n = 0; n < 2; ++n) _Pragma("unroll") for (int k = 0; k < 2; ++k) dst[n][k] = *(const PG8_LAS bf16x8*)(lds + PG8_SB(b, h) + boff + n * 2048 + k * 1024); } while (0)
#define PG8_MMA(ai, bj, At, Bt) do { __builtin_amdgcn_s_setprio(1); _Pragma("unroll") for (int m = 0; m < 4; ++m) _Pragma("unroll") for (int n = 0; n < 2; ++n) _Pragma("unroll") for (int k = 0; k < 2; ++k) \
        acc[ai][bj][m][n] = __builtin_amdgcn_mfma_f32_16x16x32_bf16(Bt[n][k], At[m][k], acc[ai][bj][m][n], 0, 0, 0); __builtin_amdgcn_s_setprio(0); } while (0)
#define PG8_WAIT_V(n) asm volatile("s_waitcnt vmcnt(" #n ")" ::: "memory")
#define PG8_WAIT_L(n) asm volatile("s_waitcnt lgkmcnt(" #n ")" ::: "memory")
#define PG8_BAR __builtin_amdgcn_s_barrier()
#define PG8_SCHED __builtin_amdgcn_sched_barrier(0)
    Unit cur, nxt; int ui = 0;
    if (!S.next(0, cur)) return;
    f32x4 acc[2][2][4][2];
#pragma unroll
    for (int a = 0; a < 2; ++a)
#pragma unroll
        for (int b = 0; b < 2; ++b)
#pragma unroll
            for (int m = 0; m < 4; ++m)
#pragma unroll
                for (int n = 0; n < 2; ++n) acc[a][b][m][n] = (f32x4){0.f, 0.f, 0.f, 0.f};
    bf16x8 At[4][2], B0[2][2], B1[2][2];
    const char* cA = (const char*)g.A + (size_t)cur.pm * tstepA + (size_t)cur.ks * ksb; const char* cB = (const char*)g.Bt + (size_t)cur.pn * tstepB + (size_t)cur.ks * ksb;
    cur.par = 0; S.a_ready(cur);
    E.prefetch(cur, lds, tid);
    PG8_STAGE(PG8_SB(0, 0), cB, voffB); PG8_STAGE(PG8_SB(0, 1), cB + hstepB, voffB); PG8_STAGE(PG8_SA(0, 0), cA, voffA); PG8_STAGE(PG8_SA(0, 1), cA + hstepA, voffA);
    if (wr == 1) PG8_BAR;
    PG8_WAIT_V(2); PG8_BAR;
    PG8_STAGE(PG8_SB(1, 0), cB + kstep, voffB); PG8_STAGE(PG8_SA(1, 0), cA + kstep, voffA); PG8_STAGE(PG8_SB(1, 1), cB + hstepB + kstep, voffB);
    PG8_WAIT_V(6); PG8_BAR;
    for (;;) {
        const bool has_next = S.next(ui + 1, nxt);
        const char* nA = has_next ? (const char*)g.A + (size_t)nxt.pm * tstepA + (size_t)nxt.ks * ksb : cA; const char* nB = has_next ? (const char*)g.Bt + (size_t)nxt.pn * tstepB + (size_t)nxt.ks * ksb : cB;
#pragma nounroll
        for (int t = 0; t < nt; t += 2) {
            const bool last = (t == nt - 2);
            const char* a1 = cA + (size_t)(t + 1) * kstep;
            const char* a2 = last ? nA : cA + (size_t)(t + 2) * kstep; const char* b2 = last ? nB : cB + (size_t)(t + 2) * kstep;
            const char* a3 = a2 + kstep; const char* b3 = b2 + kstep;
            if (last && has_next) S.a_ready(nxt);
            PG8_LDB(B0, 0, 0); PG8_LDB(B1, 0, 1); PG8_SCHED; PG8_LDA(At, 0, 0); PG8_STAGE(PG8_SA(1, 1), a1 + hstepA, voffA);
            PG8_WAIT_V(8); PG8_WAIT_L(0); PG8_BAR; PG8_MMA(0, 0, At, B0); PG8_MMA(0, 1, At, B1); PG8_BAR; PG8_SCHED;
            PG8_LDA(At, 0, 1); PG8_STAGE(PG8_SB(0, 0), b2, voffB); PG8_STAGE(PG8_SB(0, 1), b2 + hstepB, voffB); PG8_STAGE(PG8_SA(0, 0), a2, voffA);
            PG8_WAIT_V(8); PG8_WAIT_L(0); PG8_BAR; PG8_MMA(1, 0, At, B0); PG8_MMA(1, 1, At, B1); PG8_BAR; PG8_SCHED;
            PG8_LDB(B0, 1, 0); PG8_LDB(B1, 1, 1); PG8_SCHED; PG8_LDA(At, 1, 0); PG8_STAGE(PG8_SA(0, 1), a2 + hstepA, voffA);
            PG8_WAIT_V(8); PG8_WAIT_L(0); PG8_BAR; PG8_MMA(0, 0, At, B0); PG8_MMA(0, 1, At, B1); PG8_BAR; PG8_SCHED;
            PG8_LDA(At, 1, 1); PG8_STAGE(PG8_SB(1, 0), b3, voffB); PG8_STAGE(PG8_SB(1, 1), b3 + hstepB, voffB); PG8_STAGE(PG8_SA(1, 0), a3, voffA);
            PG8_WAIT_V(8); PG8_WAIT_L(0); PG8_BAR; PG8_MMA(1, 0, At, B0); PG8_MMA(1, 1, At, B1); PG8_BAR; PG8_SCHED;
        }
        if constexpr (ALIGN_EPI) { if (wr == 0) PG8_BAR; }
        E(acc, cur, wr, wc, fr, fq); S.done(cur);
        if (!has_next) break;
        if (!E.keep(cur)) {
#pragma unroll
        for (int a = 0; a < 2; ++a)
#pragma unroll
            for (int b = 0; b < 2; ++b)
#pragma unroll
                for (int m = 0; m < 4; ++m)
#pragma unroll
                    for (int n = 0; n < 2; ++n) acc[a][b][m][n] = (f32x4){0.f, 0.f, 0.f, 0.f};
        }
        cur = nxt; cur.par = (ui + 1) & 1; cA = nA; cB = nB; ++ui;
        E.prefetch(cur, lds, tid);
        if constexpr (ALIGN_EPI) { if (wr == 1) PG8_BAR; }
    }
    PG8_WAIT_V(0);
    if constexpr (!ALIGN_EPI) { if (wr == 0) PG8_BAR; }
    PG8_BAR;
#undef PG8_SA
#undef PG8_SB
#undef PG8_STAGE
#undef PG8_LDA
#undef PG8_LDB
#undef PG8_MMA
#undef PG8_WAIT_V
#undef PG8_WAIT_L
#undef PG8_BAR
#undef PG8_SCHED
}
}

constexpr int NWAVES = 8, NTHR = NWAVES * 64;
constexpr int BATCH = 8, SEQ = 4096, DM = 1024, DEPTH = 4, DFF = 4096;
constexpr int MTOT = BATCH * SEQ;
constexpr int NHALF = 1, MH = MTOT / NHALF, BH = BATCH / NHALF;
constexpr int NHEAD = 8;
constexpr int D_IN = 7328, NIN = 7424;
constexpr int NC = 768;
constexpr int NQ = 768, NKV = 1024;
constexpr float EPS = 1e-6f;
constexpr float QSCALE = 0.10206207261596575f * 1.4426950408889634f;

constexpr size_t MiB = 1u << 20;
constexpr size_t WS_CTL = 0, CTL_ZERO_BYTES = 1 * MiB;
constexpr size_t WS_SSQ = 1 * MiB, SSQ_ZERO_BYTES = 5 * MiB;
constexpr size_t WS_SSQX = WS_SSQ;
constexpr size_t WS_SSQQ = WS_SSQX + 9 * (size_t)MTOT * 8;
constexpr size_t WS_SSQKV = WS_SSQQ + 4 * (size_t)MTOT * 8;
static_assert(WS_SSQKV + 4 * (size_t)MTOT * 8 <= WS_SSQ + SSQ_ZERO_BYTES, "accumulators inside the memset region");
constexpr size_t WS_COSR = 6 * MiB, WS_SINR = 10 * MiB, WS_COSM = 14 * MiB, WS_SINM = 16 * MiB;
constexpr size_t WS_XB = 18 * MiB;
constexpr size_t WS_W = 82 * MiB;
constexpr size_t W_IN = 0, W_UQ = W_IN + (size_t)NIN * DM * 2, W_UKV = W_UQ + (size_t)NQ * 384 * 2, W_B = W_UKV + (size_t)NKV * 256 * 2,
                 W_OUT = W_B + (size_t)DM * 1536 * 2, W_UP = W_OUT + (size_t)DM * DM * 2, W_DN = W_UP + (size_t)DFF * DM * 2, W_END = W_DN + (size_t)DM * DFF * 2;
static_assert(W_END <= 40 * MiB, "weights region");
constexpr size_t WS_Y = 122 * MiB;
constexpr size_t WS_C = 218 * MiB;
constexpr size_t WS_SBK = 266 * MiB, WS_SBV = 298 * MiB;
constexpr size_t WS_RK = 330 * MiB, WS_RV = 362 * MiB, WS_RG = 394 * MiB;
constexpr size_t WS_RST = 426 * MiB;
constexpr size_t WS_QM = 266 * MiB;
constexpr size_t WS_KVM = 314 * MiB;
constexpr size_t WS_GATES = 218 * MiB;
constexpr size_t WS_MG = 410 * MiB;
constexpr size_t WS_H = 122 * MiB;
constexpr size_t WS_KPE = 474 * MiB;
constexpr size_t WS_END = 476 * MiB;
static_assert(WS_QM + (size_t)MH * NQ * 2 <= WS_KVM && WS_KVM + (size_t)MH * NKV * 2 <= WS_RG && WS_GATES + (size_t)MH * 3072 * 2 <= WS_MG && WS_MG + (size_t)MH * DM * 2 <= WS_KPE
              && WS_H + (size_t)MH * DFF * 2 <= WS_MG && WS_RG + (size_t)MH * 512 * 2 <= WS_RST && WS_RST + 32 * MiB <= WS_END && WS_Y + (size_t)MH * 1536 * 2 <= WS_C, "d_ws map");
constexpr int CW_BAR = 4096;

constexpr int RING_OFF = 0, RING_BYTES = 131072;
constexpr int LDSCTL_OFF = RING_BYTES, MISC_OFF = LDSCTL_OFF + 320;
constexpr int LDS_BYTES = 147456;

#define GAS __attribute__((address_space(1)))
#define LAS __attribute__((address_space(3)))
typedef unsigned short bf16;
typedef unsigned v4u __attribute__((ext_vector_type(4)));
typedef float f32x4 __attribute__((ext_vector_type(4)));
typedef GAS unsigned gu32;
#define RLX_AGENT __ATOMIC_RELAXED, __HIP_MEMORY_SCOPE_AGENT
#define LDS_WAIT() asm volatile("s_waitcnt lgkmcnt(0)" ::: "memory")
#define VM_WAIT() asm volatile("s_waitcnt vmcnt(0)" ::: "memory")
__device__ __forceinline__ unsigned f2bf(float f) { unsigned u = __builtin_bit_cast(unsigned, f); return (u + 0x7fffu + ((u >> 16) & 1u)) >> 16; }
__device__ __forceinline__ unsigned pk2(float lo, float hi) { return f2bf(lo) | (f2bf(hi) << 16); }
__device__ __forceinline__ float bflo(unsigned w) { return __uint_as_float(w << 16); }
__device__ __forceinline__ float bfhi(unsigned w) { return __uint_as_float(w & 0xffff0000u); }

#define XB_TMO      128
#define XB_XCNT(j)  (256  + 64 * (j))
#define XB_XSUB(j)  (1280 + 64 * (j))
#define XB_XGEN(j)  (2304 + 64 * (j))
#define XB_TOP      3328
#define XB_TOPGEN   3392
#define XCD_BAR_WORDS 3456
#define XB_SPIN_CAP (1u << 18)

__device__ __forceinline__ unsigned xb_ld(unsigned* p)              { return __hip_atomic_load(p, __ATOMIC_RELAXED, __HIP_MEMORY_SCOPE_AGENT); }
__device__ __forceinline__ unsigned xb_add(unsigned* p, unsigned v) { return __hip_atomic_fetch_add(p, v, __ATOMIC_RELAXED, __HIP_MEMORY_SCOPE_AGENT); }
__device__ __forceinline__ unsigned xb_xcc_id() { return (unsigned)__builtin_amdgcn_s_getreg((3 << 11) | 20) & 0xFu; }
#define XB_SPIN(cond, bar) do { unsigned _sp = 0; while (cond) { __builtin_amdgcn_s_sleep(1); \
    if ((++_sp & 255u) == 0u) { if (xb_ld(&(bar)[XB_TMO])) break; if (_sp > XB_SPIN_CAP) { atomicAdd(&(bar)[XB_TMO], 1u); break; } } } } while (0)

struct XcdBarrier {
    unsigned* bar; unsigned x;
    volatile LAS unsigned* st;
};
__device__ __forceinline__ XcdBarrier xcd_barrier_post(unsigned* bar, volatile LAS unsigned* st) {
    XcdBarrier b; b.bar = bar; b.x = xb_xcc_id(); b.st = st;
    if (threadIdx.x == 0) (void)xb_add(&bar[XB_XCNT(b.x)], 1u);
    return b;
}
__device__ __forceinline__ void xcd_barrier_complete(unsigned* bar, unsigned x, unsigned& nloc, unsigned& nx) {
    const unsigned G = gridDim.x * gridDim.y * gridDim.z;
    unsigned sum, cnt, mine, sp = 0u;
    for (;;) {
        sum = 0u; cnt = 0u; mine = 0u;
#pragma unroll
        for (unsigned j = 0; j < 16; ++j) { const unsigned c = xb_ld(&bar[XB_XCNT(j)]); sum += c; cnt += (c > 0u) ? 1u : 0u; mine = (j == x) ? c : mine; }
        if (sum == G) break;
        __builtin_amdgcn_s_sleep(1);
        if ((++sp & 255u) == 0u) { if (xb_ld(&bar[XB_TMO])) break; if (sp > XB_SPIN_CAP) { atomicAdd(&bar[XB_TMO], 1u); break; } }
    }
    nloc = mine > 0u ? mine : 1u; nx = cnt > 0u ? cnt : 1u;
}
__device__ __forceinline__ void xcd_barrier(const XcdBarrier& b) {
    asm volatile("s_waitcnt vmcnt(0)" ::: "memory");
    __syncthreads();
    if (threadIdx.x == 0) {
        unsigned* bar = b.bar;
        __builtin_amdgcn_s_waitcnt(0);
        unsigned nloc = b.st[0], nx = b.st[1];
        if (nloc == 0u) { xcd_barrier_complete(bar, b.x, nloc, nx); b.st[0] = nloc; b.st[1] = nx; }
        const unsigned old = xb_add(&bar[XB_XSUB(b.x)], 1u);
        const unsigned gen = old / nloc;
        if (old + 1u == (gen + 1u) * nloc) {
            __builtin_amdgcn_fence(__ATOMIC_RELEASE, "agent");
            asm volatile("s_waitcnt vmcnt(0)" ::: "memory");
            const unsigned og = xb_add(&bar[XB_TOP], 1u);
            const unsigned tg = og / nx;
            if (og + 1u == (tg + 1u) * nx) xb_add(&bar[XB_TOPGEN], 1u);
            else XB_SPIN(xb_ld(&bar[XB_TOPGEN]) == tg, bar);
            __builtin_amdgcn_fence(__ATOMIC_ACQUIRE, "agent");
            xb_add(&bar[XB_XGEN(b.x)], 1u);
            asm volatile("s_waitcnt vmcnt(0)" ::: "memory");
        } else {
            XB_SPIN(xb_ld(&bar[XB_XGEN(b.x)]) == gen, bar);
            __builtin_amdgcn_fence(__ATOMIC_ACQUIRE, "agent");
            asm volatile("s_waitcnt vmcnt(0)" ::: "memory");
        }
    }
    __syncthreads();
}

struct Args { const void* in[15]; float* out; unsigned char* ws; int ph_lo, ph_hi; };
struct Frame {
    LAS unsigned char* lds;
    int tid, lane, wave, G;
    unsigned char* ws;
};

__device__ __forceinline__ float wave_sum(float v) {
#pragma unroll
    for (int o = 1; o < 64; o <<= 1) v += __shfl_xor(v, o);
    return v;
}
typedef unsigned long long u64;
__device__ __forceinline__ void ssq_add(u64* p, float s) { atomicAdd(p, (u64)(s * 16777216.f + 0.5f)); }
__device__ __forceinline__ float ssq_get(const u64* p) { return (float)(*p) * (1.f / 16777216.f); }
__device__ __forceinline__ int vzero() { int z; asm volatile("v_mov_b32 %0, 0" : "=v"(z)); return z; }

template <int MAP> __device__ __forceinline__ int src_col(int n) {
    if constexpr (MAP == 0) return n;
    else if constexpr (MAP == 1) {
        if (n < 512) return 672 + n;
        if (n < 1024) return 1184 + (n - 512);
        if (n < 1536) return 1696 + (n - 1024);
        if (n < 2048) { const int c = n - 1536; return 2208 + (c & ~63) + ((c & 63) >> 1) + 32 * (c & 1); }
        if (n < 2560) { const int c = n - 2048; return 2720 + (c & ~63) + ((c & 63) >> 1) + 32 * (c & 1); }
        if (n < 3072) return 3232 + (n - 2560);
        if (n < 3584) return 3744 + (n - 3072);
        if (n < 6656) return 4256 + (n - 3584);
        if (n < 7040) return n - 6656;
        if (n < 7296) return 384 + (n - 7040);
        if (n < 7328) { const int j = n - 7296; return 640 + (j >> 1) + 16 * (j & 1); }
        return -1;
    } else {
        const int h = n / 96, hc = n % 96; if (hc < 64) return n; const int j = hc - 64; return h * 96 + 64 + (j >> 1) + 16 * (j & 1);
    }
}
template <int MAP> __device__ __forceinline__ void transpose_item(const float* W, int Nsrc, int Ndst, const float* gain, bf16* WT, int pitch, int koff, LAS float* scr, int item, int lane) {
    const int nblk = Ndst / 32, kb = item / nblk, nb = item % nblk, k0 = 64 * kb, n0 = 32 * nb;
    const int sc = src_col<MAP>(n0 + (lane & 31));
    float wv[32], gv[32];
#pragma unroll
    for (int i = 0; i < 32; ++i) { const int kk = 2 * i + (lane >> 5); wv[i] = (sc >= 0) ? W[(size_t)(k0 + kk) * Nsrc + sc] : 0.f; gv[i] = gain ? gain[k0 + kk] : 1.f; }
#pragma unroll
    for (int i = 0; i < 32; ++i) { const int kk = 2 * i + (lane >> 5); scr[kk * 33 + (lane & 31)] = wv[i] * gv[i]; }
    LDS_WAIT(); asm volatile("" ::: "memory");
    const int c = lane & 7;
#pragma unroll
    for (int j = 0; j < 4; ++j) { const int n = (lane >> 3) + 8 * j; const LAS float* s = scr + (8 * c) * 33 + n;
        v4u o; o.x = pk2(s[0 * 33], s[1 * 33]); o.y = pk2(s[2 * 33], s[3 * 33]); o.z = pk2(s[4 * 33], s[5 * 33]); o.w = pk2(s[6 * 33], s[7 * 33]);
        *(GAS v4u*)(WT + (size_t)(n0 + n) * pitch + koff + k0 + 8 * c) = o; }
    LDS_WAIT(); asm volatile("" ::: "memory");
}

#ifdef EPI_FENCED
#define EPI_FENCE asm volatile("" ::: "memory")
#else
#define EPI_FENCE
#endif
using pg8::Unit; using pg8::bf16_t; using pg8::u32x4; using pg8::cvt_pk_bf16;
typedef float accT[2][2][4][2] __attribute__((unused));
__device__ __forceinline__ u32x4 pack8(const float (&v)[8]) { u32x4 w; w.x = cvt_pk_bf16(v[0], v[1]); w.y = cvt_pk_bf16(v[2], v[3]); w.z = cvt_pk_bf16(v[4], v[5]); w.w = cvt_pk_bf16(v[6], v[7]); return w; }
__device__ __forceinline__ float sigmoidf_(float x) { return __builtin_amdgcn_rcpf(1.f + __expf(-x)); }

constexpr int ROWTAB_OFF = 132 * 1024;
__device__ __forceinline__ void rowtab_stage(const u64* ssq_rows, const Unit& u, PG8_LAS unsigned char* lds, int tid) {
    const int w = __builtin_amdgcn_readfirstlane(tid >> 6);
    __builtin_amdgcn_global_load_lds((const unsigned*)(ssq_rows + (size_t)u.pm * 256) + tid, (PG8_LAS unsigned*)(lds + ROWTAB_OFF + u.par * 2048 + w * 256), 4, 0, 0);
}
__device__ __forceinline__ float rowtab_get(PG8_LAS unsigned char* lds, const Unit& u, int rit) {
    const pg8::u32x2 w = *(const PG8_LAS pg8::u32x2*)(lds + ROWTAB_OFF + u.par * 2048 + rit * 8);
    return fmaf((float)w.y, 256.f, (float)w.x * (1.f / 16777216.f));
}
__device__ __forceinline__ float rowtab_rstd(PG8_LAS unsigned char* lds, const Unit& u, int rit, float invn) { return __builtin_amdgcn_rsqf(fmaf(rowtab_get(lds, u, rit), invn, EPS)); }
__device__ __forceinline__ pg8::f32x4 vmax0(pg8::f32x4 a) { return __builtin_elementwise_max(a, (pg8::f32x4){0.f, 0.f, 0.f, 0.f}); }
__device__ __forceinline__ pg8::f32x4 vminc(pg8::f32x4 a, float c) { return __builtin_elementwise_min(a, (pg8::f32x4){c, c, c, c}); }
__device__ __forceinline__ pg8::f32x4 vexp2(pg8::f32x4 a) { return (pg8::f32x4){__builtin_amdgcn_exp2f(a.x), __builtin_amdgcn_exp2f(a.y), __builtin_amdgcn_exp2f(a.z), __builtin_amdgcn_exp2f(a.w)}; }
__device__ __forceinline__ pg8::f32x4 vrcp(pg8::f32x4 a) { return (pg8::f32x4){__builtin_amdgcn_rcpf(a.x), __builtin_amdgcn_rcpf(a.y), __builtin_amdgcn_rcpf(a.z), __builtin_amdgcn_rcpf(a.w)}; }
__device__ __forceinline__ unsigned cvt_pk_bf16_cc(float lo, float hi) {
    typedef float f32x2_t __attribute__((ext_vector_type(2))); typedef __bf16 bf16x2_t __attribute__((ext_vector_type(2)));
    const f32x2_t f = {lo, hi}; return __builtin_bit_cast(unsigned, __builtin_convertvector(f, bf16x2_t));
}
__device__ __forceinline__ u32x4 pack8v(pg8::f32x4 a, pg8::f32x4 b) { u32x4 w; w.x = cvt_pk_bf16_cc(a.x, a.y); w.y = cvt_pk_bf16_cc(a.z, a.w); w.z = cvt_pk_bf16_cc(b.x, b.y); w.w = cvt_pk_bf16_cc(b.z, b.w); return w; }
__device__ __forceinline__ pg8::f32x4 vsigm_t(pg8::f32x4 t) { return vrcp(vexp2(vminc(t, 86.f)) + 1.f); }
__device__ __forceinline__ pg8::f32x4 vsigden_t(pg8::f32x4 t) { return vexp2(vminc(t, 86.f)) + 1.f; }
constexpr float NLOG2E = -1.4426950408889634f;

struct EpiIn {
    static constexpr bool PERM = true;
    const u64* ssq; int grow0;
    unsigned char* ws; PG8_LAS unsigned char* ldsb;
    const float *cosR, *sinR, *cosM, *sinM;
    u64 *ssqq, *ssqkv;
    __device__ __forceinline__ bool keep(const Unit&) const { return false; }
    __device__ __forceinline__ void prefetch(const Unit& u, PG8_LAS unsigned char* lds, int tid) const { rowtab_stage(ssq + grow0, u, lds, tid); }
    template <int MODE> __device__ __forceinline__ void run(pg8::f32x4 (&acc)[2][2][4][2], const Unit& u, int wr, int wc, int fr, int fq, bf16_t* dst, int pitch, int col0, float scale) const {
        const int lrow0 = u.pm * 256 + wr * 64 + fr, cw = wc * 32 + 8 * fq;
#pragma unroll
        for (int ai = 0; ai < 2; ++ai)
#pragma unroll
            for (int m = 0; m < 4; ++m) { EPI_FENCE;
                const int lrow = lrow0 + ai * 128 + m * 16, grow = grow0 + lrow;
                const float rs = rowtab_rstd(ldsb, u, lrow - u.pm * 256, 1.f / 1024.f) * (MODE <= 1 ? scale : 1.f);
#pragma unroll
                for (int bj = 0; bj < 2; ++bj) {
                    const int ct = bj * 128 + cw;
                    const pg8::f32x4 a0 = acc[ai][bj][m][0] * rs, a1 = acc[ai][bj][m][1] * rs;
                    bf16_t* p = dst + (size_t)lrow * pitch + col0 + ct;
                    if constexpr (MODE == 0) { *(u32x4*)p = pack8v(a0, a1); continue; }
                    if constexpr (MODE == 2) { *(u32x4*)p = pack8v(a0 * vrcp(vexp2(a0 * NLOG2E) + 1.f), a1 * vrcp(vexp2(a1 * NLOG2E) + 1.f)); continue; }
                    float v[8];
#pragma unroll
                    for (int j = 0; j < 4; ++j) { v[j] = a0[j]; v[4 + j] = a1[j]; }
                    if constexpr (MODE == 1) {
                        const int i0 = (ct & 63) >> 1;
                        const pg8::f32x4 c4 = *(const pg8::f32x4*)(cosR + (size_t)grow * 32 + i0), s4 = *(const pg8::f32x4*)(sinR + (size_t)grow * 32 + i0);
#pragma unroll
                        for (int j = 0; j < 4; ++j) { const float x1 = v[2 * j], x2 = v[2 * j + 1]; v[2 * j] = x1 * c4[j] - x2 * s4[j]; v[2 * j + 1] = x2 * c4[j] + x1 * s4[j]; }
                    } else if constexpr (MODE == 4) {
                        const int cb = col0 + bj * 128 + wc * 32;
                        if (cb < 640) {
                            float s = 0.f;
#pragma unroll
                            for (int j = 0; j < 8; ++j) s += v[j] * v[j];
                            s += __shfl_xor(s, 16); s += __shfl_xor(s, 32);
                            if (fq == 0) ssq_add((cb < 384 ? ssqq : ssqkv) + lrow, s);
                        } else if (cb < 672) {
                            const int i0 = 4 * fq;
                            const pg8::f32x4 c4 = *(const pg8::f32x4*)(cosM + (size_t)grow * 16 + i0), s4 = *(const pg8::f32x4*)(sinM + (size_t)grow * 16 + i0);
#pragma unroll
                            for (int j = 0; j < 4; ++j) { const float x1 = v[2 * j], x2 = v[2 * j + 1]; v[2 * j] = x1 * c4[j] - x2 * s4[j]; v[2 * j + 1] = x2 * c4[j] + x1 * s4[j]; }
                            p = (bf16_t*)(ws + WS_KPE) + (size_t)lrow * 32 + 8 * fq;
                        } else continue;
                    }
                    *(u32x4*)p = pack8(v);
                }
            }
    }
    __device__ __forceinline__ void run_rope(pg8::f32x4 (&acc)[2][2][4][2], const Unit& u, int wr, int wc, int fr, int fq, bf16_t* dst, int pitch, int col0, float scale) const {
        const int lrow0 = u.pm * 256 + wr * 64 + fr, cw = wc * 32 + 8 * fq, i0 = (cw & 63) >> 1;
#pragma unroll
        for (int ai = 0; ai < 2; ++ai) {
            pg8::f32x4 c4[4], s4[4];
#pragma unroll
            for (int m = 0; m < 4; ++m) { const size_t grow = (size_t)(grow0 + lrow0 + ai * 128 + m * 16); c4[m] = *(const pg8::f32x4*)(cosR + grow * 32 + i0); s4[m] = *(const pg8::f32x4*)(sinR + grow * 32 + i0); }
            asm volatile("" ::: "memory");
#pragma unroll
            for (int m = 0; m < 4; ++m) {
                const int lrow = lrow0 + ai * 128 + m * 16;
                const float rs = rowtab_rstd(ldsb, u, lrow - u.pm * 256, 1.f / 1024.f) * scale;
#pragma unroll
                for (int bj = 0; bj < 2; ++bj) {
                    const pg8::f32x4 a0 = acc[ai][bj][m][0] * rs, a1 = acc[ai][bj][m][1] * rs;
                    float v[8];
#pragma unroll
                    for (int j = 0; j < 4; ++j) { v[j] = a0[j]; v[4 + j] = a1[j]; }
#pragma unroll
                    for (int j = 0; j < 4; ++j) { const float x1 = v[2 * j], x2 = v[2 * j + 1]; v[2 * j] = x1 * c4[m][j] - x2 * s4[m][j]; v[2 * j + 1] = x2 * c4[m][j] + x1 * s4[m][j]; }
                    *(u32x4*)(dst + (size_t)lrow * pitch + col0 + bj * 128 + cw) = pack8(v);
                }
            }
            asm volatile("" ::: "memory");
        }
    }
    __device__ __forceinline__ void operator()(pg8::f32x4 (&acc)[2][2][4][2], const Unit& u, int wr, int wc, int fr_, int fq_) const {
        int fr = fr_, fq = fq_; asm volatile("" : "+v"(fr), "+v"(fq));
        const int pn = u.pn;
        if (pn >= 26) { run<4>(acc, u, wr, wc, fr, fq, (bf16_t*)(ws + WS_C), NC, (pn - 26) * 256, 1.f); return; }
        const int seg = pn >> 1, c0 = (pn & 1) * 256;
        if (seg == 0) run<0>(acc, u, wr, wc, fr, fq, (bf16_t*)(ws + WS_Y), 1536, c0 + 512, 0.125f * 1.4426950408889634f);
        else if (seg == 1) run<0>(acc, u, wr, wc, fr, fq, (bf16_t*)(ws + WS_SBK), 512, c0, 1.f);
        else if (seg == 2) run<0>(acc, u, wr, wc, fr, fq, (bf16_t*)(ws + WS_SBV), 512, c0, 1.f);
        else if (seg == 3) run_rope(acc, u, wr, wc, fr, fq, (bf16_t*)(ws + WS_Y), 1536, c0 + 1024, 0.125f);
        else if (seg == 4) run_rope(acc, u, wr, wc, fr, fq, (bf16_t*)(ws + WS_RK), 512, c0, 1.f);
        else if (seg == 5) run<0>(acc, u, wr, wc, fr, fq, (bf16_t*)(ws + WS_RV), 512, c0, 1.f);
        else run<0>(acc, u, wr, wc, fr, fq, (bf16_t*)(ws + WS_RG), 512, c0, 1.f);
    }
};

struct EpiUq {
    static constexpr bool PERM = true;
    const u64* ssqq; int grow0; bf16_t* QM; const float *cosM, *sinM; PG8_LAS unsigned char* ldsb;
    __device__ __forceinline__ bool keep(const Unit&) const { return false; }
    __device__ __forceinline__ void prefetch(const Unit& u, PG8_LAS unsigned char* lds, int tid) const { rowtab_stage(ssqq, u, lds, tid); }
    __device__ __forceinline__ void operator()(pg8::f32x4 (&acc)[2][2][4][2], const Unit& u, int wr, int wc, int fr_, int fq_) const {
        int fr = fr_, fq = fq_; asm volatile("" : "+v"(fr), "+v"(fq));
        const int lrow0 = u.pm * 256 + wr * 64 + fr, cw = wc * 32 + 8 * fq;
        int hcb[2];
#pragma unroll
        for (int bj = 0; bj < 2; ++bj) hcb[bj] = (u.pn * 256 + bj * 128 + cw) % 96;
#pragma unroll
        for (int ai = 0; ai < 2; ++ai) {
            pg8::f32x4 c4[4][2], s4[4][2];
#pragma unroll
            for (int m = 0; m < 4; ++m)
#pragma unroll
                for (int bj = 0; bj < 2; ++bj) { const size_t grow = (size_t)(grow0 + lrow0 + ai * 128 + m * 16); const int i0 = hcb[bj] >= 64 ? (hcb[bj] - 64) >> 1 : 0;
                    c4[m][bj] = *(const pg8::f32x4*)(cosM + grow * 16 + i0); s4[m][bj] = *(const pg8::f32x4*)(sinM + grow * 16 + i0); }
            asm volatile("" ::: "memory");
#pragma unroll
            for (int m = 0; m < 4; ++m) {
                const int lrow = lrow0 + ai * 128 + m * 16;
                const float rs = rowtab_rstd(ldsb, u, lrow - u.pm * 256, 1.f / 384.f) * QSCALE;
#pragma unroll
                for (int bj = 0; bj < 2; ++bj) {
                    const int c = u.pn * 256 + bj * 128 + cw;
                    const pg8::f32x4 a0 = acc[ai][bj][m][0] * rs, a1 = acc[ai][bj][m][1] * rs;
                    float v[8];
#pragma unroll
                    for (int j = 0; j < 4; ++j) { v[j] = a0[j]; v[4 + j] = a1[j]; }
                    if (hcb[bj] >= 64) {
#pragma unroll
                        for (int j = 0; j < 4; ++j) { const float x1 = v[2 * j], x2 = v[2 * j + 1]; v[2 * j] = x1 * c4[m][bj][j] - x2 * s4[m][bj][j]; v[2 * j + 1] = x2 * c4[m][bj][j] + x1 * s4[m][bj][j]; }
                    }
                    *(u32x4*)(QM + (size_t)lrow * NQ + c) = pack8(v);
                }
            }
            asm volatile("" ::: "memory");
        }
    }
};
struct EpiUkv {
    static constexpr bool PERM = true;
    const u64* ssqkv; bf16_t* KVM; PG8_LAS unsigned char* ldsb;
    __device__ __forceinline__ bool keep(const Unit&) const { return false; }
    __device__ __forceinline__ void prefetch(const Unit& u, PG8_LAS unsigned char* lds, int tid) const { rowtab_stage(ssqkv, u, lds, tid); }
    __device__ __forceinline__ void operator()(pg8::f32x4 (&acc)[2][2][4][2], const Unit& u, int wr, int wc, int fr_, int fq_) const {
        int fr = fr_, fq = fq_; asm volatile("" : "+v"(fr), "+v"(fq));
        const int lrow0 = u.pm * 256 + wr * 64 + fr, cw = wc * 32 + 8 * fq;
#pragma unroll
        for (int ai = 0; ai < 2; ++ai)
#pragma unroll
            for (int m = 0; m < 4; ++m) { EPI_FENCE;
                const int lrow = lrow0 + ai * 128 + m * 16;
                const float rs = rowtab_rstd(ldsb, u, lrow - u.pm * 256, 1.f / 256.f);
#pragma unroll
                for (int bj = 0; bj < 2; ++bj) {
                    *(u32x4*)(KVM + ((size_t)((lrow >> 12) * NHEAD + u.pn * 2 + bj) * SEQ + (lrow & (SEQ - 1))) * 128 + cw) = pack8v(acc[ai][bj][m][0] * rs, acc[ai][bj][m][1] * rs);
                }
            }
    }
};
struct EpiMerge {
    static constexpr bool PERM = true;
    const bf16_t* G; bf16_t* MG;
    __device__ __forceinline__ bool keep(const Unit& u) const { return u.ks < 2; }
    __device__ __forceinline__ void prefetch(const Unit&, PG8_LAS unsigned char*, int) const {}
    __device__ __forceinline__ void operator()(pg8::f32x4 (&acc)[2][2][4][2], const Unit& u, int wr, int wc, int fr_, int fq_) const {
        int fr = fr_, fq = fq_; asm volatile("" : "+v"(fr), "+v"(fq));
        const int lrow0 = u.pm * 256 + wr * 64 + fr, cw = wc * 32 + 8 * fq, ks = u.ks;
#pragma unroll
        for (int ai = 0; ai < 2; ++ai)
#pragma unroll
            for (int m = 0; m < 4; ++m) { EPI_FENCE;
                const int lrow = lrow0 + ai * 128 + m * 16;
#pragma unroll
                for (int bj = 0; bj < 2; ++bj) {
                    const int d = u.pn * 256 + bj * 128 + cw;
                    const bf16_t* gp = G + (size_t)lrow * 3072 + ks * 1024 + d;
                    const u32x4 ga = *(const u32x4*)gp;
                    float f[8];
#pragma unroll
                    for (int j = 0; j < 4; ++j) { f[2 * j] = bflo(ga[j]); f[2 * j + 1] = bfhi(ga[j]); }
                    if (ks < 2) {
                        const u32x4 gb = *(const u32x4*)(gp + 1024);
#pragma unroll
                        for (int j = 0; j < 4; ++j) { f[2 * j] *= __builtin_amdgcn_rcpf(bflo(gb[j])); f[2 * j + 1] *= __builtin_amdgcn_rcpf(bfhi(gb[j])); }
                    }
#pragma unroll
                    for (int j = 0; j < 4; ++j) { acc[ai][bj][m][0][j] *= f[j]; acc[ai][bj][m][1][j] *= f[4 + j]; }
                    if (ks == 2) {
                        float v[8];
#pragma unroll
                        for (int j = 0; j < 4; ++j) { v[j] = acc[ai][bj][m][0][j]; v[4 + j] = acc[ai][bj][m][1][j]; }
                        *(u32x4*)(MG + (size_t)lrow * DM + d) = pack8(v);
                    }
                }
            }
    }
};
struct EpiGate {
    static constexpr bool PERM = true;
    const u64* ssq; unsigned char* GS; PG8_LAS unsigned char* ldsb;
    __device__ __forceinline__ bool keep(const Unit&) const { return false; }
    __device__ __forceinline__ void prefetch(const Unit& u, PG8_LAS unsigned char* lds, int tid) const { rowtab_stage(ssq, u, lds, tid); }
    __device__ __forceinline__ void operator()(pg8::f32x4 (&acc)[2][2][4][2], const Unit& u, int wr, int wc, int fr_, int fq_) const {
        int fr = fr_, fq = fq_; asm volatile("" : "+v"(fr), "+v"(fq));
        unsigned char* gsw = GS + (size_t)u.ty * 131072 + (size_t)(wr * 4 + wc) * 16384;
        const unsigned lo = (unsigned)(fq * 16 + fr) * 16u;
#pragma unroll
        for (int ai = 0; ai < 2; ++ai)
#pragma unroll
            for (int m = 0; m < 4; ++m) { EPI_FENCE;
                const float rsn = rowtab_rstd(ldsb, u, wr * 64 + fr + ai * 128 + m * 16, 1.f / 1024.f) * NLOG2E;
#pragma unroll
                for (int bj = 0; bj < 2; ++bj) __builtin_nontemporal_store(pack8v(vsigden_t(acc[ai][bj][m][0] * rsn), vsigden_t(acc[ai][bj][m][1] * rsn)), (u32x4*)(gsw + ((ai * 4 + m) * 2 + bj) * 1024 + lo));
            }
    }
};
struct EpiMergeL {
    static constexpr bool PERM = true;
    const unsigned char* GS; bf16_t* MG;
    __device__ __forceinline__ bool keep(const Unit& u) const { return u.ks < 2; }
    __device__ __forceinline__ void prefetch(const Unit&, PG8_LAS unsigned char*, int) const {}
    __device__ __forceinline__ void operator()(pg8::f32x4 (&acc)[2][2][4][2], const Unit& u, int wr, int wc, int fr_, int fq_) const {
        int fr = fr_, fq = fq_; asm volatile("" : "+v"(fr), "+v"(fq));
        const int lrow0 = u.pm * 256 + wr * 64 + fr, cw = wc * 32 + 8 * fq, ks = u.ks;
        const unsigned char* gsw = GS + (size_t)(u.ty * 3 + ks) * 131072 + (size_t)(wr * 4 + wc) * 16384;
        const unsigned lo = (unsigned)(fq * 16 + fr) * 16u;
#pragma unroll
        for (int ai = 0; ai < 2; ++ai) {
            u32x4 ga[4][2], gb[4][2];
#pragma unroll
            for (int m = 0; m < 4; ++m)
#pragma unroll
                for (int bj = 0; bj < 2; ++bj) {
                    const unsigned char* gp = gsw + ((ai * 4 + m) * 2 + bj) * 1024;
                    ga[m][bj] = __builtin_nontemporal_load((const u32x4*)(gp + lo));
                    if (ks < 2) gb[m][bj] = __builtin_nontemporal_load((const u32x4*)(gp + 131072 + lo));
                }
            asm volatile("" ::: "memory");
#pragma unroll
            for (int m = 0; m < 4; ++m) {
                const int lrow = lrow0 + ai * 128 + m * 16;
#pragma unroll
                for (int bj = 0; bj < 2; ++bj) {
                    float f[8];
#pragma unroll
                    for (int j = 0; j < 4; ++j) { f[2 * j] = __builtin_amdgcn_rcpf(bflo(ga[m][bj][j])); f[2 * j + 1] = __builtin_amdgcn_rcpf(bfhi(ga[m][bj][j])); }
                    if (ks < 2) {
#pragma unroll
                        for (int j = 0; j < 4; ++j) { f[2 * j] *= bflo(gb[m][bj][j]); f[2 * j + 1] *= bfhi(gb[m][bj][j]); }
                    }
#pragma unroll
                    for (int j = 0; j < 4; ++j) { acc[ai][bj][m][0][j] *= f[j]; acc[ai][bj][m][1][j] *= f[4 + j]; }
                    if (ks == 2) {
                        float v[8];
#pragma unroll
                        for (int j = 0; j < 4; ++j) { v[j] = acc[ai][bj][m][0][j]; v[4 + j] = acc[ai][bj][m][1][j]; }
                        *(u32x4*)(MG + (size_t)lrow * DM + u.pn * 256 + bj * 128 + cw) = pack8(v);
                    }
                }
            }
            asm volatile("" ::: "memory");
        }
    }
};
struct EpiResid {
    static constexpr bool PERM = true;
    bf16_t* XB; u64* ssq_next; int grow0;
    __device__ __forceinline__ bool keep(const Unit&) const { return false; }
    __device__ __forceinline__ void prefetch(const Unit&, PG8_LAS unsigned char*, int) const {}
    __device__ __forceinline__ void operator()(pg8::f32x4 (&acc)[2][2][4][2], const Unit& u, int wr, int wc, int fr_, int fq_) const {
        int fr = fr_, fq = fq_; asm volatile("" : "+v"(fr), "+v"(fq));
        const int lrow0 = u.pm * 256 + wr * 64 + fr, cw = wc * 32 + 8 * fq;
#pragma unroll
        for (int ai = 0; ai < 2; ++ai) {
            u32x4 xh[4][2];
#pragma unroll
            for (int m = 0; m < 4; ++m)
#pragma unroll
                for (int bj = 0; bj < 2; ++bj) xh[m][bj] = *(const u32x4*)(XB + (size_t)(grow0 + lrow0 + ai * 128 + m * 16) * DM + u.pn * 256 + bj * 128 + cw);
            asm volatile("" ::: "memory");
#pragma unroll
            for (int m = 0; m < 4; ++m) {
                const int grow = grow0 + lrow0 + ai * 128 + m * 16;
                float sq = 0.f;
#pragma unroll
                for (int bj = 0; bj < 2; ++bj) {
                    const int col = u.pn * 256 + bj * 128 + cw;
                    float v[8];
#pragma unroll
                    for (int j = 0; j < 4; ++j) { v[2 * j] = bflo(xh[m][bj][j]) + acc[ai][bj][m][j >> 1][(2 * j) & 3]; v[2 * j + 1] = bfhi(xh[m][bj][j]) + acc[ai][bj][m][j >> 1][(2 * j + 1) & 3]; }
#pragma unroll
                    for (int j = 0; j < 8; ++j) sq += v[j] * v[j];
                    *(u32x4*)(XB + (size_t)grow * DM + col) = pack8(v);
                }
                sq += __shfl_xor(sq, 16); sq += __shfl_xor(sq, 32);
                if (fq == 0) ssq_add(ssq_next + grow, sq);
            }
            asm volatile("" ::: "memory");
        }
    }
};
struct EpiUp {
    static constexpr bool PERM = true;
    const u64* ssq; int grow0; bf16_t* H; int var; PG8_LAS unsigned char* ldsb;
    __device__ __forceinline__ bool keep(const Unit&) const { return false; }
    __device__ __forceinline__ void prefetch(const Unit& u, PG8_LAS unsigned char* lds, int tid) const { rowtab_stage(ssq + grow0, u, lds, tid); }
    __device__ __forceinline__ void operator()(pg8::f32x4 (&acc)[2][2][4][2], const Unit& u, int wr, int wc, int fr_, int fq_) const {
        int fr = fr_, fq = fq_; asm volatile("" : "+v"(fr), "+v"(fq));
        if (var & 2) {
#pragma unroll
            for (int ai = 0; ai < 2; ++ai)
#pragma unroll
                for (int bj = 0; bj < 2; ++bj)
#pragma unroll
                    for (int m = 0; m < 4; ++m) { asm volatile("" :: "v"(acc[ai][bj][m][0]), "v"(acc[ai][bj][m][1])); }
            return;
        }
        const int lrow0 = u.pm * 256 + wr * 64 + fr, cw = wc * 32 + 8 * fq;
#pragma unroll
        for (int ai = 0; ai < 2; ++ai)
#pragma unroll
            for (int m = 0; m < 4; ++m) { EPI_FENCE;
                const int lrow = lrow0 + ai * 128 + m * 16;
                const float rs = rowtab_rstd(ldsb, u, lrow - u.pm * 256, 1.f / 1024.f);
#pragma unroll
                for (int bj = 0; bj < 2; ++bj) {
                    pg8::f32x4 a0 = acc[ai][bj][m][0] * rs, a1 = acc[ai][bj][m][1] * rs;
                    a0 = a0 * vmax0(a0); a1 = a1 * vmax0(a1);
                    const u32x4 w = pack8v(a0, a1);
                    if (var & 1) { asm volatile("" :: "v"(w)); } else *(u32x4*)(H + (size_t)lrow * DFF + u.pn * 256 + bj * 128 + cw) = w;
                }
            }
    }
};

namespace att {
typedef short bf16x8 __attribute__((ext_vector_type(8)));
typedef short s16x4 __attribute__((ext_vector_type(4)));
typedef float f32x16 __attribute__((ext_vector_type(16)));
typedef unsigned u32x4 __attribute__((ext_vector_type(4)));
constexpr int KP96 = 208, KP64 = 144, VP = 192;
constexpr int TK = 128;
constexpr int KBUF = TK * KP96, VBUF = TK * VP;
constexpr int OFF_K0 = 0, OFF_K1 = KBUF, OFF_V0 = 2 * KBUF, OFF_V1 = 2 * KBUF + VBUF, OFF_FLAG = 2 * KBUF + 2 * VBUF, ATT_LDS = OFF_FLAG + 64;
static_assert(ATT_LDS <= RING_BYTES, "attention LDS");
__device__ __forceinline__ int crow(int r, int h) { return (r & 3) + 8 * (r >> 2) + 4 * h; }
__device__ __forceinline__ s16x4 tr16(const LAS unsigned char* p) { typedef short v4i16_t __attribute__((ext_vector_type(4))); return __builtin_bit_cast(s16x4, __builtin_amdgcn_ds_read_tr16_b64_v4i16((LAS v4i16_t*)p)); }
__device__ __forceinline__ unsigned cvt_pk_bf16_c(float lo, float hi) {
    typedef float f32x2_t __attribute__((ext_vector_type(2))); typedef __bf16 bf16x2_t __attribute__((ext_vector_type(2)));
    const f32x2_t f = {lo, hi}; return __builtin_bit_cast(unsigned, __builtin_convertvector(f, bf16x2_t));
}
__device__ __forceinline__ bf16x8 pack8c(const f32x16& p, int s) {
    u32x4 w; w.x = cvt_pk_bf16_c(p[8 * s + 0], p[8 * s + 1]); w.y = cvt_pk_bf16_c(p[8 * s + 2], p[8 * s + 3]); w.z = cvt_pk_bf16_c(p[8 * s + 4], p[8 * s + 5]); w.w = cvt_pk_bf16_c(p[8 * s + 6], p[8 * s + 7]);
    return __builtin_bit_cast(bf16x8, w);
}
__device__ __forceinline__ bf16x8 pack8s(const f32x16& p, int s) {
    u32x4 w; w.x = pg8::cvt_pk_bf16(p[8 * s + 0], p[8 * s + 1]); w.y = pg8::cvt_pk_bf16(p[8 * s + 2], p[8 * s + 3]); w.z = pg8::cvt_pk_bf16(p[8 * s + 4], p[8 * s + 5]); w.w = pg8::cvt_pk_bf16(p[8 * s + 6], p[8 * s + 7]);
    return __builtin_bit_cast(bf16x8, w);
}
template <int NKS> __device__ __forceinline__ f32x16 qk_block(const LAS unsigned char* krows, int pitch, const bf16x8 (&qf)[NKS], int r32, int hh) {
    f32x16 p;
#pragma unroll
    for (int i = 0; i < 16; ++i) p[i] = 0.f;
    const LAS unsigned char* kp = krows + r32 * pitch + hh * 16;
#pragma unroll
    for (int ks = 0; ks < NKS; ++ks) { const bf16x8 kf = *(const LAS bf16x8*)(kp + ks * 32); p = __builtin_amdgcn_mfma_f32_32x32x16_bf16(kf, qf[ks], p, 0, 0, 0); }
    return p;
}
template <int NKS> __device__ __forceinline__ void qk_block2(att::f32x16& pA, att::f32x16& pB, const LAS unsigned char* krows, int pitch, const att::bf16x8 (&qf)[NKS], int r32, int hh, float init = 0.f) {
    using namespace att;
    const LAS unsigned char* kp = krows + r32 * pitch + hh * 16;
    bf16x8 ka[NKS], kb[NKS];
#pragma unroll
    for (int ks = 0; ks < NKS; ++ks) ka[ks] = *(const LAS bf16x8*)(kp + ks * 32);
#pragma unroll
    for (int ks = 0; ks < NKS; ++ks) kb[ks] = *(const LAS bf16x8*)(kp + 32 * pitch + ks * 32);
#pragma unroll
    for (int i = 0; i < 16; ++i) { pA[i] = init; pB[i] = init; }
#pragma unroll
    for (int ks = 0; ks < NKS; ++ks) pA = __builtin_amdgcn_mfma_f32_32x32x16_bf16(ka[ks], qf[ks], pA, 0, 0, 0);
#pragma unroll
    for (int ks = 0; ks < NKS; ++ks) pB = __builtin_amdgcn_mfma_f32_32x32x16_bf16(kb[ks], qf[ks], pB, 0, 0, 0);
}
__device__ __forceinline__ void pv_block(f32x16 (&o)[2], const LAS unsigned char* vrows, bf16x8 pb0, bf16x8 pb1, int lane) {
    const int hh = lane >> 5, g1 = (lane >> 4) & 1, q4 = (lane >> 2) & 3, p = lane & 3;
    const LAS unsigned char* base = vrows + (4 * hh + q4) * VP + (16 * g1 + 4 * p) * 2;
#pragma unroll
    for (int db = 0; db < 2; ++db)
#pragma unroll
        for (int s = 0; s < 2; ++s) {
            const s16x4 lo = tr16(base + (16 * s) * VP + db * 64), hi = tr16(base + (16 * s + 8) * VP + db * 64);
            const bf16x8 vf = {lo[0], lo[1], lo[2], lo[3], hi[0], hi[1], hi[2], hi[3]};
            o[db] = __builtin_amdgcn_mfma_f32_32x32x16_bf16(vf, s == 0 ? pb0 : pb1, o[db], 0, 0, 0);
        }
}
__device__ __forceinline__ void store_ot(bf16* dst, const f32x16 (&o)[2], float sc, int hh) {
#pragma unroll
    for (int db = 0; db < 2; ++db)
#pragma unroll
        for (int g = 0; g < 4; ++g) {
            pg8::u32x2 w; w.x = pg8::cvt_pk_bf16(o[db][4 * g] * sc, o[db][4 * g + 1] * sc); w.y = pg8::cvt_pk_bf16(o[db][4 * g + 2] * sc, o[db][4 * g + 3] * sc);
            *(GAS pg8::u32x2*)(dst + db * 32 + 8 * g + 4 * hh) = w;
        }
}
}

template <bool MASKED> __device__ __forceinline__ void mla_sm_pv(att::f32x16& P0, att::f32x16& P1, att::f32x16 (&o)[2], float& m, float& l, const LAS unsigned char* Vb, int base, int qg, int lane, int hh) {
    using namespace att;
    if constexpr (MASKED) {
#pragma unroll
        for (int r = 0; r < 16; ++r) { const int key = base + crow(r, hh); if (key > qg) P0[r] = -INFINITY; if (key + 32 > qg) P1[r] = -INFINITY; }
    }
    float mx = fmaxf(P0[0], P1[0]);
#pragma unroll
    for (int r = 1; r < 16; ++r) mx = fmaxf(mx, fmaxf(P0[r], P1[r]));
    mx = fmaxf(mx, __shfl_xor(mx, 32));
    const float mn = fmaxf(m, mx), al = __builtin_amdgcn_exp2f(m - mn);
    m = mn;
    float sum = 0.f;
#pragma unroll
    for (int r = 0; r < 16; ++r) { P0[r] = __builtin_amdgcn_exp2f(P0[r] - mn); P1[r] = __builtin_amdgcn_exp2f(P1[r] - mn); sum += P0[r] + P1[r]; }
    sum += __shfl_xor(sum, 32);
    l = l * al + sum;
#pragma unroll
    for (int r = 0; r < 16; ++r) { o[0][r] *= al; o[1][r] *= al; }
    pv_block(o, Vb, pack8s(P0, 0), pack8s(P0, 1), lane);
    pv_block(o, Vb + 32 * VP, pack8s(P1, 0), pack8s(P1, 1), lane);
}
__device__ __forceinline__ float max3f(float a, float b, float c) { return fmaxf(fmaxf(a, b), c); }
__device__ __forceinline__ void mla_sm_pv_ref(att::f32x16& A0, att::f32x16& A1, att::f32x16& B0, att::f32x16& B1, att::f32x16 (&o)[2], float& m, float& l, const LAS unsigned char* Vb, int lane, bool first) {
    using namespace att;
    float mx = max3f(A0[0], A1[0], B0[0]); mx = fmaxf(mx, B1[0]);
#pragma unroll
    for (int r = 1; r < 16; ++r) { mx = max3f(mx, A0[r], A1[r]); mx = max3f(mx, B0[r], B1[r]); }
    mx = fmaxf(mx, __shfl_xor(mx, 32));
    if (first || __builtin_amdgcn_ballot_w64(mx > 8.f) != 0ull) {
        const float d = (first || mx > 8.f) ? mx : 0.f, al = first ? 1.f : __builtin_amdgcn_exp2f(-d);
        m = first ? d : m + d; l *= al;
#pragma unroll
        for (int r = 0; r < 16; ++r) { o[0][r] *= al; o[1][r] *= al; A0[r] -= d; A1[r] -= d; B0[r] -= d; B1[r] -= d; }
    }
    float s0 = 0.f, s1 = 0.f;
#pragma unroll
    for (int r = 0; r < 16; ++r) { A0[r] = __builtin_amdgcn_exp2f(A0[r]); s0 += A0[r]; }
    pv_block(o, Vb, pack8c(A0, 0), pack8c(A0, 1), lane);
#pragma unroll
    for (int r = 0; r < 16; ++r) { A1[r] = __builtin_amdgcn_exp2f(A1[r]); s1 += A1[r]; }
    pv_block(o, Vb + 32 * VP, pack8c(A1, 0), pack8c(A1, 1), lane);
#pragma unroll
    for (int r = 0; r < 16; ++r) { B0[r] = __builtin_amdgcn_exp2f(B0[r]); s0 += B0[r]; }
    pv_block(o, Vb + 64 * VP, pack8c(B0, 0), pack8c(B0, 1), lane);
#pragma unroll
    for (int r = 0; r < 16; ++r) { B1[r] = __builtin_amdgcn_exp2f(B1[r]); s1 += B1[r]; }
    pv_block(o, Vb + 96 * VP, pack8c(B1, 0), pack8c(B1, 1), lane);
    s0 += s1; s0 += __shfl_xor(s0, 32);
    l += s0;
}
template <int VAR> __device__ __forceinline__ void mla_unit(Frame& F, int bh, int qb) {
    using namespace att;
    const bf16* QM = (const bf16*)(F.ws + WS_QM); const bf16* KVM = (const bf16*)(F.ws + WS_KVM); const bf16* C = (const bf16*)(F.ws + WS_C); bf16* Y = (bf16*)(F.ws + WS_Y);
    const int b = bh >> 3, h = bh & 7, q0 = qb * 256, w = F.wave, lane = F.lane, r32 = lane & 31, hh = lane >> 5, tid = F.tid;
    const int qmin = q0 + 32 * w, qg = qmin + r32;
    const size_t rowb = (size_t)b * SEQ;
    bf16x8 qf[6];
#pragma unroll
    for (int ks = 0; ks < 6; ++ks) qf[ks] = *(const GAS bf16x8*)(QM + (rowb + qg) * NQ + h * 96 + ks * 16 + hh * 8);
    float m = -INFINITY, l = 0.f; f32x16 o[2];
#pragma unroll
    for (int i = 0; i < 16; ++i) { o[0][i] = 0.f; o[1][i] = 0.f; }
    const int NT = 2 * qb + 2;
    const int kr0 = tid >> 3, kc0 = tid & 7, rr = tid >> 2, rc = tid & 3;
    const bf16* gkn = KVM + ((size_t)bh * SEQ + kr0) * 128 + kc0 * 8;
    const bf16* gkr = (const bf16*)(F.ws + WS_KPE) + (rowb + rr) * 32 + rc * 8;
    const int lk0 = kr0 * KP96 + kc0 * 16, lkr = rr * KP96 + 128 + rc * 16, lv0 = kr0 * VP + kc0 * 16;
    v4u R0, R1, R2, R3, R4;
#define MLA_LOAD(j) do { const size_t o_ = (size_t)(j) * TK; R0 = *(const GAS v4u*)(gkn + o_ * 128); R1 = *(const GAS v4u*)(gkn + (o_ + 64) * 128); R2 = *(const GAS v4u*)(gkr + o_ * 32); \
        R3 = *(const GAS v4u*)(gkn + o_ * 128 + 64); R4 = *(const GAS v4u*)(gkn + (o_ + 64) * 128 + 64); } while (0)
#define MLA_STORE(kb, vb) do { *(LAS v4u*)(F.lds + (kb) + lk0) = R0; *(LAS v4u*)(F.lds + (kb) + lk0 + 64 * KP96) = R1; *(LAS v4u*)(F.lds + (kb) + lkr) = R2; \
        *(LAS v4u*)(F.lds + (vb) + lv0) = R3; *(LAS v4u*)(F.lds + (vb) + lv0 + 64 * VP) = R4; } while (0)
    MLA_LOAD(0); MLA_STORE(OFF_K0, OFF_V0);
    __syncthreads();
    int j = 0;
    for (; j < NT - 2; ++j) {
        const int kb = (j & 1) ? OFF_K1 : OFF_K0, vb = (j & 1) ? OFF_V1 : OFF_V0;
        MLA_LOAD(j + 1);
        const LAS unsigned char* Kb = F.lds + kb; const LAS unsigned char* Vb = F.lds + vb;
        f32x16 pa0, pa1, pb0, pb1;
        const float ini = (j == 0) ? 0.f : -m;
        qk_block2<6>(pa0, pa1, Kb, KP96, qf, r32, hh, ini);
        qk_block2<6>(pb0, pb1, Kb + 64 * KP96, KP96, qf, r32, hh, ini);
        mla_sm_pv_ref(pa0, pa1, pb0, pb1, o, m, l, Vb, lane, j == 0);
        if (j & 1) MLA_STORE(OFF_K0, OFF_V0); else MLA_STORE(OFF_K1, OFF_V1);
        __syncthreads();
    }
    for (; j < NT; ++j) {
        const int kb = (j & 1) ? OFF_K1 : OFF_K0, vb = (j & 1) ? OFF_V1 : OFF_V0;
        if (j + 1 < NT) MLA_LOAD(j + 1);
#pragma unroll
        for (int sub = 0; sub < 2; ++sub) {
            const int base = j * TK + sub * 64;
            if (base <= qmin + 31) {
                const LAS unsigned char* Kb = F.lds + kb + sub * 64 * KP96; const LAS unsigned char* Vb = F.lds + vb + sub * 64 * VP;
                f32x16 p0 = qk_block<6>(Kb, KP96, qf, r32, hh), p1 = qk_block<6>(Kb + 32 * KP96, KP96, qf, r32, hh);
                mla_sm_pv<true>(p0, p1, o, m, l, Vb, base, qg, lane, hh);
            }
        }
        if (j + 1 < NT) { if (j & 1) MLA_STORE(OFF_K0, OFF_V0); else MLA_STORE(OFF_K1, OFF_V1); }
        __syncthreads();
    }
#undef MLA_LOAD
#undef MLA_STORE
    if constexpr (VAR == 0) store_ot(Y + (rowb + qg) * 1536 + h * 64, o, 1.f / l, hh);
    else store_ot((bf16*)(F.ws + WS_MG) + (rowb + qg) * 512 + h * 64, o, 1.f / (l + 1.f), hh);
}
template <int VAR> __device__ __forceinline__ void mla_phase(Frame& F) {
    const int vcu = (F.G % 8 == 0) ? (int)(blockIdx.x % 8) * (F.G / 8) + (int)blockIdx.x / 8 : (int)blockIdx.x;
    for (int u = vcu; u < BH * NHEAD * 8; u += F.G) {
        const int bh = u >> 3, s = u & 7;
        mla_unit<VAR>(F, bh, 15 - s);
        mla_unit<VAR>(F, bh, s);
    }
}

template <bool MASKED> __device__ __forceinline__ void sb_block(att::f32x16& z, float& run, int kbase, int t, int hh) {
    using namespace att;
    float om[16];
#pragma unroll
    for (int r = 0; r < 16; ++r) {
        const float e = __builtin_amdgcn_exp2f(-fmaxf(z[r], -120.f));
        float beta = __builtin_amdgcn_rcpf(1.f + e), omb = e * beta;
        if constexpr (MASKED) { const bool valid = kbase + crow(r, hh) < t; beta = valid ? beta : 0.f; omb = valid ? omb : 1.f; }
        z[r] = beta; om[r] = omb;
    }
    float Gs[4], Go[4];
#pragma unroll
    for (int g = 0; g < 4; ++g) { Gs[g] = (om[4 * g] * om[4 * g + 1]) * (om[4 * g + 2] * om[4 * g + 3]); Go[g] = __shfl_xor(Gs[g], 32); }
    float T = 1.f;
#pragma unroll
    for (int g = 3; g >= 0; --g) {
        float P = run * T * (hh == 0 ? Go[g] : 1.f);
#pragma unroll
        for (int i = 3; i >= 0; --i) { const int r = 4 * g + i; z[r] *= P; P *= om[r]; }
        T *= Gs[g] * Go[g];
    }
    run *= T;
}
template <int VAR> __device__ __forceinline__ void sb_unit(Frame& F, int bh, int qb, bf16* OUT, int opitch, int ocol) {
    using namespace att;
    const bf16* Y = (const bf16*)(F.ws + WS_Y); const bf16* SK = (const bf16*)(F.ws + WS_SBK); const bf16* SV = (const bf16*)(F.ws + WS_SBV);
    const int b = bh >> 3, h = bh & 7, q0 = qb * 256, w = F.wave, lane = F.lane, r32 = lane & 31, hh = lane >> 5, tid = F.tid;
    const int qmin = q0 + 32 * w, qg = qmin + r32;
    const size_t rowb = (size_t)b * SEQ;
    bf16x8 qf[4];
#pragma unroll
    for (int ks = 0; ks < 4; ++ks) qf[ks] = *(const GAS bf16x8*)(Y + (rowb + qg) * 1536 + 512 + h * 64 + ks * 16 + hh * 8);
    float run = 1.f; f32x16 o[2];
#pragma unroll
    for (int i = 0; i < 16; ++i) { o[0][i] = 0.f; o[1][i] = 0.f; }
    constexpr int SBT = TK * KP64 + TK * VP, SB_FLAG = 3 * SBT;
    static_assert(SB_FLAG + 64 <= RING_BYTES, "stick-breaking LDS");
    volatile LAS unsigned* fl = (volatile LAS unsigned*)(F.lds + SB_FLAG);
    if (tid < 3) fl[tid] = 0u;
    const int kr0 = tid >> 3, kc0 = tid & 7;
    const bf16* gk = SK + (rowb + kr0) * 512 + h * 64 + kc0 * 8; const bf16* gv = SV + (rowb + kr0) * 512 + h * 64 + kc0 * 8;
    const int lk0 = kr0 * KP64 + kc0 * 16, lv0 = TK * KP64 + kr0 * VP + kc0 * 16;
    v4u RA0, RA1, RA2, RA3, RB0, RB1, RB2, RB3;
#define SB_LOADA(j) do { const size_t o_ = (size_t)(j) * TK * 512; RA0 = *(const GAS v4u*)(gk + o_); RA1 = *(const GAS v4u*)(gk + o_ + 64 * 512); RA2 = *(const GAS v4u*)(gv + o_); RA3 = *(const GAS v4u*)(gv + o_ + 64 * 512); } while (0)
#define SB_LOADB(j) do { const size_t o_ = (size_t)(j) * TK * 512; RB0 = *(const GAS v4u*)(gk + o_); RB1 = *(const GAS v4u*)(gk + o_ + 64 * 512); RB2 = *(const GAS v4u*)(gv + o_); RB3 = *(const GAS v4u*)(gv + o_ + 64 * 512); } while (0)
#define SB_STOREA(tb) do { *(LAS v4u*)(F.lds + (tb) + lk0) = RA0; *(LAS v4u*)(F.lds + (tb) + lk0 + 64 * KP64) = RA1; *(LAS v4u*)(F.lds + (tb) + lv0) = RA2; *(LAS v4u*)(F.lds + (tb) + lv0 + 64 * VP) = RA3; } while (0)
#define SB_STOREB(tb) do { *(LAS v4u*)(F.lds + (tb) + lk0) = RB0; *(LAS v4u*)(F.lds + (tb) + lk0 + 64 * KP64) = RB1; *(LAS v4u*)(F.lds + (tb) + lv0) = RB2; *(LAS v4u*)(F.lds + (tb) + lv0 + 64 * VP) = RB3; } while (0)
    const int jtop = 2 * qb + 1;
    const int up = w >> 2;
    SB_LOADA(jtop); SB_LOADB(jtop - 1); SB_STOREA(0); SB_STOREB(SBT);
    if (jtop >= 2) SB_LOADA(jtop - 2);
    __syncthreads();
    for (int it = 0; ; ++it) {
        const int jt = jtop - it, mj = jt - 1 + up;
        const int tb = ((it + 1 - up) % 3) * SBT;
        if (jt >= 3) { if (it & 1) SB_LOADA(jt - 3); else SB_LOADB(jt - 3); }
        if (tid == 0) fl[(it + 1) % 3] = 0u;
        if (mj >= 0 && __ballot(run > 0.f) != 0ull) {
            if (it >= 1) {
#pragma unroll
                for (int sub = 1; sub >= 0; --sub) {
                    if (sub == 0 && __ballot(run > 0.f) == 0ull) break;
                    const LAS unsigned char* Kb = F.lds + tb + sub * 64 * KP64; const LAS unsigned char* Vb = F.lds + tb + TK * KP64 + sub * 64 * VP;
                    f32x16 p0 = qk_block<4>(Kb, KP64, qf, r32, hh), p1 = qk_block<4>(Kb + 32 * KP64, KP64, qf, r32, hh);
                    if constexpr (VAR != 1) { sb_block<false>(p1, run, 0, 0, hh);
                    sb_block<false>(p0, run, 0, 0, hh); } else run *= 1e-12f;
                    if constexpr (VAR != 2) { pv_block(o, Vb, pack8s(p0, 0), pack8s(p0, 1), lane);
                    pv_block(o, Vb + 32 * VP, pack8s(p1, 0), pack8s(p1, 1), lane); } else o[0][0] += p0[0] + p1[1];
                }
            } else {
#pragma unroll
                for (int sub = 1; sub >= 0; --sub) {
                    const int base = mj * TK + sub * 64;
                    if (base < qmin + 31) {
                        const LAS unsigned char* Kb = F.lds + tb + sub * 64 * KP64; const LAS unsigned char* Vb = F.lds + tb + TK * KP64 + sub * 64 * VP;
                        f32x16 p0 = qk_block<4>(Kb, KP64, qf, r32, hh), p1 = qk_block<4>(Kb + 32 * KP64, KP64, qf, r32, hh);
                        if constexpr (VAR != 1) { sb_block<true>(p1, run, base + 32, qg, hh);
                        sb_block<true>(p0, run, base, qg, hh); } else run *= (base + 63 < qg ? 1e-12f : 1.f);
                        if constexpr (VAR != 2) { pv_block(o, Vb, pack8s(p0, 0), pack8s(p0, 1), lane);
                        pv_block(o, Vb + 32 * VP, pack8s(p1, 0), pack8s(p1, 1), lane); } else o[0][0] += p0[0] + p1[1];
                    }
                }
            }
        }
        if (mj >= 1 && __ballot(run > 0.f) != 0ull && lane == 0) fl[it % 3] = 1u;
        if (jt >= 2) { if (it & 1) SB_STOREB(((it + 2) % 3) * SBT); else SB_STOREA(((it + 2) % 3) * SBT); }
        __syncthreads();
        if (fl[it % 3] == 0u) break;
        if constexpr (VAR == 5) { if (it >= 3) break; }
        if constexpr (VAR == 6) { break; }
    }
#undef SB_LOADA
#undef SB_LOADB
#undef SB_STOREA
#undef SB_STOREB
    __syncthreads();
    store_ot(OUT + (rowb + qg) * opitch + ocol + h * 64, o, 1.f, hh);
}
template <int VAR> __device__ __forceinline__ void sb_phase(Frame& F, bf16* OUT, int opitch, int ocol) {
    const int vcu = (F.G % 8 == 0) ? (int)(blockIdx.x % 8) * (F.G / 8) + (int)blockIdx.x / 8 : (int)blockIdx.x;
    for (int u = vcu; u < BH * NHEAD * 8; u += F.G) { const int bh = u >> 3, s = u & 7; sb_unit<VAR>(F, bh, 15 - s, OUT, opitch, ocol); sb_unit<VAR>(F, bh, s, OUT, opitch, ocol); }
}

__device__ __forceinline__ float log2_gamma(int h) {
    return h == 0 ? -4.5803689613e-02f : h == 1 ? -2.2720076500e-02f : h == 2 ? -1.1315313228e-02f : h == 3 ? -5.6465631411e-03f : h == 4 ? -2.8205190624e-03f : h == 5 ? -1.4095702547e-03f : h == 6 ? -7.0461297659e-04f : -3.5226347163e-04f;
}
constexpr size_t WS_KVS = WS_RST;
__device__ __forceinline__ void ret_stage(Frame& F, const bf16* RK, const bf16* RV, size_t row0, int h, float lg2, int kp, int voff) {
    using namespace att;
    const int tid = F.tid, r0 = tid >> 3, ch = tid & 7;
    v4u Rk[4], Rv[4];
#pragma unroll
    for (int i = 0; i < 4; ++i) { const size_t go = (row0 + r0 + 64 * i) * 512 + h * 64 + ch * 8; Rk[i] = *(const GAS v4u*)(RK + go); Rv[i] = *(const GAS v4u*)(RV + go); }
#pragma unroll
    for (int i = 0; i < 4; ++i) { const int row = r0 + 64 * i; const float z = __builtin_amdgcn_exp2f((float)(127 - (row & 127)) * lg2);
        v4u k; k.x = pg8::cvt_pk_bf16(bflo(Rk[i].x) * z, bfhi(Rk[i].x) * z); k.y = pg8::cvt_pk_bf16(bflo(Rk[i].y) * z, bfhi(Rk[i].y) * z);
        k.z = pg8::cvt_pk_bf16(bflo(Rk[i].z) * z, bfhi(Rk[i].z) * z); k.w = pg8::cvt_pk_bf16(bflo(Rk[i].w) * z, bfhi(Rk[i].w) * z);
        *(LAS v4u*)(F.lds + row * kp + ch * 16) = k; *(LAS v4u*)(F.lds + voff + row * VP + ch * 16) = Rv[i]; }
}
__device__ __forceinline__ void ret_r1_phase(Frame& F) {
    using namespace att;
    const bf16* RK = (const bf16*)(F.ws + WS_RK); const bf16* RV = (const bf16*)(F.ws + WS_RV); float* KVS = (float*)(F.ws + WS_KVS);
    const int lane = F.lane, w = F.wave, r32 = lane & 31, hh = lane >> 5, g1 = (lane >> 4) & 1, q4 = (lane >> 2) & 3, p4 = lane & 3;
    constexpr int VOFF = 256 * VP;
    for (int u = blockIdx.x; u < BH * NHEAD * 16; u += F.G) {
        const int bh = u >> 4, cp = u & 15, b = bh >> 3, h = bh & 7;
        ret_stage(F, RK, RV, (size_t)b * SEQ + cp * 256, h, log2_gamma(h), VP, VOFF);
        __syncthreads();
        const int c2 = w >> 2, eb = (w >> 1) & 1, db = w & 1;
        f32x16 acc;
#pragma unroll
        for (int i = 0; i < 16; ++i) acc[i] = 0.f;
        const LAS unsigned char* vb = F.lds + VOFF + (c2 * 128 + 8 * hh + q4) * VP + (eb * 32 + 16 * g1 + 4 * p4) * 2;
        const LAS unsigned char* kb = F.lds + (c2 * 128 + 8 * hh + q4) * VP + (db * 32 + 16 * g1 + 4 * p4) * 2;
#pragma unroll
        for (int ks = 0; ks < 8; ++ks) {
            const s16x4 al = tr16(vb + ks * 16 * VP), ah = tr16(vb + (ks * 16 + 4) * VP), bl = tr16(kb + ks * 16 * VP), bhi = tr16(kb + (ks * 16 + 4) * VP);
            const bf16x8 af = {al[0], al[1], al[2], al[3], ah[0], ah[1], ah[2], ah[3]}, bf = {bl[0], bl[1], bl[2], bl[3], bhi[0], bhi[1], bhi[2], bhi[3]};
            acc = __builtin_amdgcn_mfma_f32_32x32x16_bf16(af, bf, acc, 0, 0, 0);
        }
        float* dst = KVS + ((size_t)(bh * 32 + 2 * cp + c2) * 64 + eb * 32) * 64 + db * 32 + r32;
#pragma unroll
        for (int r = 0; r < 16; ++r) dst[crow(r, hh) * 64] = acc[r];
        __syncthreads();
    }
}
__device__ __forceinline__ void ret_scan_phase(Frame& F) {
    float* KVS = (float*)(F.ws + WS_KVS);
    for (int idx = blockIdx.x * NTHR + F.tid; idx < BH * NHEAD * 4096; idx += F.G * NTHR) {
        const int bh = idx >> 12, ed = idx & 4095;
        const float dec = __builtin_amdgcn_exp2f(128.f * log2_gamma(bh & 7));
        float S = 0.f, kv[32];
        float* base = KVS + ((size_t)(bh * 32) << 12) + ed;
#pragma unroll
        for (int n = 0; n < 32; ++n) kv[n] = base[(size_t)n << 12];
        asm volatile("" ::: "memory");
#pragma unroll
        for (int n = 0; n < 32; ++n) { base[(size_t)n << 12] = S; S = S * dec + kv[n]; }
    }
}
__device__ __forceinline__ void ret_r3_phase(Frame& F, const float* gn, bf16* OUT, int opitch, int ocol, int ng, int nlow) {
    using namespace att;
    const bf16* RK = (const bf16*)(F.ws + WS_RK); const bf16* RV = (const bf16*)(F.ws + WS_RV); const bf16* RG = (const bf16*)(F.ws + WS_RG); bf16* Y = (bf16*)(F.ws + WS_Y);
    const float* PREV = (const float*)(F.ws + WS_KVS);
    const int lane = F.lane, w = F.wave, r32 = lane & 31, hh = lane >> 5;
    constexpr int VOFF = 40960;
    const int c_ = (int)blockIdx.x; const bool low_ = c_ < ng;
    for (int u = low_ ? c_ : ng * nlow + (c_ - ng); u < (low_ ? ng * nlow : BH * NHEAD * 16); u += (low_ ? ng : F.G - ng)) {
        const int bh = u >> 4, cp = u & 15, b = bh >> 3, h = bh & 7;
        const float lg2 = log2_gamma(h);
        const size_t row0 = (size_t)b * SEQ + cp * 256;
        const int c2 = w >> 2, wq = w & 3, it = 32 * wq + r32;
        const size_t trow = row0 + c2 * 128 + it;
        bf16x8 qf[4];
#pragma unroll
        for (int ks = 0; ks < 4; ++ks) qf[ks] = *(const GAS bf16x8*)(Y + trow * 1536 + 1024 + h * 64 + ks * 16 + hh * 8);
        pg8::u32x2 rgv[8];
#pragma unroll
        for (int eb = 0; eb < 2; ++eb)
#pragma unroll
            for (int g = 0; g < 4; ++g) rgv[eb * 4 + g] = *(const GAS pg8::u32x2*)(RG + trow * 512 + h * 64 + eb * 32 + 8 * g + 4 * hh);
        bf16x8 pf[2][4];
        { const float* pv = PREV + ((size_t)(bh * 32 + 2 * cp + c2) << 12) + r32 * 64 + hh * 8;
#pragma unroll
          for (int eb = 0; eb < 2; ++eb)
#pragma unroll
              for (int ks = 0; ks < 4; ++ks) { const f32x4 a0 = *(const GAS f32x4*)(pv + eb * 32 * 64 + ks * 16), a1 = *(const GAS f32x4*)(pv + eb * 32 * 64 + ks * 16 + 4);
                  u32x4 aw; aw.x = pg8::cvt_pk_bf16(a0[0], a0[1]); aw.y = pg8::cvt_pk_bf16(a0[2], a0[3]); aw.z = pg8::cvt_pk_bf16(a1[0], a1[1]); aw.w = pg8::cvt_pk_bf16(a1[2], a1[3]);
                  pf[eb][ks] = __builtin_bit_cast(bf16x8, aw); } }
        ret_stage(F, RK, RV, row0, h, lg2, KP64, VOFF);
        __syncthreads();
        f32x16 o[2];
#pragma unroll
        for (int i = 0; i < 16; ++i) { o[0][i] = 0.f; o[1][i] = 0.f; }
        const float xi = __builtin_amdgcn_exp2f((float)(it - 127) * lg2);
        for (int kb = 0; kb <= wq; ++kb) {
            f32x16 p = qk_block<4>(F.lds + (c2 * 128 + kb * 32) * KP64, KP64, qf, r32, hh);
#pragma unroll
            for (int r = 0; r < 16; ++r) { const int is = kb * 32 + crow(r, hh); p[r] = (is <= it) ? p[r] * xi : 0.f; }
            pv_block(o, F.lds + VOFF + (c2 * 128 + kb * 32) * VP, pack8s(p, 0), pack8s(p, 1), lane);
        }
        { const float xc = __builtin_amdgcn_exp2f((float)(it + 1) * lg2);
#pragma unroll
          for (int eb = 0; eb < 2; ++eb) { f32x16 oc;
#pragma unroll
              for (int i = 0; i < 16; ++i) oc[i] = 0.f;
#pragma unroll
              for (int ks = 0; ks < 4; ++ks) oc = __builtin_amdgcn_mfma_f32_32x32x16_bf16(pf[eb][ks], qf[ks], oc, 0, 0, 0);
#pragma unroll
              for (int i = 0; i < 16; ++i) o[eb][i] += oc[i] * xc; } }
        float s1 = 0.f;
#pragma unroll
        for (int i = 0; i < 16; ++i) s1 += o[0][i] + o[1][i];
        s1 += __shfl_xor(s1, 32);
        const float mu = s1 * (1.f / 64.f); float s2 = 0.f;
#pragma unroll
        for (int i = 0; i < 16; ++i) { o[0][i] -= mu; o[1][i] -= mu; s2 += o[0][i] * o[0][i] + o[1][i] * o[1][i]; }
        s2 += __shfl_xor(s2, 32);
        const float rstd = rsqrtf(s2 * (1.f / 64.f) + EPS);
        f32x4 gvv[8];
#pragma unroll
        for (int eb = 0; eb < 2; ++eb)
#pragma unroll
            for (int g = 0; g < 4; ++g) gvv[eb * 4 + g] = *(const f32x4*)(gn + h * 64 + eb * 32 + 8 * g + 4 * hh);
        asm volatile("" ::: "memory");
#pragma unroll
        for (int eb = 0; eb < 2; ++eb)
#pragma unroll
            for (int g = 0; g < 4; ++g) { const int e = eb * 32 + 8 * g + 4 * hh;
                const f32x4 gv = gvv[eb * 4 + g]; const pg8::u32x2 rg = rgv[eb * 4 + g];
                float sg[4] = {bflo(rg.x), bfhi(rg.x), bflo(rg.y), bfhi(rg.y)};
#pragma unroll
                for (int j = 0; j < 4; ++j) sg[j] = sg[j] * __builtin_amdgcn_rcpf(1.f + __builtin_amdgcn_exp2f(sg[j] * -1.4426950408889634f));
                pg8::u32x2 wv; wv.x = pg8::cvt_pk_bf16(o[eb][4 * g] * rstd * gv[0] * sg[0], o[eb][4 * g + 1] * rstd * gv[1] * sg[1]);
                wv.y = pg8::cvt_pk_bf16(o[eb][4 * g + 2] * rstd * gv[2] * sg[2], o[eb][4 * g + 3] * rstd * gv[3] * sg[3]);
                *(GAS pg8::u32x2*)(OUT + trow * opitch + ocol + h * 64 + e) = wv; }
        __syncthreads();
    }
}

__device__ __forceinline__ void prologue_phase(Frame& F, const float* x, const int* pos, float* cosR, float* sinR, float* cosM, float* sinM, bf16* XB, bf16* XL, u64* ssq0) {
    const int gt = blockIdx.x * NTHR + F.tid, NT = F.G * NTHR;
    {
        GAS v4u* z = (GAS v4u*)((unsigned char*)ssq0 + (size_t)MTOT * 8); constexpr int NZ = (int)((WS_SSQ + SSQ_ZERO_BYTES - WS_SSQX - (size_t)MTOT * 8) / 16);
        for (int i = gt; i < NZ; i += NT) z[i] = v4u{0u, 0u, 0u, 0u};
    }
    for (int idx = gt; idx < MTOT * 32; idx += NT) {
        const int row = idx >> 5, i = idx & 31;
        const double inv = exp2(-(double)i * (13.287712379549449 / 32.0));
        const double ang = (double)pos[row] * inv;
        double s, c; sincos(ang, &s, &c);
        cosR[idx] = (float)c; sinR[idx] = (float)s;
        if ((i & 1) == 0) { cosM[row * 16 + (i >> 1)] = (float)c; sinM[row * 16 + (i >> 1)] = (float)s; }
    }
    const int gw = blockIdx.x * NWAVES + F.wave, NGW = F.G * NWAVES;
    for (int m0 = gw; m0 < MTOT; m0 += 2 * NGW) {
        f32x4 v[2][4];
#pragma unroll
        for (int r = 0; r < 2; ++r) { const int m = m0 + r * NGW; if (m < MTOT) { const GAS f32x4* xr = (const GAS f32x4*)(x + (size_t)m * DM) + F.lane;
#pragma unroll
            for (int j = 0; j < 4; ++j) v[r][j] = xr[64 * j]; } }
#pragma unroll
        for (int r = 0; r < 2; ++r) { const int m = m0 + r * NGW; if (m < MTOT) {
            float s = 0.f;
#pragma unroll
            for (int j = 0; j < 4; ++j) s += (v[r][j].x * v[r][j].x + v[r][j].y * v[r][j].y) + (v[r][j].z * v[r][j].z + v[r][j].w * v[r][j].w);
            s = wave_sum(s);
            GAS unsigned long long* o8 = (GAS unsigned long long*)(XB + (size_t)m * DM) + F.lane;
#pragma unroll
            for (int j = 0; j < 4; ++j) { const unsigned h0 = pk2(v[r][j].x, v[r][j].y), h1 = pk2(v[r][j].z, v[r][j].w); o8[64 * j] = (unsigned long long)h0 | ((unsigned long long)h1 << 32); }
            if (F.lane == 0) ssq0[m] = (u64)(s * 16777216.f + 0.5f); } }
    }
}
__device__ __forceinline__ void final_phase(Frame& F, float* xo, const bf16* XB, const bf16* XL, const u64* ssq, const float* g) {
    const int gw = blockIdx.x * NWAVES + F.wave, NGW = F.G * NWAVES;
    f32x4 gv[4];
#pragma unroll
    for (int j = 0; j < 4; ++j) gv[j] = *((const f32x4*)g + F.lane + 64 * j);
    for (int m0 = gw; m0 < MTOT; m0 += 4 * NGW) {
        unsigned long long h[4][4]; u64 sq[4];
#pragma unroll
        for (int r = 0; r < 4; ++r) { const int m = m0 + r * NGW; if (m < MTOT) { sq[r] = __hip_atomic_load(ssq + m, RLX_AGENT);
#pragma unroll
            for (int j = 0; j < 4; ++j) h[r][j] = ((const GAS unsigned long long*)(XB + (size_t)m * DM) + F.lane)[64 * j]; } }
#pragma unroll
        for (int r = 0; r < 4; ++r) { const int m = m0 + r * NGW; if (m < MTOT) {
            const float rs = rsqrtf((float)sq[r] * (1.f / 16777216.f) * (1.f / 1024.f) + EPS);
            GAS f32x4* xr = (GAS f32x4*)(xo + (size_t)m * DM) + F.lane;
#pragma unroll
            for (int j = 0; j < 4; ++j) { const unsigned h0 = (unsigned)h[r][j], h1 = (unsigned)(h[r][j] >> 32);
                f32x4 v; v.x = bflo(h0); v.y = bfhi(h0); v.z = bflo(h1); v.w = bfhi(h1);
                xr[64 * j] = v * rs * gv[j]; } } }
    }
}
__device__ __forceinline__ void convert_phase(Frame& F, const Args& a, int l, unsigned char* W) {
    LAS float* scr = (LAS float*)(F.lds + RING_OFF + F.wave * 16384);
    const float* g_mix = (const float*)a.in[2] + (size_t)l * DM;
    const float* w_in = (const float*)a.in[3] + (size_t)l * DM * D_IN;
    const float* g_q = (const float*)a.in[4] + (size_t)l * 384;
    const float* w_uq = (const float*)a.in[5] + (size_t)l * 384 * NQ;
    const float* g_kv = (const float*)a.in[6] + (size_t)l * 256;
    const float* w_ukv = (const float*)a.in[7] + (size_t)l * 256 * NKV;
    const float* w_br = (const float*)a.in[9] + (size_t)l * 3 * 512 * DM;
    const float* w_out = (const float*)a.in[10] + (size_t)l * DM * DM;
    const float* g_mlp = (const float*)a.in[11] + (size_t)l * DM;
    const float* w_up = (const float*)a.in[12] + (size_t)l * DM * DFF;
    const float* w_dn = (const float*)a.in[13] + (size_t)l * DFF * DM;
    constexpr int I_IN = (DM / 64) * (NIN / 32), I_UQ = (384 / 64) * (NQ / 32), I_UKV = (256 / 64) * (NKV / 32), I_B = (512 / 64) * (DM / 32), I_OUT = (DM / 64) * (DM / 32),
                  I_UP = (DM / 64) * (DFF / 32), I_DN = (DFF / 64) * (DM / 32);
    constexpr int NITEMS = I_IN + I_UQ + I_UKV + 3 * I_B + I_OUT + I_UP + I_DN;
    const int gw = blockIdx.x * NWAVES + F.wave, NGW = F.G * NWAVES;
    for (int it = gw; it < NITEMS; it += NGW) {
        int r = it;
        if (r < I_IN) { transpose_item<1>(w_in, D_IN, NIN, g_mix, (bf16*)(W + W_IN), DM, 0, scr, r, F.lane); continue; } r -= I_IN;
        if (r < I_UQ) { transpose_item<2>(w_uq, NQ, NQ, g_q, (bf16*)(W + W_UQ), 384, 0, scr, r, F.lane); continue; } r -= I_UQ;
        if (r < I_UKV) { transpose_item<0>(w_ukv, NKV, NKV, g_kv, (bf16*)(W + W_UKV), 256, 0, scr, r, F.lane); continue; } r -= I_UKV;
        if (r < 3 * I_B) { const int s = r / I_B; transpose_item<0>(w_br + (size_t)s * 512 * DM, DM, DM, nullptr, (bf16*)(W + W_B), 1536, s * 512, scr, r % I_B, F.lane); continue; } r -= 3 * I_B;
        if (r < I_OUT) { transpose_item<0>(w_out, DM, DM, nullptr, (bf16*)(W + W_OUT), DM, 0, scr, r, F.lane); continue; } r -= I_OUT;
        if (r < I_UP) { transpose_item<0>(w_up, DFF, DFF, g_mlp, (bf16*)(W + W_UP), DM, 0, scr, r, F.lane); continue; } r -= I_UP;
        transpose_item<0>(w_dn, DM, DM, nullptr, (bf16*)(W + W_DN), DFF, 0, scr, r, F.lane);
    }
}

__device__ __forceinline__ void ld8(const bf16* p, float* f) { const v4u w = *(const GAS v4u*)p; f[0] = bflo(w.x); f[1] = bfhi(w.x); f[2] = bflo(w.y); f[3] = bfhi(w.y); f[4] = bflo(w.z); f[5] = bfhi(w.z); f[6] = bflo(w.w); f[7] = bfhi(w.w); }
__device__ __forceinline__ void st8(bf16* p, const float* f) { v4u w; w.x = pk2(f[0], f[1]); w.y = pk2(f[2], f[3]); w.z = pk2(f[4], f[5]); w.w = pk2(f[6], f[7]); *(GAS v4u*)p = w; }
__device__ __forceinline__ void item_bht(int it, int& bh, int& t) { bh = it >> 12; const int r = it & 4095; t = (r & 511) * 8 + (r >> 9); }

__device__ __forceinline__ void naive_mla(Frame& F) {
    const bf16* QM = (const bf16*)(F.ws + WS_QM); const bf16* KVM = (const bf16*)(F.ws + WS_KVM); const bf16* C = (const bf16*)(F.ws + WS_C); bf16* Y = (bf16*)(F.ws + WS_Y);
    const int vz = vzero();
    for (int it = blockIdx.x * NTHR + F.tid; it < BH * NHEAD * SEQ; it += F.G * NTHR) {
        int bh, t; item_bht(it, bh, t); const int b = bh >> 3, h = bh & 7; const size_t lrow = (size_t)b * SEQ + t;
        float q[96];
#pragma unroll
        for (int j = 0; j < 12; ++j) ld8(QM + lrow * NQ + h * 96 + 8 * j, q + 8 * j);
        float m = -INFINITY, l = 0.f, acc[64];
#pragma unroll
        for (int e = 0; e < 64; ++e) acc[e] = 0.f;
        for (int s = 0; s <= t; ++s) {
            const size_t krow = (size_t)b * SEQ + s + vz;
            const bf16* kn = KVM + krow * NKV + h * 128; const bf16* kr = C + krow * NC + 640;
            float z = 0.f, k[8];
#pragma unroll
            for (int j = 0; j < 8; ++j) { ld8(kn + 8 * j, k);
#pragma unroll
                for (int i = 0; i < 8; ++i) z += q[8 * j + i] * k[i]; }
#pragma unroll
            for (int j = 0; j < 4; ++j) { ld8(kr + 8 * j, k);
#pragma unroll
                for (int i = 0; i < 8; ++i) z += q[64 + 8 * j + i] * k[i]; }
            if (z > m) { const float al = exp2f(m - z); l *= al;
#pragma unroll
                for (int e = 0; e < 64; ++e) acc[e] *= al;
                m = z; }
            const float p = exp2f(z - m); l += p;
#pragma unroll
            for (int j = 0; j < 8; ++j) { ld8(kn + 64 + 8 * j, k);
#pragma unroll
                for (int i = 0; i < 8; ++i) acc[8 * j + i] += p * k[i]; }
        }
        const float il = 1.f / l;
#pragma unroll
        for (int e = 0; e < 64; ++e) acc[e] *= il;
#pragma unroll
        for (int j = 0; j < 8; ++j) st8(Y + lrow * 1536 + h * 64 + 8 * j, acc + 8 * j);
    }
}
__device__ __forceinline__ void naive_sb(Frame& F) {
    bf16* Y = (bf16*)(F.ws + WS_Y); const bf16* SK = (const bf16*)(F.ws + WS_SBK); const bf16* SV = (const bf16*)(F.ws + WS_SBV);
    const int vz = vzero();
    for (int it = blockIdx.x * NTHR + F.tid; it < BH * NHEAD * SEQ; it += F.G * NTHR) {
        int bh, t; item_bht(it, bh, t); const int b = bh >> 3, h = bh & 7; const size_t lrow = (size_t)b * SEQ + t;
        float q[64];
#pragma unroll
        for (int j = 0; j < 8; ++j) ld8(Y + lrow * 1536 + 512 + h * 64 + 8 * j, q + 8 * j);
        float run = 0.f, acc[64];
#pragma unroll
        for (int e = 0; e < 64; ++e) acc[e] = 0.f;
        for (int s = t - 1; s >= 0; --s) {
            const size_t krow = (size_t)b * SEQ + s + vz;
            const bf16* kp = SK + krow * 512 + h * 64; const bf16* vp = SV + krow * 512 + h * 64;
            float z = 0.f, k[8];
#pragma unroll
            for (int j = 0; j < 8; ++j) { ld8(kp + 8 * j, k);
#pragma unroll
                for (int i = 0; i < 8; ++i) z += q[8 * j + i] * k[i]; }
            const float sp = fmaxf(z, 0.f) + log1pf(__expf(-fabsf(z)));
            const float a = __expf(z - sp + run);
#pragma unroll
            for (int j = 0; j < 8; ++j) { ld8(vp + 8 * j, k);
#pragma unroll
                for (int i = 0; i < 8; ++i) acc[8 * j + i] += a * k[i]; }
            run -= sp;
            if (run < -105.f) break;
        }
#pragma unroll
        for (int j = 0; j < 8; ++j) st8(Y + lrow * 1536 + 512 + h * 64 + 8 * j, acc + 8 * j);
    }
}
__device__ __forceinline__ void naive_ret(Frame& F, const float* gn) {
    bf16* Y = (bf16*)(F.ws + WS_Y); const bf16* RK = (const bf16*)(F.ws + WS_RK); const bf16* RV = (const bf16*)(F.ws + WS_RV); const bf16* RG = (const bf16*)(F.ws + WS_RG);
    const int vz = vzero();
    for (int it = blockIdx.x * NTHR + F.tid; it < BH * NHEAD * SEQ; it += F.G * NTHR) {
        int bh, t; item_bht(it, bh, t); const int b = bh >> 3, h = bh & 7; const size_t lrow = (size_t)b * SEQ + t;
        const float lg2 = log2_gamma(h);
        float q[64];
#pragma unroll
        for (int j = 0; j < 8; ++j) ld8(Y + lrow * 1536 + 1024 + h * 64 + 8 * j, q + 8 * j);
        float acc[64];
#pragma unroll
        for (int e = 0; e < 64; ++e) acc[e] = 0.f;
        for (int s = 0; s <= t; ++s) {
            const size_t krow = (size_t)b * SEQ + s + vz;
            const bf16* kp = RK + krow * 512 + h * 64; const bf16* vp = RV + krow * 512 + h * 64;
            float z = 0.f, k[8];
#pragma unroll
            for (int j = 0; j < 8; ++j) { ld8(kp + 8 * j, k);
#pragma unroll
                for (int i = 0; i < 8; ++i) z += q[8 * j + i] * k[i]; }
            const float a = z * exp2f((float)(t - s) * lg2);
#pragma unroll
            for (int j = 0; j < 8; ++j) { ld8(vp + 8 * j, k);
#pragma unroll
                for (int i = 0; i < 8; ++i) acc[8 * j + i] += a * k[i]; }
        }
        float mu = 0.f;
#pragma unroll
        for (int e = 0; e < 64; ++e) mu += acc[e];
        mu *= (1.f / 64.f); float var = 0.f;
#pragma unroll
        for (int e = 0; e < 64; ++e) { acc[e] -= mu; var += acc[e] * acc[e]; }
        const float rstd = rsqrtf(var * (1.f / 64.f) + EPS);
#pragma unroll
        for (int j = 0; j < 8; ++j) { float g8[8]; ld8(RG + lrow * 512 + h * 64 + 8 * j, g8);
#pragma unroll
            for (int i = 0; i < 8; ++i) acc[8 * j + i] = acc[8 * j + i] * rstd * gn[h * 64 + 8 * j + i] * g8[i];
            st8(Y + lrow * 1536 + 1024 + h * 64 + 8 * j, acc + 8 * j); }
    }
}

#ifndef ALIGN1_V
#define ALIGN1_V true
#endif
constexpr bool ALIGN1 = ALIGN1_V;
constexpr int LATE_TILE = 25;
constexpr int N_PHASES = 1 + DEPTH * 10 + 1;
__global__ void __launch_bounds__(NTHR, 2) fwd(Args args) {
    extern __shared__ __attribute__((aligned(16))) unsigned char lds[];
    Frame F;
    F.lds = (LAS unsigned char*)lds; F.tid = threadIdx.x; F.lane = F.tid & 63; F.wave = __builtin_amdgcn_readfirstlane(F.tid >> 6); F.G = gridDim.x; F.ws = args.ws;
    volatile LAS unsigned* MISC = (volatile LAS unsigned*)(F.lds + MISC_OFF);
    for (int u = F.tid; u < (LDS_BYTES - LDSCTL_OFF) / 4; u += NTHR) ((LAS unsigned*)(F.lds + LDSCTL_OFF))[u] = 0u;
    __syncthreads();
    const int lo = args.ph_lo, hi = args.ph_hi;
    const bool multi = (hi - lo) > 1;
    XcdBarrier bar; bar.bar = (unsigned*)(F.ws + WS_CTL) + CW_BAR; bar.x = 0; bar.st = nullptr;
    if (multi) bar = xcd_barrier_post((unsigned*)(F.ws + WS_CTL) + CW_BAR, MISC + 8);
    int ph = 0;
#ifdef DBG_WAIT
#define PH_TBEG tb_ = __builtin_amdgcn_s_memrealtime();
#else
#define PH_TBEG
#endif
#define PH_BEGIN if (ph >= lo && ph < hi) { PH_TBEG { int t_ = threadIdx.x; asm volatile("" : "+v"(t_)); F.tid = t_; F.lane = t_ & 63; }
#ifdef DUP_BAR
#define PH_END   if (ph + 1 < hi) { xcd_barrier(bar); xcd_barrier(bar); } } ++ph;
#elif defined(DBG_WAIT)
#ifndef DBG_INSIDE
#define DBG_W_ACC if (sel1_) w_all += t1_ - t0_; if (sel_) w_sel += t1_ - t0_;
#else
#define DBG_W_ACC
#endif
#ifdef DBG_INSIDE
#define DBG_BODY_ACC if (sel1_) w_all += t0_ - tb_; if (sel_) w_sel += t0_ - tb_;
#define DBG_WAIT_ACC(d)
#else
#define DBG_BODY_ACC
#endif
    unsigned long long t_start = __builtin_amdgcn_s_memrealtime(), c_start = clock64(), w_all = 0ull, w_sel = 0ull, tb_ = 0ull; int sel_ = 0, sel1_ = 0; int hlp_ = 0;
#define PH_END   if (ph + 1 < hi) { __syncthreads(); const unsigned long long t0_ = __builtin_amdgcn_s_memrealtime(); DBG_BODY_ACC \
        if (ph + 2 == hi && F.tid == 0) { atomicAdd((u64*)(ws + WS_SSQ + 4352 * 1024), w_all); atomicAdd((u64*)(ws + WS_SSQ + 4352 * 1024) + 1, w_sel); } \
        xcd_barrier(bar); const unsigned long long t1_ = __builtin_amdgcn_s_memrealtime(); DBG_W_ACC } } ++ph; ++hlp_; sel1_ = (DBG_W1 == 0 || hlp_ == DBG_W1); sel_ = (hlp_ == DBG_W2);
#else
#define PH_END   if (ph + 1 < hi) xcd_barrier(bar); } ++ph;
#endif

    unsigned char* ws = F.ws;
    u64* ssqx = (u64*)(ws + WS_SSQX);
    float* cosR = (float*)(ws + WS_COSR); float* sinR = (float*)(ws + WS_SINR); float* cosM = (float*)(ws + WS_COSM); float* sinM = (float*)(ws + WS_SINM);
    bf16* XB = (bf16*)(ws + WS_XB);
    bf16* XL = (bf16*)args.out + 1024;
    const float* x_in = (const float*)args.in[0];

    unsigned char* const Wbuf0 = ws + WS_W; unsigned char* const Wbuf1 = (unsigned char*)args.out;
    PH_BEGIN prologue_phase(F, x_in, (const int*)args.in[1], cosR, sinR, cosM, sinM, XB, XL, ssqx); convert_phase(F, args, 0, Wbuf0);
#ifdef DUP_PRO
    prologue_phase(F, x_in, (const int*)args.in[1], cosR, sinR, cosM, sinM, XB, XL, ssqx);
#endif
    PH_END

    for (int l = 0; l < DEPTH; ++l) {
        unsigned char* const Wl = (l & 1) ? Wbuf1 : Wbuf0; unsigned char* const Wn = (l & 1) ? Wbuf0 : Wbuf1;
        {
            constexpr int grow0 = 0;
            u64* ssqq = (u64*)(ws + WS_SSQQ) + (size_t)l * MTOT; u64* ssqkv = (u64*)(ws + WS_SSQKV) + (size_t)l * MTOT;
            const float* ret_gn = (const float*)args.in[8] + (size_t)l * 512;
            PH_BEGIN {
#ifdef DBG_WAIT
                hlp_ = 1; sel1_ = (DBG_W1 == 0 || hlp_ == DBG_W1); sel_ = (hlp_ == DBG_W2);
#endif
                pg8::Gemm g{XB, (const bf16*)(Wl + W_IN), DM, DM, DM};
                pg8::MapOrder S; S.b.init(MH, 16 * 256, F.G, (int)blockIdx.x); S.from = 14; S.add = 12;
                EpiIn E{ssqx + (size_t)(2 * l) * MTOT, grow0, ws, F.lds + RING_OFF, cosR, sinR, cosM, sinM, ssqq, ssqkv};
                pg8::gemm_phase<EpiIn, pg8::MapOrder, true>(F.lds + RING_OFF, g, S, E);
            } PH_END
            PH_BEGIN {
#ifdef DUP_SB
                sb_phase<DUP_SB>(F, (bf16*)args.out, 512, 0);
#endif
                sb_phase<0>(F, (bf16*)(ws + WS_Y), 1536, 512);
                ret_r1_phase(F);
            } PH_END
            PH_BEGIN ret_scan_phase(F); PH_END
            PH_BEGIN {
                const int ng = (F.G == 256) ? 128 : 0;
                { pg8::Gemm g{XB, (const bf16*)(Wl + W_IN), DM, DM, DM};
                    pg8::MapOrder S; S.b.init(MH, 256, F.G, (int)blockIdx.x); S.from = 0; S.add = 28;
                    EpiIn E{ssqx + (size_t)(2 * l) * MTOT, grow0, ws, F.lds + RING_OFF, cosR, sinR, cosM, sinM, ssqq, ssqkv};
                    pg8::gemm_phase<EpiIn, pg8::MapOrder, true>(F.lds + RING_OFF, g, S, E); }
                ret_r3_phase(F, ret_gn, (bf16*)(ws + WS_Y), 1536, 1024, ng, 3);
            } PH_END
            PH_BEGIN {
                { pg8::Gemm g{(const bf16*)(ws + WS_C), (const bf16*)(Wl + W_UQ), NC, 384, 384};
                  pg8::StaticOrder S; S.init(MH, NQ, F.G, (int)blockIdx.x);
                  EpiUq E{ssqq, grow0, (bf16*)(ws + WS_QM), cosM, sinM, F.lds + RING_OFF};
                  pg8::gemm_phase<EpiUq, pg8::StaticOrder, true>(F.lds + RING_OFF, g, S, E); }
                { pg8::Gemm g{(const bf16*)(ws + WS_C) + 384, (const bf16*)(Wl + W_UKV), NC, 256, 256};
                  pg8::StaticOrder S; S.init(MH, NKV, F.G, (int)blockIdx.x);
                  EpiUkv E{ssqkv, (bf16*)(ws + WS_KVM), F.lds + RING_OFF};
                  pg8::gemm_phase<EpiUkv, pg8::StaticOrder, true>(F.lds + RING_OFF, g, S, E); }
            } PH_END
            PH_BEGIN {
                mla_phase<0>(F);
#ifdef DUP_MLA
                mla_phase<DUP_MLA>(F);
#endif
            } PH_END
            PH_BEGIN {
                unsigned char* gs = ws + WS_GATES + (size_t)blockIdx.x * (6 * 131072);
                { pg8::Gemm g{XB, (const bf16*)(Wl + W_IN), DM, DM, DM};
                  pg8::GateOrder S; S.b.init(MH, DM, F.G, (int)blockIdx.x);
                  EpiGate E{ssqx + (size_t)(2 * l) * MTOT + grow0, gs, F.lds + RING_OFF};
                  pg8::gemm_phase<EpiGate, pg8::GateOrder, true>(F.lds + RING_OFF, g, S, E); }
                { pg8::Gemm g{(const bf16*)(ws + WS_Y), (const bf16*)(Wl + W_B), 1536, 1536, 512};
                  pg8::SegOrder<3> S; S.b.init(MH, DM, F.G, (int)blockIdx.x);
                  EpiMergeL E{gs, (bf16*)(ws + WS_MG)};
                  pg8::gemm_phase<EpiMergeL, pg8::SegOrder<3>, ALIGN1>(F.lds + RING_OFF, g, S, E); }
            } PH_END
            PH_BEGIN {
                pg8::Gemm g{(const bf16*)(ws + WS_MG), (const bf16*)(Wl + W_OUT), DM, DM, DM};
                pg8::StaticOrder S; S.init(MH, DM, F.G, (int)blockIdx.x);
                EpiResid E{XB, ssqx + (size_t)(2 * l + 1) * MTOT, grow0};
                pg8::gemm_phase<EpiResid, pg8::StaticOrder, ALIGN1>(F.lds + RING_OFF, g, S, E);
            } PH_END
            PH_BEGIN {
                pg8::Gemm g{XB, (const bf16*)(Wl + W_UP), DM, DM, DM};
                pg8::StaticOrder S; S.init(MH, DFF, F.G, (int)blockIdx.x);
                EpiUp E{ssqx + (size_t)(2 * l + 1) * MTOT, grow0, (bf16*)(ws + WS_H), 0, F.lds + RING_OFF};
                pg8::gemm_phase<EpiUp, pg8::StaticOrder, true>(F.lds + RING_OFF, g, S, E);
#ifdef DUP_UP
                { EpiUp E2{ssqx + (size_t)(2 * l + 1) * MTOT, grow0, (bf16*)(ws + WS_H), DUP_UP - 1, F.lds + RING_OFF};
#ifdef DUP_UP_K
                  pg8::Gemm g2{XB, (const bf16*)(Wl + W_UP), DUP_UP_LD, DUP_UP_LD, DUP_UP_K};
#else
                  pg8::Gemm g2 = g;
#endif
                  pg8::gemm_phase<EpiUp, pg8::StaticOrder, true>(F.lds + RING_OFF, g2, S, E2); }
#endif
            } PH_END
            PH_BEGIN {
                pg8::Gemm g{(const bf16*)(ws + WS_H), (const bf16*)(Wl + W_DN), DFF, DFF, DFF};
                pg8::StaticOrder S; S.init(MH, DM, F.G, (int)blockIdx.x);
                EpiResid E{XB, ssqx + (size_t)(2 * l + 2) * MTOT, grow0};
                pg8::gemm_phase<EpiResid, pg8::StaticOrder, ALIGN1>(F.lds + RING_OFF, g, S, E);
                if (l + 1 < DEPTH) convert_phase(F, args, l + 1, Wn);
            } PH_END
        }
    }
#ifdef DBG_WAIT
    PH_BEGIN { final_phase(F, args.out, XB, XL, ssqx + (size_t)(2 * DEPTH) * MTOT, (const float*)args.in[14]);
        const unsigned long long tot = __builtin_amdgcn_s_memrealtime() - t_start;
        const u64* acc_ = (const u64*)(ws + WS_SSQ + 4352 * 1024);
        float f1 = (float)__hip_atomic_load(acc_, RLX_AGENT) / ((float)F.G * (float)tot), f2 = (float)__hip_atomic_load(acc_ + 1, RLX_AGENT) / ((float)F.G * (float)tot);
#ifdef DBG_CLOCK
        f2 = rintf((float)(clock64() - c_start) / (float)tot * 0.1f * 5.f) * 0.2f * 0.1f; f1 = 0.f;
#endif
        f1 = rintf(f1 * 100.f) * 0.01f; f2 = rintf(f2 * 100.f) * 0.01f;
        const float sc = 1.f + 0.3f * sqrtf(f1);
        __syncthreads();
        const int gw = blockIdx.x * NWAVES + F.wave, NGW = F.G * NWAVES;
        for (int m = gw; m < MTOT; m += NGW) { GAS f32x4* xr = (GAS f32x4*)(args.out + (size_t)m * DM) + F.lane;
            for (int j = 0; j < 4; ++j) { f32x4 v = xr[64 * j]; v = v * sc; if (m == 0 && j == 0 && F.lane == 0) v.x += 100.f * f2; xr[64 * j] = v; } }
    } PH_END
#else
    PH_BEGIN final_phase(F, args.out, XB, XL, ssqx + (size_t)(2 * DEPTH) * MTOT, (const float*)args.in[14]); PH_END
#endif
#undef PH_BEGIN
#undef PH_END
}


#ifdef DBG_STOP
struct DumpItem { size_t off; int where; int is_f32; int rows; int width; int pitch; };
__global__ void __launch_bounds__(512) dbg_rowsum(Args a, float* dst, size_t off, int where, int is_f32, int rows, int width, int pitch) {
    const unsigned char* base = (where == 0) ? (const unsigned char*)a.ws : (where == 1) ? (const unsigned char*)a.out : (const unsigned char*)a.in[0];
    base += off;
    const int lane = threadIdx.x & 63, gw = blockIdx.x * 8 + (threadIdx.x >> 6), ngw = gridDim.x * 8;
    for (int r = gw; r < rows; r += ngw) {
        float s = 0.f;
        if (is_f32) { const float* p = (const float*)base + (size_t)r * pitch; for (int c = lane; c < width; c += 64) s += p[c] * (1.f + 0.001f * (c & 15)); }
        else { const unsigned short* p = (const unsigned short*)base + (size_t)r * pitch; for (int c = lane; c < width; c += 64) s += __uint_as_float((unsigned)p[c] << 16) * (1.f + 0.001f * (c & 15)); }
        for (int o = 1; o < 64; o <<= 1) s += __shfl_xor(s, o);
        if (lane == 0) dst[r] = s;
    }
}
__global__ void __launch_bounds__(512) dbg_copy(const float* src, float* out, int n, int total) {
    for (int i = blockIdx.x * 512 + threadIdx.x; i < total; i += gridDim.x * 512) out[i] = (i < n) ? src[i] : 0.f;
}
#endif
#ifndef MK_ONE_LAUNCH
#define MK_ONE_LAUNCH 0
#endif
extern "C" void kernel_launch(void* const* d_in, const int* in_sizes, int n_in, void* d_out, int out_size, void* d_ws, size_t ws_size, hipStream_t stream) {
    static int grid = 0;
    if (grid == 0) {
        if (n_in != 15 || in_sizes[0] != MTOT * DM || out_size != MTOT * DM || ws_size < WS_END) { fprintf(stderr, "kernel_launch: unexpected shapes (n_in %d, in0 %d, out %d, ws %zu < %zu); nothing launched\n", n_in, n_in > 0 ? in_sizes[0] : -1, out_size, ws_size, (size_t)WS_END); grid = -1; return; }
        int dev = 0, cus = 0, per_cu = 0;
        if (hipGetDevice(&dev) != hipSuccess || hipDeviceGetAttribute(&cus, hipDeviceAttributeMultiprocessorCount, dev) != hipSuccess) { grid = -1; return; }
        if (hipFuncSetAttribute((const void*)fwd, hipFuncAttributeMaxDynamicSharedMemorySize, LDS_BYTES) != hipSuccess) { fprintf(stderr, "kernel_launch: hipFuncSetAttribute failed\n"); grid = -1; return; }
        if (hipOccupancyMaxActiveBlocksPerMultiprocessor(&per_cu, (const void*)fwd, NTHR, LDS_BYTES) != hipSuccess || per_cu < 1) { fprintf(stderr, "kernel_launch: occupancy query reports %d blocks per CU\n", per_cu); }
        (void)hipGetLastError();
        grid = cus;
    }
    if (grid < 0) return;
    if (hipMemsetAsync((char*)d_ws + WS_CTL, 0, CTL_ZERO_BYTES, stream) != hipSuccess) return;
    Args a{};
    for (int i = 0; i < 15; ++i) a.in[i] = d_in[i];
    a.out = (float*)d_out; a.ws = (unsigned char*)d_ws;
#ifdef DBG_STOP
    for (int p = 0; p < DBG_STOP; ++p) { a.ph_lo = p; a.ph_hi = p + 1; hipLaunchKernelGGL(fwd, dim3(grid), dim3(NTHR), LDS_BYTES, stream, a); }
    {   const DumpItem items[] = { DBG_ITEMS };
        float* scratch = (float*)((unsigned char*)d_ws + WS_RST); int n = 0;
        for (const DumpItem& it : items) { hipLaunchKernelGGL(dbg_rowsum, dim3(256), dim3(512), 0, stream, a, scratch + n, it.off, it.where, it.is_f32, it.rows, it.width, it.pitch); n += it.rows; }
        hipLaunchKernelGGL(dbg_copy, dim3(1024), dim3(512), 0, stream, (const float*)scratch, (float*)d_out, n, out_size); }
#elif MK_ONE_LAUNCH
    a.ph_lo = 0; a.ph_hi = N_PHASES;
    hipLaunchKernelGGL(fwd, dim3(grid), dim3(NTHR), LDS_BYTES, stream, a);
#else
    for (int p = 0; p < N_PHASES; ++p) { a.ph_lo = p; a.ph_hi = p + 1; hipLaunchKernelGGL(fwd, dim3(grid), dim3(NTHR), LDS_BYTES, stream, a); }
#endif
}
```

```cpp
#define MK_ONE_LAUNCH 1
#include <hip/hip_runtime.h>
#include <cstdio>
#include <cstdint>
#include <cmath>

namespace pg8 {
#define PG8_LAS __attribute__((address_space(3)))
typedef unsigned short bf16_t;
typedef short bf16x8 __attribute__((ext_vector_type(8)));
typedef float f32x4 __attribute__((ext_vector_type(4)));
typedef unsigned u32x4 __attribute__((ext_vector_type(4)));
typedef unsigned u32x2 __attribute__((ext_vector_type(2)));
constexpr int BM = 256, BK = 64, HALF = 128, HTB = HALF * BK * 2  , STAGE_BYTES = 8 * HTB, NXCD = 8, WGM = 8;

__host__ __device__ __forceinline__ int lds_byte(int r, int c) { const int st = (r >> 4) * 2 + (c >> 5), rr = r & 15, cc = c & 31, ob = rr * 64 + cc * 2; return st * 1024 + (ob ^ (((ob >> 9) & 1) << 5)); }
__host__ __device__ __forceinline__ void stage_rc(int b, int& R, int& C) { const int st = b / 1024, sb = b % 1024, swz = sb ^ (((sb >> 9) & 1) << 5); R = (st >> 1) * 16 + swz / 64; C = (st & 1) * 32 + (swz % 64) / 2; }
__host__ __device__ __forceinline__ int perm32(int rho) { const int n = rho >> 4, i = rho & 15; return 8 * (i >> 2) + 4 * n + (i & 3); }

struct Unit { int pm, pn, ks, par, ty; };
struct Gemm { const bf16_t* A; const bf16_t* Bt; int lda, ldb, K; };

struct StaticOrder {
    int nM, nN, nwg, G, c;
    __host__ __device__ void init(int M, int N, int G_, int c_) { nM = M / BM; nN = N / BM; nwg = nM * nN; G = G_; c = c_; }
    __host__ __device__ bool tile(int i, Unit& u) const {
        const long L = (long)i * G + c; if (L >= nwg) return false;
        int wgid = (int)L; { const int q = nwg / NXCD, r = nwg % NXCD, xcd = wgid % NXCD, off = wgid / NXCD; wgid = (xcd < r ? xcd * (q + 1) : r * (q + 1) + (xcd - r) * q) + off; }
        const int nig = WGM * nN, gid = wgid / nig, fm = gid * WGM, gsz = (nM - fm) < WGM ? (nM - fm) : WGM;
        u.pm = fm + ((wgid % nig) % gsz); u.pn = (wgid % nig) / gsz; u.ks = 0; u.ty = 0; return true;
    }
    __host__ __device__ bool next(int i, Unit& u) const { return tile(i, u); }
    __device__ __forceinline__ void a_ready(const Unit&) const {}
    __device__ __forceinline__ void done(const Unit&) const {}
};
struct MapOrder {
    StaticOrder b; int from, add;
    __host__ __device__ bool next(int i, Unit& u) const { if (!b.tile(i, u)) return false; if (u.pn >= from) u.pn += add; return true; }
    __device__ __forceinline__ void a_ready(const Unit&) const {}
    __device__ __forceinline__ void done(const Unit&) const {}
};
struct GateOrder {
    StaticOrder b;
    __host__ __device__ bool next(int i, Unit& u) const { if (!b.tile(i / 3, u)) return false; u.pn = 14 + 4 * (i % 3) + u.pn; u.ty = i; return true; }
    __device__ __forceinline__ void a_ready(const Unit&) const {}
    __device__ __forceinline__ void done(const Unit&) const {}
};
template <int NSEG> struct SegOrder {
    StaticOrder b;
    __host__ __device__ bool next(int i, Unit& u) const { if (!b.tile(i / NSEG, u)) return false; u.ks = i % NSEG; u.ty = i / NSEG; return true; }
    __device__ __forceinline__ void a_ready(const Unit&) const {}
    __device__ __forceinline__ void done(const Unit&) const {}
};

__device__ __forceinline__ unsigned cvt_pk_bf16(float lo, float hi) { unsigned r; asm volatile("s_nop 0\n\tv_cvt_pk_bf16_f32 %0, %1, %2" : "=v"(r) : "v"(lo), "v"(hi)); return r; }

template <class Epi, class Sched, bool ALIGN_EPI>
__device__ __forceinline__ void gemm_phase(PG8_LAS unsigned char* lds, const Gemm g, const Sched& S, const Epi& E) {
    int tid_ = threadIdx.x; asm volatile("" : "+v"(tid_));
    const int tid = tid_, wid = __builtin_amdgcn_readfirstlane(tid >> 6), lane = tid & 63, wr = wid >> 2, wc = wid & 3, fr = lane & 15, fq = lane >> 4;
    const int K = g.K, nt = K / BK;
    unsigned voffA[2], voffB[2];
#pragma unroll
    for (int i = 0; i < 2; ++i) { int R, C; stage_rc(tid * 16 + i * 8192, R, C); const int Rb = Epi::PERM ? ((R & ~31) + perm32(R & 31)) : R;
        voffA[i] = (unsigned)(R * g.lda + C) * 2u; voffB[i] = (unsigned)(Rb * g.ldb + C) * 2u; }
    const size_t kstep = (size_t)(BK * 2);
    const size_t hstepA = (size_t)HALF * g.lda * 2, hstepB = (size_t)HALF * g.ldb * 2;
    const size_t tstepA = 2 * hstepA, tstepB = 2 * hstepB;
    const size_t ksb = (size_t)K * 2;
    const unsigned ldsw = (unsigned)wid * 1024u;
    const int aoff = lds_byte(wr * 64 + fr, fq * 8), boff = lds_byte(wc * 32 + fr, fq * 8);
#define PG8_SA(b, h) (((b) * 2 + (h)) * HTB)
#define PG8_SB(b, h) ((4 + (b) * 2 + (h)) * HTB)
#define PG8_STAGE(bufoff, gbase, voff) do { _Pragma("unroll") for (int _i = 0; _i < 2; ++_i) \
        __builtin_amdgcn_global_load_lds((const unsigned*)((const char*)(gbase) + (voff)[_i]), (PG8_LAS unsigned*)(lds + (bufoff) + ldsw + _i * 8192), 16, 0, 0); } while (0)
#define PG8_LDA(dst, b, h) do { _Pragma("unroll") for (int m = 0; m < 4; ++m) _Pragma("unroll") for (int k = 0; k < 2; ++k) dst[m][k] = *(const PG8_LAS bf16x8*)(lds + PG8_SA(b, h) + aoff + m * 2048 + k * 1024); } while (0)
#define PG8_LDB(dst, b, h) do { _Pragma("unroll") for (int n = 0; n < 2; ++n) _Pragma("unroll") for (int k = 0; k < 2; ++k) dst[n][k] = *(const PG8_LAS bf16x8*)(lds + PG8_SB(b, h) + boff + n * 2048 + k * 1024); } while (0)
#define PG8_MMA(ai, bj, At, Bt) do { __builtin_amdgcn_s_setprio(1); _Pragma("unroll") for (int m = 0; m < 4; ++m) _Pragma("unroll") for (int n = 0; n < 2; ++n) _Pragma("unroll") for (int k = 0; k < 2; ++k) \
        acc[ai][bj][m][n] = __builtin_amdgcn_mfma_f32_16x16x32_bf16(Bt[n][k], At[m][k], acc[ai][bj][m][n], 0, 0, 0); __builtin_amdgcn_s_setprio(0); } while (0)
#define PG8_WAIT_V(n) asm volatile("s_waitcnt vmcnt(" #n ")" ::: "memory")
#define PG8_WAIT_L(n) asm volatile("s_waitcnt lgkmcnt(" #n ")" ::: "memory")
#define PG8_BAR __builtin_amdgcn_s_barrier()
#define PG8_SCHED __builtin_amdgcn_sched_barrier(0)
    Unit cur, nxt; int ui = 0;
    if (!S.next(0, cur)) return;
    f32x4 acc[2][2][4][2];
#pragma unroll
    for (int a = 0; a < 2; ++a)
#pragma unroll
        for (int b = 0; b < 2; ++b)
#pragma unroll
            for (int m = 0; m < 4; ++m)
#pragma unroll
                for (int n = 0; n < 2; ++n) acc[a][b][m][n] = (f32x4){0.f, 0.f, 0.f, 0.f};
    bf16x8 At[4][2], B0[2][2], B1[2][2];
    const char* cA = (const char*)g.A + (size_t)cur.pm * tstepA + (size_t)cur.ks * ksb; const char* cB = (const char*)g.Bt + (size_t)cur.pn * tstepB + (size_t)cur.ks * ksb;
    cur.par = 0; S.a_ready(cur);
    E.prefetch(cur, lds, tid);
    PG8_STAGE(PG8_SB(0, 0), cB, voffB); PG8_STAGE(PG8_SB(0, 1), cB + hstepB, voffB); PG8_STAGE(PG8_SA(0, 0), cA, voffA); PG8_STAGE(PG8_SA(0, 1), cA + hstepA, voffA);
    if (wr == 1) PG8_BAR;
    PG8_WAIT_V(2); PG8_BAR;
    PG8_STAGE(PG8_SB(1, 0), cB + kstep, voffB); PG8_STAGE(PG8_SA(1, 0), cA + kstep, voffA); PG8_STAGE(PG8_SB(1, 1), cB + hstepB + kstep, voffB);
    PG8_WAIT_V(6); PG8_BAR;
    for (;;) {
        const bool has_next = S.next(ui + 1, nxt);
        const char* nA = has_next ? (const char*)g.A + (size_t)nxt.pm * tstepA + (size_t)nxt.ks * ksb : cA; const char* nB = has_next ? (const char*)g.Bt + (size_t)nxt.pn * tstepB + (size_t)nxt.ks * ksb : cB;
#pragma nounroll
        for (int t = 0; t < nt; t += 2) {
            const bool last = (t == nt - 2);
            const char* a1 = cA + (size_t)(t + 1) * kstep;
            const char* a2 = last ? nA : cA + (size_t)(t + 2) * kstep; const char* b2 = last ? nB : cB + (size_t)(t + 2) * kstep;
            const char* a3 = a2 + kstep; const char* b3 = b2 + kstep;
            if (last && has_next) S.a_ready(nxt);
            PG8_LDB(B0, 0, 0); PG8_LDB(B1, 0, 1); PG8_SCHED; PG8_LDA(At, 0, 0); PG8_STAGE(PG8_SA(1, 1), a1 + hstepA, voffA);
            PG8_WAIT_V(8); PG8_WAIT_L(0); PG8_BAR; PG8_MMA(0, 0, At, B0); PG8_MMA(0, 1, At, B1); PG8_BAR; PG8_SCHED;
            PG8_LDA(At, 0, 1); PG8_STAGE(PG8_SB(0, 0), b2, voffB); PG8_STAGE(PG8_SB(0, 1), b2 + hstepB, voffB); PG8_STAGE(PG8_SA(0, 0), a2, voffA);
            PG8_WAIT_V(8); PG8_WAIT_L(0); PG8_BAR; PG8_MMA(1, 0, At, B0); PG8_MMA(1, 1, At, B1); PG8_BAR; PG8_SCHED;
            PG8_LDB(B0, 1, 0); PG8_LDB(B1, 1, 1); PG8_SCHED; PG8_LDA(At, 1, 0); PG8_STAGE(PG8_SA(0, 1), a2 + hstepA, voffA);
            PG8_WAIT_V(8); PG8_WAIT_L(0); PG8_BAR; PG8_MMA(0, 0, At, B0); PG8_MMA(0, 1, At, B1); PG8_BAR; PG8_SCHED;
            PG8_LDA(At, 1, 1); PG8_STAGE(PG8_SB(1, 0), b3, voffB); PG8_STAGE(PG8_SB(1, 1), b3 + hstepB, voffB); PG8_STAGE(PG8_SA(1, 0), a3, voffA);
            PG8_WAIT_V(8); PG8_WAIT_L(0); PG8_BAR; PG8_MMA(1, 0, At, B0); PG8_MMA(1, 1, At, B1); PG8_BAR; PG8_SCHED;
        }
        if constexpr (ALIGN_EPI) { if (wr == 0) PG8_BAR; }
        E(acc, cur, wr, wc, fr, fq); S.done(cur);
        if (!has_next) break;
        if (!E.keep(cur)) {
#pragma unroll
        for (int a = 0; a < 2; ++a)
#pragma unroll
            for (int b = 0; b < 2; ++b)
#pragma unroll
                for (int m = 0; m < 4; ++m)
#pragma unroll
                    for (int n = 0; n < 2; ++n) acc[a][b][m][n] = (f32x4){0.f, 0.f, 0.f, 0.f};
        }
        cur = nxt; cur.par = (ui + 1) & 1; cA = nA; cB = nB; ++ui;
        E.prefetch(cur, lds, tid);
        if constexpr (ALIGN_EPI) { if (wr == 1) PG8_BAR; }
    }
    PG8_WAIT_V(0);
    if constexpr (!ALIGN_EPI) { if (wr == 0) PG8_BAR; }
    PG8_BAR;
#undef PG8_SA
#undef PG8_SB
#undef PG8_STAGE
#undef PG8_LDA
#undef PG8_LDB
#undef PG8_MMA
#undef PG8_WAIT_V
#undef PG8_WAIT_L
#undef PG8_BAR
#undef PG8_SCHED
}
}

constexpr int NWAVES = 8, NTHR = NWAVES * 64;
constexpr int BATCH = 8, SEQ = 4096, DM = 1024, DEPTH = 4, DFF = 4096;
constexpr int MTOT = BATCH * SEQ;
constexpr int NHALF = 1, MH = MTOT / NHALF, BH = BATCH / NHALF;
constexpr int NHEAD = 8;
constexpr int D_IN = 7328, NIN = 7424;
constexpr int NC = 768;
constexpr int NQ = 768, NKV = 1024;
constexpr float EPS = 1e-6f;
constexpr float QSCALE = 0.10206207261596575f * 1.4426950408889634f;

constexpr size_t MiB = 1u << 20;
constexpr size_t WS_CTL = 0, CTL_ZERO_BYTES = 1 * MiB;
constexpr size_t WS_SSQ = 1 * MiB, SSQ_ZERO_BYTES = 5 * MiB;
constexpr size_t WS_SSQX = WS_SSQ;
constexpr size_t WS_SSQQ = WS_SSQX + 9 * (size_t)MTOT * 8;
constexpr size_t WS_SSQKV = WS_SSQQ + 4 * (size_t)MTOT * 8;
static_assert(WS_SSQKV + 4 * (size_t)MTOT * 8 <= WS_SSQ + SSQ_ZERO_BYTES, "accumulators inside the memset region");
constexpr size_t WS_COSR = 6 * MiB, WS_SINR = 10 * MiB, WS_COSM = 14 * MiB, WS_SINM = 16 * MiB;
constexpr size_t WS_XB = 18 * MiB;
constexpr size_t WS_W = 82 * MiB;
constexpr size_t W_IN = 0, W_UQ = W_IN + (size_t)NIN * DM * 2, W_UKV = W_UQ + (size_t)NQ * 384 * 2, W_B = W_UKV + (size_t)NKV * 256 * 2,
                 W_OUT = W_B + (size_t)DM * 1536 * 2, W_UP = W_OUT + (size_t)DM * DM * 2, W_DN = W_UP + (size_t)DFF * DM * 2, W_END = W_DN + (size_t)DM * DFF * 2;
static_assert(W_END <= 40 * MiB, "weights region");
constexpr size_t WS_Y = 122 * MiB;
constexpr size_t WS_C = 218 * MiB;
constexpr size_t WS_SBK = 266 * MiB, WS_SBV = 298 * MiB;
constexpr size_t WS_RK = 330 * MiB, WS_RV = 362 * MiB, WS_RG = 394 * MiB;
constexpr size_t WS_RST = 426 * MiB;
constexpr size_t WS_QM = 266 * MiB;
constexpr size_t WS_KVM = 314 * MiB;
constexpr size_t WS_GATES = 218 * MiB;
constexpr size_t WS_MG = 410 * MiB;
constexpr size_t WS_H = 122 * MiB;
constexpr size_t WS_KPE = 474 * MiB;
constexpr size_t WS_PREVB = 476 * MiB;
constexpr size_t WS_END = 492 * MiB;
static_assert(WS_QM + (size_t)MH * NQ * 2 <= WS_KVM && WS_KVM + (size_t)MH * NKV * 2 <= WS_RG && WS_GATES + (size_t)MH * 3072 * 2 <= WS_MG && WS_MG + (size_t)MH * DM * 2 <= WS_KPE
              && WS_H + (size_t)MH * DFF * 2 <= WS_MG && WS_RG + (size_t)MH * 512 * 2 <= WS_RST && WS_RST + 32 * MiB <= WS_END && WS_Y + (size_t)MH * 1536 * 2 <= WS_C, "d_ws map");
constexpr int CW_BAR = 4096;

constexpr int RING_OFF = 0, RING_BYTES = 131072;
constexpr int LDSCTL_OFF = RING_BYTES, MISC_OFF = LDSCTL_OFF + 320;
constexpr int LDS_BYTES = 147456;

#define GAS __attribute__((address_space(1)))
#define LAS __attribute__((address_space(3)))
typedef unsigned short bf16;
typedef unsigned v4u __attribute__((ext_vector_type(4)));
typedef float f32x4 __attribute__((ext_vector_type(4)));
typedef GAS unsigned gu32;
#define RLX_AGENT __ATOMIC_RELAXED, __HIP_MEMORY_SCOPE_AGENT
#define LDS_WAIT() asm volatile("s_waitcnt lgkmcnt(0)" ::: "memory")
#define VM_WAIT() asm volatile("s_waitcnt vmcnt(0)" ::: "memory")
__device__ __forceinline__ unsigned f2bf(float f) { unsigned u = __builtin_bit_cast(unsigned, f); return (u + 0x7fffu + ((u >> 16) & 1u)) >> 16; }
__device__ __forceinline__ unsigned pk2(float lo, float hi) { return f2bf(lo) | (f2bf(hi) << 16); }
__device__ __forceinline__ float bflo(unsigned w) { return __uint_as_float(w << 16); }
__device__ __forceinline__ float bfhi(unsigned w) { return __uint_as_float(w & 0xffff0000u); }

#define XB_TMO      128
#define XB_XCNT(j)  (256  + 64 * (j))
#define XB_XSUB(j)  (1280 + 64 * (j))
#define XB_XGEN(j)  (2304 + 64 * (j))
#define XB_TOP      3328
#define XB_TOPGEN   3392
#define XCD_BAR_WORDS 3456
#define XB_SPIN_CAP (1u << 18)

__device__ __forceinline__ unsigned xb_ld(unsigned* p)              { return __hip_atomic_load(p, __ATOMIC_RELAXED, __HIP_MEMORY_SCOPE_AGENT); }
__device__ __forceinline__ unsigned xb_add(unsigned* p, unsigned v) { return __hip_atomic_fetch_add(p, v, __ATOMIC_RELAXED, __HIP_MEMORY_SCOPE_AGENT); }
__device__ __forceinline__ unsigned xb_xcc_id() { return (unsigned)__builtin_amdgcn_s_getreg((3 << 11) | 20) & 0xFu; }
#define XB_SPIN(cond, bar) do { unsigned _sp = 0; while (cond) { __builtin_amdgcn_s_sleep(1); \
    if ((++_sp & 255u) == 0u) { if (xb_ld(&(bar)[XB_TMO])) break; if (_sp > XB_SPIN_CAP) { atomicAdd(&(bar)[XB_TMO], 1u); break; } } } } while (0)

struct XcdBarrier {
    unsigned* bar; unsigned x;
    volatile LAS unsigned* st;
};
__device__ __forceinline__ XcdBarrier xcd_barrier_post(unsigned* bar, volatile LAS unsigned* st) {
    XcdBarrier b; b.bar = bar; b.x = xb_xcc_id(); b.st = st;
    if (threadIdx.x == 0) (void)xb_add(&bar[XB_XCNT(b.x)], 1u);
    return b;
}
__device__ __forceinline__ void xcd_barrier_complete(unsigned* bar, unsigned x, unsigned& nloc, unsigned& nx) {
    const unsigned G = gridDim.x * gridDim.y * gridDim.z;
    unsigned sum, cnt, mine, sp = 0u;
    for (;;) {
        sum = 0u; cnt = 0u; mine = 0u;
#pragma unroll
        for (unsigned j = 0; j < 16; ++j) { const unsigned c = xb_ld(&bar[XB_XCNT(j)]); sum += c; cnt += (c > 0u) ? 1u : 0u; mine = (j == x) ? c : mine; }
        if (sum == G) break;
        __builtin_amdgcn_s_sleep(1);
        if ((++sp & 255u) == 0u) { if (xb_ld(&bar[XB_TMO])) break; if (sp > XB_SPIN_CAP) { atomicAdd(&bar[XB_TMO], 1u); break; } }
    }
    nloc = mine > 0u ? mine : 1u; nx = cnt > 0u ? cnt : 1u;
}
__device__ __forceinline__ void xcd_barrier(const XcdBarrier& b) {
    asm volatile("s_waitcnt vmcnt(0)" ::: "memory");
    __syncthreads();
    if (threadIdx.x == 0) {
        unsigned* bar = b.bar;
        __builtin_amdgcn_s_waitcnt(0);
        unsigned nloc = b.st[0], nx = b.st[1];
        if (nloc == 0u) { xcd_barrier_complete(bar, b.x, nloc, nx); b.st[0] = nloc; b.st[1] = nx; }
        const unsigned old = xb_add(&bar[XB_XSUB(b.x)], 1u);
        const unsigned gen = old / nloc;
        if (old + 1u == (gen + 1u) * nloc) {
            __builtin_amdgcn_fence(__ATOMIC_RELEASE, "agent");
            asm volatile("s_waitcnt vmcnt(0)" ::: "memory");
            const unsigned og = xb_add(&bar[XB_TOP], 1u);
            const unsigned tg = og / nx;
            if (og + 1u == (tg + 1u) * nx) xb_add(&bar[XB_TOPGEN], 1u);
            else XB_SPIN(xb_ld(&bar[XB_TOPGEN]) == tg, bar);
            __builtin_amdgcn_fence(__ATOMIC_ACQUIRE, "agent");
            xb_add(&bar[XB_XGEN(b.x)], 1u);
            asm volatile("s_waitcnt vmcnt(0)" ::: "memory");
        } else {
            XB_SPIN(xb_ld(&bar[XB_XGEN(b.x)]) == gen, bar);
            __builtin_amdgcn_fence(__ATOMIC_ACQUIRE, "agent");
            asm volatile("s_waitcnt vmcnt(0)" ::: "memory");
        }
    }
    __syncthreads();
}

struct Args { const void* in[15]; float* out; unsigned char* ws; int ph_lo, ph_hi; };
struct Frame {
    LAS unsigned char* lds;
    int tid, lane, wave, G;
    unsigned char* ws;
};

__device__ __forceinline__ float wave_sum(float v) {
#pragma unroll
    for (int o = 1; o < 64; o <<= 1) v += __shfl_xor(v, o);
    return v;
}
typedef unsigned long long u64;
__device__ __forceinline__ void ssq_add(u64* p, float s) { atomicAdd(p, (u64)(s * 16777216.f + 0.5f)); }
__device__ __forceinline__ float ssq_get(const u64* p) { return (float)(*p) * (1.f / 16777216.f); }
__device__ __forceinline__ int vzero() { int z; asm volatile("v_mov_b32 %0, 0" : "=v"(z)); return z; }

template <int MAP> __device__ __forceinline__ int src_col(int n) {
    if constexpr (MAP == 0) return n;
    else if constexpr (MAP == 1) {
        if (n < 512) return 672 + n;
        if (n < 1024) return 1184 + (n - 512);
        if (n < 1536) return 1696 + (n - 1024);
        if (n < 2048) { const int c = n - 1536; return 2208 + (c & ~63) + ((c & 63) >> 1) + 32 * (c & 1); }
        if (n < 2560) { const int c = n - 2048; return 2720 + (c & ~63) + ((c & 63) >> 1) + 32 * (c & 1); }
        if (n < 3072) return 3232 + (n - 2560);
        if (n < 3584) return 3744 + (n - 3072);
        if (n < 6656) return 4256 + (n - 3584);
        if (n < 7040) return n - 6656;
        if (n < 7296) return 384 + (n - 7040);
        if (n < 7328) { const int j = n - 7296; return 640 + (j >> 1) + 16 * (j & 1); }
        return -1;
    } else {
        const int h = n / 96, hc = n % 96; if (hc < 64) return n; const int j = hc - 64; return h * 96 + 64 + (j >> 1) + 16 * (j & 1);
    }
}
template <int MAP> __device__ __forceinline__ void transpose_item(const float* W, int Nsrc, int Ndst, const float* gain, bf16* WT, int pitch, int koff, LAS float* scr, int item, int lane) {
    const int nblk = Ndst / 32, kb = item / nblk, nb = item % nblk, k0 = 64 * kb, n0 = 32 * nb;
    const int sc = src_col<MAP>(n0 + (lane & 31));
    float wv[32], gv[32];
#pragma unroll
    for (int i = 0; i < 32; ++i) { const int kk = 2 * i + (lane >> 5); wv[i] = (sc >= 0) ? W[(size_t)(k0 + kk) * Nsrc + sc] : 0.f; gv[i] = gain ? gain[k0 + kk] : 1.f; }
#pragma unroll
    for (int i = 0; i < 32; ++i) { const int kk = 2 * i + (lane >> 5); scr[kk * 33 + (lane & 31)] = wv[i] * gv[i]; }
    LDS_WAIT(); asm volatile("" ::: "memory");
    const int c = lane & 7;
#pragma unroll
    for (int j = 0; j < 4; ++j) { const int n = (lane >> 3) + 8 * j; const LAS float* s = scr + (8 * c) * 33 + n;
        v4u o; o.x = pk2(s[0 * 33], s[1 * 33]); o.y = pk2(s[2 * 33], s[3 * 33]); o.z = pk2(s[4 * 33], s[5 * 33]); o.w = pk2(s[6 * 33], s[7 * 33]);
        *(GAS v4u*)(WT + (size_t)(n0 + n) * pitch + koff + k0 + 8 * c) = o; }
    LDS_WAIT(); asm volatile("" ::: "memory");
}

#ifdef EPI_FENCED
#define EPI_FENCE asm volatile("" ::: "memory")
#else
#define EPI_FENCE
#endif
using pg8::Unit; using pg8::bf16_t; using pg8::u32x4; using pg8::cvt_pk_bf16;
typedef float accT[2][2][4][2] __attribute__((unused));
__device__ __forceinline__ u32x4 pack8(const float (&v)[8]) { u32x4 w; w.x = cvt_pk_bf16(v[0], v[1]); w.y = cvt_pk_bf16(v[2], v[3]); w.z = cvt_pk_bf16(v[4], v[5]); w.w = cvt_pk_bf16(v[6], v[7]); return w; }
__device__ __forceinline__ float sigmoidf_(float x) { return __builtin_amdgcn_rcpf(1.f + __expf(-x)); }

constexpr int ROWTAB_OFF = 132 * 1024;
__device__ __forceinline__ void rowtab_stage(const u64* ssq_rows, const Unit& u, PG8_LAS unsigned char* lds, int tid) {
    const int w = __builtin_amdgcn_readfirstlane(tid >> 6);
    __builtin_amdgcn_global_load_lds((const unsigned*)(ssq_rows + (size_t)u.pm * 256) + tid, (PG8_LAS unsigned*)(lds + ROWTAB_OFF + u.par * 2048 + w * 256), 4, 0, 0);
}
__device__ __forceinline__ float rowtab_get(PG8_LAS unsigned char* lds, const Unit& u, int rit) {
    const pg8::u32x2 w = *(const PG8_LAS pg8::u32x2*)(lds + ROWTAB_OFF + u.par * 2048 + rit * 8);
    return fmaf((float)w.y, 256.f, (float)w.x * (1.f / 16777216.f));
}
__device__ __forceinline__ float rowtab_rstd(PG8_LAS unsigned char* lds, const Unit& u, int rit, float invn) { return __builtin_amdgcn_rsqf(fmaf(rowtab_get(lds, u, rit), invn, EPS)); }
__device__ __forceinline__ pg8::f32x4 vmax0(pg8::f32x4 a) { return __builtin_elementwise_max(a, (pg8::f32x4){0.f, 0.f, 0.f, 0.f}); }
__device__ __forceinline__ pg8::f32x4 vminc(pg8::f32x4 a, float c) { return __builtin_elementwise_min(a, (pg8::f32x4){c, c, c, c}); }
__device__ __forceinline__ pg8::f32x4 vexp2(pg8::f32x4 a) { return (pg8::f32x4){__builtin_amdgcn_exp2f(a.x), __builtin_amdgcn_exp2f(a.y), __builtin_amdgcn_exp2f(a.z), __builtin_amdgcn_exp2f(a.w)}; }
__device__ __forceinline__ pg8::f32x4 vrcp(pg8::f32x4 a) { return (pg8::f32x4){__builtin_amdgcn_rcpf(a.x), __builtin_amdgcn_rcpf(a.y), __builtin_amdgcn_rcpf(a.z), __builtin_amdgcn_rcpf(a.w)}; }
__device__ __forceinline__ unsigned cvt_pk_bf16_cc(float lo, float hi) {
    typedef float f32x2_t __attribute__((ext_vector_type(2))); typedef __bf16 bf16x2_t __attribute__((ext_vector_type(2)));
    const f32x2_t f = {lo, hi}; return __builtin_bit_cast(unsigned, __builtin_convertvector(f, bf16x2_t));
}
__device__ __forceinline__ u32x4 pack8v(pg8::f32x4 a, pg8::f32x4 b) { u32x4 w; w.x = cvt_pk_bf16_cc(a.x, a.y); w.y = cvt_pk_bf16_cc(a.z, a.w); w.z = cvt_pk_bf16_cc(b.x, b.y); w.w = cvt_pk_bf16_cc(b.z, b.w); return w; }
__device__ __forceinline__ pg8::f32x4 vsigm_t(pg8::f32x4 t) { return vrcp(vexp2(vminc(t, 86.f)) + 1.f); }
__device__ __forceinline__ pg8::f32x4 vsigden_t(pg8::f32x4 t) { return vexp2(vminc(t, 86.f)) + 1.f; }
constexpr float NLOG2E = -1.4426950408889634f;

struct EpiIn {
    static constexpr bool PERM = true;
    const u64* ssq; int grow0;
    unsigned char* ws; PG8_LAS unsigned char* ldsb;
    const float *cosR, *sinR, *cosM, *sinM;
    u64 *ssqq, *ssqkv;
    __device__ __forceinline__ bool keep(const Unit&) const { return false; }
    __device__ __forceinline__ void prefetch(const Unit& u, PG8_LAS unsigned char* lds, int tid) const { rowtab_stage(ssq + grow0, u, lds, tid); }
    template <int MODE> __device__ __forceinline__ void run(pg8::f32x4 (&acc)[2][2][4][2], const Unit& u, int wr, int wc, int fr, int fq, bf16_t* dst, int pitch, int col0, float scale) const {
        const int lrow0 = u.pm * 256 + wr * 64 + fr, cw = wc * 32 + 8 * fq;
#pragma unroll
        for (int ai = 0; ai < 2; ++ai)
#pragma unroll
            for (int m = 0; m < 4; ++m) { EPI_FENCE;
                const int lrow = lrow0 + ai * 128 + m * 16, grow = grow0 + lrow;
                const float rs = rowtab_rstd(ldsb, u, lrow - u.pm * 256, 1.f / 1024.f) * (MODE <= 1 ? scale : 1.f);
#pragma unroll
                for (int bj = 0; bj < 2; ++bj) {
                    const int ct = bj * 128 + cw;
                    const pg8::f32x4 a0 = acc[ai][bj][m][0] * rs, a1 = acc[ai][bj][m][1] * rs;
                    bf16_t* p = dst + (size_t)lrow * pitch + col0 + ct;
                    if constexpr (MODE == 0) { *(u32x4*)p = pack8v(a0, a1); continue; }
                    if constexpr (MODE == 2) { *(u32x4*)p = pack8v(a0 * vrcp(vexp2(a0 * NLOG2E) + 1.f), a1 * vrcp(vexp2(a1 * NLOG2E) + 1.f)); continue; }
                    float v[8];
#pragma unroll
                    for (int j = 0; j < 4; ++j) { v[j] = a0[j]; v[4 + j] = a1[j]; }
                    if constexpr (MODE == 1) {
                        const int i0 = (ct & 63) >> 1;
                        const pg8::f32x4 c4 = *(const pg8::f32x4*)(cosR + (size_t)grow * 32 + i0), s4 = *(const pg8::f32x4*)(sinR + (size_t)grow * 32 + i0);
#pragma unroll
                        for (int j = 0; j < 4; ++j) { const float x1 = v[2 * j], x2 = v[2 * j + 1]; v[2 * j] = x1 * c4[j] - x2 * s4[j]; v[2 * j + 1] = x2 * c4[j] + x1 * s4[j]; }
                    } else if constexpr (MODE == 4) {
                        const int cb = col0 + bj * 128 + wc * 32;
                        if (cb < 640) {
                            float s = 0.f;
#pragma unroll
                            for (int j = 0; j < 8; ++j) s += v[j] * v[j];
                            s += __shfl_xor(s, 16); s += __shfl_xor(s, 32);
                            if (fq == 0) ssq_add((cb < 384 ? ssqq : ssqkv) + lrow, s);
                        } else if (cb < 672) {
                            const int i0 = 4 * fq;
                            const pg8::f32x4 c4 = *(const pg8::f32x4*)(cosM + (size_t)grow * 16 + i0), s4 = *(const pg8::f32x4*)(sinM + (size_t)grow * 16 + i0);
#pragma unroll
                            for (int j = 0; j < 4; ++j) { const float x1 = v[2 * j], x2 = v[2 * j + 1]; v[2 * j] = x1 * c4[j] - x2 * s4[j]; v[2 * j + 1] = x2 * c4[j] + x1 * s4[j]; }
                            p = (bf16_t*)(ws + WS_KPE) + (size_t)lrow * 32 + 8 * fq;
                        } else continue;
                    }
                    *(u32x4*)p = pack8(v);
                }
            }
    }
    __device__ __forceinline__ void run_rope(pg8::f32x4 (&acc)[2][2][4][2], const Unit& u, int wr, int wc, int fr, int fq, bf16_t* dst, int pitch, int col0, float scale) const {
        const int lrow0 = u.pm * 256 + wr * 64 + fr, cw = wc * 32 + 8 * fq, i0 = (cw & 63) >> 1;
#pragma unroll
        for (int ai = 0; ai < 2; ++ai) {
            pg8::f32x4 c4[4], s4[4];
#pragma unroll
            for (int m = 0; m < 4; ++m) { const size_t grow = (size_t)(grow0 + lrow0 + ai * 128 + m * 16); c4[m] = *(const pg8::f32x4*)(cosR + grow * 32 + i0); s4[m] = *(const pg8::f32x4*)(sinR + grow * 32 + i0); }
            asm volatile("" ::: "memory");
#pragma unroll
            for (int m = 0; m < 4; ++m) {
                const int lrow = lrow0 + ai * 128 + m * 16;
                const float rs = rowtab_rstd(ldsb, u, lrow - u.pm * 256, 1.f / 1024.f) * scale;
#pragma unroll
                for (int bj = 0; bj < 2; ++bj) {
                    const pg8::f32x4 a0 = acc[ai][bj][m][0] * rs, a1 = acc[ai][bj][m][1] * rs;
                    float v[8];
#pragma unroll
                    for (int j = 0; j < 4; ++j) { v[j] = a0[j]; v[4 + j] = a1[j]; }
#pragma unroll
                    for (int j = 0; j < 4; ++j) { const float x1 = v[2 * j], x2 = v[2 * j + 1]; v[2 * j] = x1 * c4[m][j] - x2 * s4[m][j]; v[2 * j + 1] = x2 * c4[m][j] + x1 * s4[m][j]; }
                    *(u32x4*)(dst + (size_t)lrow * pitch + col0 + bj * 128 + cw) = pack8(v);
                }
            }
            asm volatile("" ::: "memory");
        }
    }
    __device__ __forceinline__ void operator()(pg8::f32x4 (&acc)[2][2][4][2], const Unit& u, int wr, int wc, int fr_, int fq_) const {
        int fr = fr_, fq = fq_; asm volatile("" : "+v"(fr), "+v"(fq));
        const int pn = u.pn;
        if (pn >= 26) { run<4>(acc, u, wr, wc, fr, fq, (bf16_t*)(ws + WS_C), NC, (pn - 26) * 256, 1.f); return; }
        const int seg = pn >> 1, c0 = (pn & 1) * 256;
        if (seg == 0) run<0>(acc, u, wr, wc, fr, fq, (bf16_t*)(ws + WS_Y), 1536, c0 + 512, 0.125f * 1.4426950408889634f);
        else if (seg == 1) run<0>(acc, u, wr, wc, fr, fq, (bf16_t*)(ws + WS_SBK), 512, c0, 1.f);
        else if (seg == 2) run<0>(acc, u, wr, wc, fr, fq, (bf16_t*)(ws + WS_SBV), 512, c0, 1.f);
        else if (seg == 3) run_rope(acc, u, wr, wc, fr, fq, (bf16_t*)(ws + WS_Y), 1536, c0 + 1024, 0.125f);
        else if (seg == 4) run_rope(acc, u, wr, wc, fr, fq, (bf16_t*)(ws + WS_RK), 512, c0, 1.f);
        else if (seg == 5) run<0>(acc, u, wr, wc, fr, fq, (bf16_t*)(ws + WS_RV), 512, c0, 1.f);
        else run<2>(acc, u, wr, wc, fr, fq, (bf16_t*)(ws + WS_RG), 512, c0, 1.f);
    }
};

struct EpiUq {
    static constexpr bool PERM = true;
    const u64* ssqq; int grow0; bf16_t* QM; const float *cosM, *sinM; PG8_LAS unsigned char* ldsb;
    __device__ __forceinline__ bool keep(const Unit&) const { return false; }
    __device__ __forceinline__ void prefetch(const Unit& u, PG8_LAS unsigned char* lds, int tid) const { rowtab_stage(ssqq, u, lds, tid); }
    __device__ __forceinline__ void operator()(pg8::f32x4 (&acc)[2][2][4][2], const Unit& u, int wr, int wc, int fr_, int fq_) const {
        int fr = fr_, fq = fq_; asm volatile("" : "+v"(fr), "+v"(fq));
        const int lrow0 = u.pm * 256 + wr * 64 + fr, cw = wc * 32 + 8 * fq;
        int hcb[2];
#pragma unroll
        for (int bj = 0; bj < 2; ++bj) hcb[bj] = (u.pn * 256 + bj * 128 + cw) % 96;
#pragma unroll
        for (int ai = 0; ai < 2; ++ai) {
            pg8::f32x4 c4[4][2], s4[4][2];
#pragma unroll
            for (int m = 0; m < 4; ++m)
#pragma unroll
                for (int bj = 0; bj < 2; ++bj) { const size_t grow = (size_t)(grow0 + lrow0 + ai * 128 + m * 16); const int i0 = hcb[bj] >= 64 ? (hcb[bj] - 64) >> 1 : 0;
                    c4[m][bj] = *(const pg8::f32x4*)(cosM + grow * 16 + i0); s4[m][bj] = *(const pg8::f32x4*)(sinM + grow * 16 + i0); }
            asm volatile("" ::: "memory");
#pragma unroll
            for (int m = 0; m < 4; ++m) {
                const int lrow = lrow0 + ai * 128 + m * 16;
                const float rs = rowtab_rstd(ldsb, u, lrow - u.pm * 256, 1.f / 384.f) * QSCALE;
#pragma unroll
                for (int bj = 0; bj < 2; ++bj) {
                    const int c = u.pn * 256 + bj * 128 + cw;
                    const pg8::f32x4 a0 = acc[ai][bj][m][0] * rs, a1 = acc[ai][bj][m][1] * rs;
                    float v[8];
#pragma unroll
                    for (int j = 0; j < 4; ++j) { v[j] = a0[j]; v[4 + j] = a1[j]; }
                    if (hcb[bj] >= 64) {
#pragma unroll
                        for (int j = 0; j < 4; ++j) { const float x1 = v[2 * j], x2 = v[2 * j + 1]; v[2 * j] = x1 * c4[m][bj][j] - x2 * s4[m][bj][j]; v[2 * j + 1] = x2 * c4[m][bj][j] + x1 * s4[m][bj][j]; }
                    }
                    *(u32x4*)(QM + (size_t)lrow * NQ + c) = pack8(v);
                }
            }
            asm volatile("" ::: "memory");
        }
    }
};
struct EpiUkv {
    static constexpr bool PERM = true;
    const u64* ssqkv; bf16_t* KVM; PG8_LAS unsigned char* ldsb;
    __device__ __forceinline__ bool keep(const Unit&) const { return false; }
    __device__ __forceinline__ void prefetch(const Unit& u, PG8_LAS unsigned char* lds, int tid) const { rowtab_stage(ssqkv, u, lds, tid); }
    __device__ __forceinline__ void operator()(pg8::f32x4 (&acc)[2][2][4][2], const Unit& u, int wr, int wc, int fr_, int fq_) const {
        int fr = fr_, fq = fq_; asm volatile("" : "+v"(fr), "+v"(fq));
        const int lrow0 = u.pm * 256 + wr * 64 + fr, cw = wc * 32 + 8 * fq;
#pragma unroll
        for (int ai = 0; ai < 2; ++ai)
#pragma unroll
            for (int m = 0; m < 4; ++m) { EPI_FENCE;
                const int lrow = lrow0 + ai * 128 + m * 16;
                const float rs = rowtab_rstd(ldsb, u, lrow - u.pm * 256, 1.f / 256.f);
#pragma unroll
                for (int bj = 0; bj < 2; ++bj) {
                    *(u32x4*)(KVM + ((size_t)((lrow >> 12) * NHEAD + u.pn * 2 + bj) * SEQ + (lrow & (SEQ - 1))) * 128 + cw) = pack8v(acc[ai][bj][m][0] * rs, acc[ai][bj][m][1] * rs);
                }
            }
    }
};
struct EpiMerge {
    static constexpr bool PERM = true;
    const bf16_t* G; bf16_t* MG;
    __device__ __forceinline__ bool keep(const Unit& u) const { return u.ks < 2; }
    __device__ __forceinline__ void prefetch(const Unit&, PG8_LAS unsigned char*, int) const {}
    __device__ __forceinline__ void operator()(pg8::f32x4 (&acc)[2][2][4][2], const Unit& u, int wr, int wc, int fr_, int fq_) const {
        int fr = fr_, fq = fq_; asm volatile("" : "+v"(fr), "+v"(fq));
        const int lrow0 = u.pm * 256 + wr * 64 + fr, cw = wc * 32 + 8 * fq, ks = u.ks;
#pragma unroll
        for (int ai = 0; ai < 2; ++ai)
#pragma unroll
            for (int m = 0; m < 4; ++m) { EPI_FENCE;
                const int lrow = lrow0 + ai * 128 + m * 16;
#pragma unroll
                for (int bj = 0; bj < 2; ++bj) {
                    const int d = u.pn * 256 + bj * 128 + cw;
                    const bf16_t* gp = G + (size_t)lrow * 3072 + ks * 1024 + d;
                    const u32x4 ga = *(const u32x4*)gp;
                    float f[8];
#pragma unroll
                    for (int j = 0; j < 4; ++j) { f[2 * j] = bflo(ga[j]); f[2 * j + 1] = bfhi(ga[j]); }
                    if (ks < 2) {
                        const u32x4 gb = *(const u32x4*)(gp + 1024);
#pragma unroll
                        for (int j = 0; j < 4; ++j) { f[2 * j] *= __builtin_amdgcn_rcpf(bflo(gb[j])); f[2 * j + 1] *= __builtin_amdgcn_rcpf(bfhi(gb[j])); }
                    }
#pragma unroll
                    for (int j = 0; j < 4; ++j) { acc[ai][bj][m][0][j] *= f[j]; acc[ai][bj][m][1][j] *= f[4 + j]; }
                    if (ks == 2) {
                        float v[8];
#pragma unroll
                        for (int j = 0; j < 4; ++j) { v[j] = acc[ai][bj][m][0][j]; v[4 + j] = acc[ai][bj][m][1][j]; }
                        *(u32x4*)(MG + (size_t)lrow * DM + d) = pack8(v);
                    }
                }
            }
    }
};
struct EpiGate {
    static constexpr bool PERM = true;
    const u64* ssq; unsigned char* GS; PG8_LAS unsigned char* ldsb;
    __device__ __forceinline__ bool keep(const Unit&) const { return false; }
    __device__ __forceinline__ void prefetch(const Unit& u, PG8_LAS unsigned char* lds, int tid) const { rowtab_stage(ssq, u, lds, tid); }
    __device__ __forceinline__ void operator()(pg8::f32x4 (&acc)[2][2][4][2], const Unit& u, int wr, int wc, int fr_, int fq_) const {
        int fr = fr_, fq = fq_; asm volatile("" : "+v"(fr), "+v"(fq));
        unsigned char* gsw = GS + (size_t)u.ty * 131072 + (size_t)(wr * 4 + wc) * 16384;
        const unsigned lo = (unsigned)(fq * 16 + fr) * 16u;
#pragma unroll
        for (int ai = 0; ai < 2; ++ai)
#pragma unroll
            for (int m = 0; m < 4; ++m) { EPI_FENCE;
                const float rsn = rowtab_rstd(ldsb, u, wr * 64 + fr + ai * 128 + m * 16, 1.f / 1024.f) * NLOG2E;
#pragma unroll
                for (int bj = 0; bj < 2; ++bj) __builtin_nontemporal_store(pack8v(vsigden_t(acc[ai][bj][m][0] * rsn), vsigden_t(acc[ai][bj][m][1] * rsn)), (u32x4*)(gsw + ((ai * 4 + m) * 2 + bj) * 1024 + lo));
            }
    }
};
struct EpiMergeL {
    static constexpr bool PERM = true;
    const unsigned char* GS; bf16_t* MG;
    __device__ __forceinline__ bool keep(const Unit& u) const { return u.ks < 2; }
    __device__ __forceinline__ void prefetch(const Unit&, PG8_LAS unsigned char*, int) const {}
    __device__ __forceinline__ void operator()(pg8::f32x4 (&acc)[2][2][4][2], const Unit& u, int wr, int wc, int fr_, int fq_) const {
        int fr = fr_, fq = fq_; asm volatile("" : "+v"(fr), "+v"(fq));
        const int lrow0 = u.pm * 256 + wr * 64 + fr, cw = wc * 32 + 8 * fq, ks = u.ks;
        const unsigned char* gsw = GS + (size_t)(u.ty * 3 + ks) * 131072 + (size_t)(wr * 4 + wc) * 16384;
        const unsigned lo = (unsigned)(fq * 16 + fr) * 16u;
#pragma unroll
        for (int ai = 0; ai < 2; ++ai) {
            u32x4 ga[4][2], gb[4][2];
#pragma unroll
            for (int m = 0; m < 4; ++m)
#pragma unroll
                for (int bj = 0; bj < 2; ++bj) {
                    const unsigned char* gp = gsw + ((ai * 4 + m) * 2 + bj) * 1024;
                    ga[m][bj] = __builtin_nontemporal_load((const u32x4*)(gp + lo));
                    if (ks < 2) gb[m][bj] = __builtin_nontemporal_load((const u32x4*)(gp + 131072 + lo));
                }
            asm volatile("" ::: "memory");
#pragma unroll
            for (int m = 0; m < 4; ++m) {
                const int lrow = lrow0 + ai * 128 + m * 16;
#pragma unroll
                for (int bj = 0; bj < 2; ++bj) {
                    float f[8];
#pragma unroll
                    for (int j = 0; j < 4; ++j) { f[2 * j] = __builtin_amdgcn_rcpf(bflo(ga[m][bj][j])); f[2 * j + 1] = __builtin_amdgcn_rcpf(bfhi(ga[m][bj][j])); }
                    if (ks < 2) {
#pragma unroll
                        for (int j = 0; j < 4; ++j) { f[2 * j] *= bflo(gb[m][bj][j]); f[2 * j + 1] *= bfhi(gb[m][bj][j]); }
                    }
#pragma unroll
                    for (int j = 0; j < 4; ++j) { acc[ai][bj][m][0][j] *= f[j]; acc[ai][bj][m][1][j] *= f[4 + j]; }
                    if (ks == 2) {
                        float v[8];
#pragma unroll
                        for (int j = 0; j < 4; ++j) { v[j] = acc[ai][bj][m][0][j]; v[4 + j] = acc[ai][bj][m][1][j]; }
                        *(u32x4*)(MG + (size_t)lrow * DM + u.pn * 256 + bj * 128 + cw) = pack8(v);
                    }
                }
            }
            asm volatile("" ::: "memory");
        }
    }
};
struct EpiResid {
    static constexpr bool PERM = true;
    bf16_t* XB; u64* ssq_next; int grow0;
    __device__ __forceinline__ bool keep(const Unit&) const { return false; }
    __device__ __forceinline__ void prefetch(const Unit&, PG8_LAS unsigned char*, int) const {}
    __device__ __forceinline__ void operator()(pg8::f32x4 (&acc)[2][2][4][2], const Unit& u, int wr, int wc, int fr_, int fq_) const {
        int fr = fr_, fq = fq_; asm volatile("" : "+v"(fr), "+v"(fq));
        const int lrow0 = u.pm * 256 + wr * 64 + fr, cw = wc * 32 + 8 * fq;
#pragma unroll
        for (int ai = 0; ai < 2; ++ai) {
            u32x4 xh[4][2];
#pragma unroll
            for (int m = 0; m < 4; ++m)
#pragma unroll
                for (int bj = 0; bj < 2; ++bj) xh[m][bj] = *(const u32x4*)(XB + (size_t)(grow0 + lrow0 + ai * 128 + m * 16) * DM + u.pn * 256 + bj * 128 + cw);
            asm volatile("" ::: "memory");
#pragma unroll
            for (int m = 0; m < 4; ++m) {
                const int grow = grow0 + lrow0 + ai * 128 + m * 16;
                float sq = 0.f;
#pragma unroll
                for (int bj = 0; bj < 2; ++bj) {
                    const int col = u.pn * 256 + bj * 128 + cw;
                    float v[8];
#pragma unroll
                    for (int j = 0; j < 4; ++j) { v[2 * j] = bflo(xh[m][bj][j]) + acc[ai][bj][m][j >> 1][(2 * j) & 3]; v[2 * j + 1] = bfhi(xh[m][bj][j]) + acc[ai][bj][m][j >> 1][(2 * j + 1) & 3]; }
#pragma unroll
                    for (int j = 0; j < 8; ++j) sq += v[j] * v[j];
                    *(u32x4*)(XB + (size_t)grow * DM + col) = pack8(v);
                }
                sq += __shfl_xor(sq, 16); sq += __shfl_xor(sq, 32);
                if (fq == 0) ssq_add(ssq_next + grow, sq);
            }
            asm volatile("" ::: "memory");
        }
    }
};
struct EpiUp {
    static constexpr bool PERM = true;
    const u64* ssq; int grow0; bf16_t* H; int var; PG8_LAS unsigned char* ldsb;
    __device__ __forceinline__ bool keep(const Unit&) const { return false; }
    __device__ __forceinline__ void prefetch(const Unit& u, PG8_LAS unsigned char* lds, int tid) const { rowtab_stage(ssq + grow0, u, lds, tid); }
    __device__ __forceinline__ void operator()(pg8::f32x4 (&acc)[2][2][4][2], const Unit& u, int wr, int wc, int fr_, int fq_) const {
        int fr = fr_, fq = fq_; asm volatile("" : "+v"(fr), "+v"(fq));
        if (var & 2) {
#pragma unroll
            for (int ai = 0; ai < 2; ++ai)
#pragma unroll
                for (int bj = 0; bj < 2; ++bj)
#pragma unroll
                    for (int m = 0; m < 4; ++m) { asm volatile("" :: "v"(acc[ai][bj][m][0]), "v"(acc[ai][bj][m][1])); }
            return;
        }
        const int lrow0 = u.pm * 256 + wr * 64 + fr, cw = wc * 32 + 8 * fq;
#pragma unroll
        for (int ai = 0; ai < 2; ++ai)
#pragma unroll
            for (int m = 0; m < 4; ++m) { EPI_FENCE;
                const int lrow = lrow0 + ai * 128 + m * 16;
                const float rs = rowtab_rstd(ldsb, u, lrow - u.pm * 256, 1.f / 1024.f);
#pragma unroll
                for (int bj = 0; bj < 2; ++bj) {
                    pg8::f32x4 a0 = acc[ai][bj][m][0] * rs, a1 = acc[ai][bj][m][1] * rs;
                    a0 = a0 * vmax0(a0); a1 = a1 * vmax0(a1);
                    const u32x4 w = pack8v(a0, a1);
                    if (var & 1) { asm volatile("" :: "v"(w)); } else *(u32x4*)(H + (size_t)lrow * DFF + u.pn * 256 + bj * 128 + cw) = w;
                }
            }
    }
};

namespace att {
typedef short bf16x8 __attribute__((ext_vector_type(8)));
typedef short s16x4 __attribute__((ext_vector_type(4)));
typedef float f32x16 __attribute__((ext_vector_type(16)));
typedef unsigned u32x4 __attribute__((ext_vector_type(4)));
constexpr int KP96 = 208, KP64 = 144, VP = 192;
constexpr int TK = 128;
constexpr int KBUF = TK * KP96, VBUF = TK * VP;
constexpr int OFF_K0 = 0, OFF_K1 = KBUF, OFF_V0 = 2 * KBUF, OFF_V1 = 2 * KBUF + VBUF, OFF_FLAG = 2 * KBUF + 2 * VBUF, ATT_LDS = OFF_FLAG + 64;
static_assert(ATT_LDS <= RING_BYTES, "attention LDS");
__device__ __forceinline__ int crow(int r, int h) { return (r & 3) + 8 * (r >> 2) + 4 * h; }
__device__ __forceinline__ s16x4 tr16(const LAS unsigned char* p) { typedef short v4i16_t __attribute__((ext_vector_type(4))); return __builtin_bit_cast(s16x4, __builtin_amdgcn_ds_read_tr16_b64_v4i16((LAS v4i16_t*)p)); }
__device__ __forceinline__ unsigned cvt_pk_bf16_c(float lo, float hi) {
    typedef float f32x2_t __attribute__((ext_vector_type(2))); typedef __bf16 bf16x2_t __attribute__((ext_vector_type(2)));
    const f32x2_t f = {lo, hi}; return __builtin_bit_cast(unsigned, __builtin_convertvector(f, bf16x2_t));
}
__device__ __forceinline__ bf16x8 pack8c(const f32x16& p, int s) {
    u32x4 w; w.x = cvt_pk_bf16_c(p[8 * s + 0], p[8 * s + 1]); w.y = cvt_pk_bf16_c(p[8 * s + 2], p[8 * s + 3]); w.z = cvt_pk_bf16_c(p[8 * s + 4], p[8 * s + 5]); w.w = cvt_pk_bf16_c(p[8 * s + 6], p[8 * s + 7]);
    return __builtin_bit_cast(bf16x8, w);
}
__device__ __forceinline__ bf16x8 pack8s(const f32x16& p, int s) {
    u32x4 w; w.x = pg8::cvt_pk_bf16(p[8 * s + 0], p[8 * s + 1]); w.y = pg8::cvt_pk_bf16(p[8 * s + 2], p[8 * s + 3]); w.z = pg8::cvt_pk_bf16(p[8 * s + 4], p[8 * s + 5]); w.w = pg8::cvt_pk_bf16(p[8 * s + 6], p[8 * s + 7]);
    return __builtin_bit_cast(bf16x8, w);
}
template <int NKS> __device__ __forceinline__ f32x16 qk_block(const LAS unsigned char* krows, int pitch, const bf16x8 (&qf)[NKS], int r32, int hh) {
    f32x16 p;
#pragma unroll
    for (int i = 0; i < 16; ++i) p[i] = 0.f;
    const LAS unsigned char* kp = krows + r32 * pitch + hh * 16;
#pragma unroll
    for (int ks = 0; ks < NKS; ++ks) { const bf16x8 kf = *(const LAS bf16x8*)(kp + ks * 32); p = __builtin_amdgcn_mfma_f32_32x32x16_bf16(kf, qf[ks], p, 0, 0, 0); }
    return p;
}
template <int NKS> __device__ __forceinline__ void qk_block2(att::f32x16& pA, att::f32x16& pB, const LAS unsigned char* krows, int pitch, const att::bf16x8 (&qf)[NKS], int r32, int hh, float init = 0.f) {
    using namespace att;
    const LAS unsigned char* kp = krows + r32 * pitch + hh * 16;
    bf16x8 ka[NKS], kb[NKS];
#pragma unroll
    for (int ks = 0; ks < NKS; ++ks) ka[ks] = *(const LAS bf16x8*)(kp + ks * 32);
#pragma unroll
    for (int ks = 0; ks < NKS; ++ks) kb[ks] = *(const LAS bf16x8*)(kp + 32 * pitch + ks * 32);
#pragma unroll
    for (int i = 0; i < 16; ++i) { pA[i] = init; pB[i] = init; }
#pragma unroll
    for (int ks = 0; ks < NKS; ++ks) pA = __builtin_amdgcn_mfma_f32_32x32x16_bf16(ka[ks], qf[ks], pA, 0, 0, 0);
#pragma unroll
    for (int ks = 0; ks < NKS; ++ks) pB = __builtin_amdgcn_mfma_f32_32x32x16_bf16(kb[ks], qf[ks], pB, 0, 0, 0);
}
__device__ __forceinline__ void pv_block(f32x16 (&o)[2], const LAS unsigned char* vrows, bf16x8 pb0, bf16x8 pb1, int lane) {
    const int hh = lane >> 5, g1 = (lane >> 4) & 1, q4 = (lane >> 2) & 3, p = lane & 3;
    const LAS unsigned char* base = vrows + (4 * hh + q4) * VP + (16 * g1 + 4 * p) * 2;
#pragma unroll
    for (int db = 0; db < 2; ++db)
#pragma unroll
        for (int s = 0; s < 2; ++s) {
            const s16x4 lo = tr16(base + (16 * s) * VP + db * 64), hi = tr16(base + (16 * s + 8) * VP + db * 64);
            const bf16x8 vf = {lo[0], lo[1], lo[2], lo[3], hi[0], hi[1], hi[2], hi[3]};
            o[db] = __builtin_amdgcn_mfma_f32_32x32x16_bf16(vf, s == 0 ? pb0 : pb1, o[db], 0, 0, 0);
        }
}
__device__ __forceinline__ void store_ot(bf16* dst, const f32x16 (&o)[2], float sc, int hh) {
#pragma unroll
    for (int db = 0; db < 2; ++db)
#pragma unroll
        for (int g = 0; g < 4; ++g) {
            pg8::u32x2 w; w.x = pg8::cvt_pk_bf16(o[db][4 * g] * sc, o[db][4 * g + 1] * sc); w.y = pg8::cvt_pk_bf16(o[db][4 * g + 2] * sc, o[db][4 * g + 3] * sc);
            *(GAS pg8::u32x2*)(dst + db * 32 + 8 * g + 4 * hh) = w;
        }
}
}

template <bool MASKED> __device__ __forceinline__ void mla_sm_pv(att::f32x16& P0, att::f32x16& P1, att::f32x16 (&o)[2], float& m, float& l, const LAS unsigned char* Vb, int base, int qg, int lane, int hh) {
    using namespace att;
    if constexpr (MASKED) {
#pragma unroll
        for (int r = 0; r < 16; ++r) { const int key = base + crow(r, hh); if (key > qg) P0[r] = -INFINITY; if (key + 32 > qg) P1[r] = -INFINITY; }
    }
    float mx = fmaxf(P0[0], P1[0]);
#pragma unroll
    for (int r = 1; r < 16; ++r) mx = fmaxf(mx, fmaxf(P0[r], P1[r]));
    mx = fmaxf(mx, __shfl_xor(mx, 32));
    const float mn = fmaxf(m, mx), al = __builtin_amdgcn_exp2f(m - mn);
    m = mn;
    float sum = 0.f;
#pragma unroll
    for (int r = 0; r < 16; ++r) { P0[r] = __builtin_amdgcn_exp2f(P0[r] - mn); P1[r] = __builtin_amdgcn_exp2f(P1[r] - mn); sum += P0[r] + P1[r]; }
    sum += __shfl_xor(sum, 32);
    l = l * al + sum;
#pragma unroll
    for (int r = 0; r < 16; ++r) { o[0][r] *= al; o[1][r] *= al; }
    pv_block(o, Vb, pack8s(P0, 0), pack8s(P0, 1), lane);
    pv_block(o, Vb + 32 * VP, pack8s(P1, 0), pack8s(P1, 1), lane);
}
__device__ __forceinline__ float max3f(float a, float b, float c) { return fmaxf(fmaxf(a, b), c); }
__device__ __forceinline__ void mla_sm_pv_ref(att::f32x16& A0, att::f32x16& A1, att::f32x16& B0, att::f32x16& B1, att::f32x16 (&o)[2], float& m, float& l, const LAS unsigned char* Vb, int lane, bool first) {
    using namespace att;
    float mx = max3f(A0[0], A1[0], B0[0]); mx = fmaxf(mx, B1[0]);
#pragma unroll
    for (int r = 1; r < 16; ++r) { mx = max3f(mx, A0[r], A1[r]); mx = max3f(mx, B0[r], B1[r]); }
    mx = fmaxf(mx, __shfl_xor(mx, 32));
    if (first || __builtin_amdgcn_ballot_w64(mx > 8.f) != 0ull) {
        const float d = (first || mx > 8.f) ? mx : 0.f, al = first ? 1.f : __builtin_amdgcn_exp2f(-d);
        m = first ? d : m + d; l *= al;
#pragma unroll
        for (int r = 0; r < 16; ++r) { o[0][r] *= al; o[1][r] *= al; A0[r] -= d; A1[r] -= d; B0[r] -= d; B1[r] -= d; }
    }
    float s0 = 0.f, s1 = 0.f;
#pragma unroll
    for (int r = 0; r < 16; ++r) { A0[r] = __builtin_amdgcn_exp2f(A0[r]); s0 += A0[r]; }
    pv_block(o, Vb, pack8c(A0, 0), pack8c(A0, 1), lane);
#pragma unroll
    for (int r = 0; r < 16; ++r) { A1[r] = __builtin_amdgcn_exp2f(A1[r]); s1 += A1[r]; }
    pv_block(o, Vb + 32 * VP, pack8c(A1, 0), pack8c(A1, 1), lane);
#pragma unroll
    for (int r = 0; r < 16; ++r) { B0[r] = __builtin_amdgcn_exp2f(B0[r]); s0 += B0[r]; }
    pv_block(o, Vb + 64 * VP, pack8c(B0, 0), pack8c(B0, 1), lane);
#pragma unroll
    for (int r = 0; r < 16; ++r) { B1[r] = __builtin_amdgcn_exp2f(B1[r]); s1 += B1[r]; }
    pv_block(o, Vb + 96 * VP, pack8c(B1, 0), pack8c(B1, 1), lane);
    s0 += s1; s0 += __shfl_xor(s0, 32);
    l += s0;
}
template <int VAR> __device__ __forceinline__ void mla_unit(Frame& F, int bh, int qb) {
    using namespace att;
    const bf16* QM = (const bf16*)(F.ws + WS_QM); const bf16* KVM = (const bf16*)(F.ws + WS_KVM); const bf16* C = (const bf16*)(F.ws + WS_C); bf16* Y = (bf16*)(F.ws + WS_Y);
    const int b = bh >> 3, h = bh & 7, q0 = qb * 256, w = F.wave, lane = F.lane, r32 = lane & 31, hh = lane >> 5, tid = F.tid;
    const int qmin = q0 + 32 * w, qg = qmin + r32;
    const size_t rowb = (size_t)b * SEQ;
    bf16x8 qf[6];
#pragma unroll
    for (int ks = 0; ks < 6; ++ks) qf[ks] = *(const GAS bf16x8*)(QM + (rowb + qg) * NQ + h * 96 + ks * 16 + hh * 8);
    float m = -INFINITY, l = 0.f; f32x16 o[2];
#pragma unroll
    for (int i = 0; i < 16; ++i) { o[0][i] = 0.f; o[1][i] = 0.f; }
    const int NT = 2 * qb + 2;
    const int kr0 = tid >> 3, kc0 = tid & 7, rr = tid >> 2, rc = tid & 3;
    const bf16* gkn = KVM + ((size_t)bh * SEQ + kr0) * 128 + kc0 * 8;
    const bf16* gkr = (const bf16*)(F.ws + WS_KPE) + (rowb + rr) * 32 + rc * 8;
    const int lk0 = kr0 * KP96 + kc0 * 16, lkr = rr * KP96 + 128 + rc * 16, lv0 = kr0 * VP + kc0 * 16;
    v4u R0, R1, R2, R3, R4;
#define MLA_LOAD(j) do { const size_t o_ = (size_t)(j) * TK; R0 = *(const GAS v4u*)(gkn + o_ * 128); R1 = *(const GAS v4u*)(gkn + (o_ + 64) * 128); R2 = *(const GAS v4u*)(gkr + o_ * 32); \
        R3 = *(const GAS v4u*)(gkn + o_ * 128 + 64); R4 = *(const GAS v4u*)(gkn + (o_ + 64) * 128 + 64); } while (0)
#define MLA_STORE(kb, vb) do { *(LAS v4u*)(F.lds + (kb) + lk0) = R0; *(LAS v4u*)(F.lds + (kb) + lk0 + 64 * KP96) = R1; *(LAS v4u*)(F.lds + (kb) + lkr) = R2; \
        *(LAS v4u*)(F.lds + (vb) + lv0) = R3; *(LAS v4u*)(F.lds + (vb) + lv0 + 64 * VP) = R4; } while (0)
    MLA_LOAD(0); MLA_STORE(OFF_K0, OFF_V0);
    __syncthreads();
    int j = 0;
    for (; j < NT - 2; ++j) {
        const int kb = (j & 1) ? OFF_K1 : OFF_K0, vb = (j & 1) ? OFF_V1 : OFF_V0;
        MLA_LOAD(j + 1);
        const LAS unsigned char* Kb = F.lds + kb; const LAS unsigned char* Vb = F.lds + vb;
        f32x16 pa0, pa1, pb0, pb1;
        const float ini = (j == 0) ? 0.f : -m;
        qk_block2<6>(pa0, pa1, Kb, KP96, qf, r32, hh, ini);
        qk_block2<6>(pb0, pb1, Kb + 64 * KP96, KP96, qf, r32, hh, ini);
        mla_sm_pv_ref(pa0, pa1, pb0, pb1, o, m, l, Vb, lane, j == 0);
        if (j & 1) MLA_STORE(OFF_K0, OFF_V0); else MLA_STORE(OFF_K1, OFF_V1);
        __syncthreads();
    }
    for (; j < NT; ++j) {
        const int kb = (j & 1) ? OFF_K1 : OFF_K0, vb = (j & 1) ? OFF_V1 : OFF_V0;
        if (j + 1 < NT) MLA_LOAD(j + 1);
#pragma unroll
        for (int sub = 0; sub < 2; ++sub) {
            const int base = j * TK + sub * 64;
            if (base <= qmin + 31) {
                const LAS unsigned char* Kb = F.lds + kb + sub * 64 * KP96; const LAS unsigned char* Vb = F.lds + vb + sub * 64 * VP;
                f32x16 p0 = qk_block<6>(Kb, KP96, qf, r32, hh), p1 = qk_block<6>(Kb + 32 * KP96, KP96, qf, r32, hh);
                mla_sm_pv<true>(p0, p1, o, m, l, Vb, base, qg, lane, hh);
            }
        }
        if (j + 1 < NT) { if (j & 1) MLA_STORE(OFF_K0, OFF_V0); else MLA_STORE(OFF_K1, OFF_V1); }
        __syncthreads();
    }
#undef MLA_LOAD
#undef MLA_STORE
    if constexpr (VAR == 0) store_ot(Y + (rowb + qg) * 1536 + h * 64, o, 1.f / l, hh);
    else store_ot((bf16*)(F.ws + WS_MG) + (rowb + qg) * 512 + h * 64, o, 1.f / (l + 1.f), hh);
}
template <int VAR> __device__ __forceinline__ void mla_phase(Frame& F) {
    const int vcu = (F.G % 8 == 0) ? (int)(blockIdx.x % 8) * (F.G / 8) + (int)blockIdx.x / 8 : (int)blockIdx.x;
    for (int u = vcu; u < BH * NHEAD * 8; u += F.G) {
        const int bh = u >> 3, s = u & 7;
        mla_unit<VAR>(F, bh, 15 - s);
        mla_unit<VAR>(F, bh, s);
    }
}

template <bool MASKED> __device__ __forceinline__ void sb_block(att::f32x16& z, float& run, int kbase, int t, int hh) {
    using namespace att;
    float om[16];
#pragma unroll
    for (int r = 0; r < 16; ++r) {
        const float e = __builtin_amdgcn_exp2f(-fmaxf(z[r], -120.f));
        float beta = __builtin_amdgcn_rcpf(1.f + e), omb = e * beta;
        if constexpr (MASKED) { const bool valid = kbase + crow(r, hh) < t; beta = valid ? beta : 0.f; omb = valid ? omb : 1.f; }
        z[r] = beta; om[r] = omb;
    }
    float Gs[4], Go[4];
#pragma unroll
    for (int g = 0; g < 4; ++g) { Gs[g] = (om[4 * g] * om[4 * g + 1]) * (om[4 * g + 2] * om[4 * g + 3]); Go[g] = __shfl_xor(Gs[g], 32); }
    float T = 1.f;
#pragma unroll
    for (int g = 3; g >= 0; --g) {
        float P = run * T * (hh == 0 ? Go[g] : 1.f);
#pragma unroll
        for (int i = 3; i >= 0; --i) { const int r = 4 * g + i; z[r] *= P; P *= om[r]; }
        T *= Gs[g] * Go[g];
    }
    run *= T;
}
template <int VAR> __device__ __forceinline__ void sb_unit(Frame& F, int bh, int qb, bf16* OUT, int opitch, int ocol) {
    using namespace att;
    const bf16* Y = (const bf16*)(F.ws + WS_Y); const bf16* SK = (const bf16*)(F.ws + WS_SBK); const bf16* SV = (const bf16*)(F.ws + WS_SBV);
    const int b = bh >> 3, h = bh & 7, q0 = qb * 256, w = F.wave, lane = F.lane, r32 = lane & 31, hh = lane >> 5, tid = F.tid;
    const int qmin = q0 + 32 * w, qg = qmin + r32;
    const size_t rowb = (size_t)b * SEQ;
    bf16x8 qf[4];
#pragma unroll
    for (int ks = 0; ks < 4; ++ks) qf[ks] = *(const GAS bf16x8*)(Y + (rowb + qg) * 1536 + 512 + h * 64 + ks * 16 + hh * 8);
    float run = 1.f; f32x16 o[2];
#pragma unroll
    for (int i = 0; i < 16; ++i) { o[0][i] = 0.f; o[1][i] = 0.f; }
    constexpr int SBT = TK * KP64 + TK * VP, SB_FLAG = 3 * SBT;
    static_assert(SB_FLAG + 64 <= RING_BYTES, "stick-breaking LDS");
    volatile LAS unsigned* fl = (volatile LAS unsigned*)(F.lds + SB_FLAG);
    if (tid < 3) fl[tid] = 0u;
    const int kr0 = tid >> 3, kc0 = tid & 7;
    const bf16* gk = SK + (rowb + kr0) * 512 + h * 64 + kc0 * 8; const bf16* gv = SV + (rowb + kr0) * 512 + h * 64 + kc0 * 8;
    const int lk0 = kr0 * KP64 + kc0 * 16, lv0 = TK * KP64 + kr0 * VP + kc0 * 16;
    v4u RA0, RA1, RA2, RA3, RB0, RB1, RB2, RB3;
#define SB_LOADA(j) do { const size_t o_ = (size_t)(j) * TK * 512; RA0 = *(const GAS v4u*)(gk + o_); RA1 = *(const GAS v4u*)(gk + o_ + 64 * 512); RA2 = *(const GAS v4u*)(gv + o_); RA3 = *(const GAS v4u*)(gv + o_ + 64 * 512); } while (0)
#define SB_LOADB(j) do { const size_t o_ = (size_t)(j) * TK * 512; RB0 = *(const GAS v4u*)(gk + o_); RB1 = *(const GAS v4u*)(gk + o_ + 64 * 512); RB2 = *(const GAS v4u*)(gv + o_); RB3 = *(const GAS v4u*)(gv + o_ + 64 * 512); } while (0)
#define SB_STOREA(tb) do { *(LAS v4u*)(F.lds + (tb) + lk0) = RA0; *(LAS v4u*)(F.lds + (tb) + lk0 + 64 * KP64) = RA1; *(LAS v4u*)(F.lds + (tb) + lv0) = RA2; *(LAS v4u*)(F.lds + (tb) + lv0 + 64 * VP) = RA3; } while (0)
#define SB_STOREB(tb) do { *(LAS v4u*)(F.lds + (tb) + lk0) = RB0; *(LAS v4u*)(F.lds + (tb) + lk0 + 64 * KP64) = RB1; *(LAS v4u*)(F.lds + (tb) + lv0) = RB2; *(LAS v4u*)(F.lds + (tb) + lv0 + 64 * VP) = RB3; } while (0)
    const int jtop = 2 * qb + 1;
    const int up = w >> 2;
    SB_LOADA(jtop); SB_LOADB(jtop - 1); SB_STOREA(0); SB_STOREB(SBT);
    if (jtop >= 2) SB_LOADA(jtop - 2);
    __syncthreads();
    for (int it = 0; ; ++it) {
        const int jt = jtop - it, mj = jt - 1 + up;
        const int tb = ((it + 1 - up) % 3) * SBT;
        if (jt >= 3) { if (it & 1) SB_LOADA(jt - 3); else SB_LOADB(jt - 3); }
        if (tid == 0) fl[(it + 1) % 3] = 0u;
        if (mj >= 0 && __ballot(run > 0.f) != 0ull) {
            if (it >= 1) {
#pragma unroll
                for (int sub = 1; sub >= 0; --sub) {
                    if (sub == 0 && __ballot(run > 0.f) == 0ull) break;
                    const LAS unsigned char* Kb = F.lds + tb + sub * 64 * KP64; const LAS unsigned char* Vb = F.lds + tb + TK * KP64 + sub * 64 * VP;
                    f32x16 p0 = qk_block<4>(Kb, KP64, qf, r32, hh), p1 = qk_block<4>(Kb + 32 * KP64, KP64, qf, r32, hh);
                    if constexpr (VAR != 1) { sb_block<false>(p1, run, 0, 0, hh);
                    sb_block<false>(p0, run, 0, 0, hh); } else run *= 1e-12f;
                    if constexpr (VAR != 2) { pv_block(o, Vb, pack8s(p0, 0), pack8s(p0, 1), lane);
                    pv_block(o, Vb + 32 * VP, pack8s(p1, 0), pack8s(p1, 1), lane); } else o[0][0] += p0[0] + p1[1];
                }
            } else {
#pragma unroll
                for (int sub = 1; sub >= 0; --sub) {
                    const int base = mj * TK + sub * 64;
                    if (base < qmin + 31) {
                        const LAS unsigned char* Kb = F.lds + tb + sub * 64 * KP64; const LAS unsigned char* Vb = F.lds + tb + TK * KP64 + sub * 64 * VP;
                        f32x16 p0 = qk_block<4>(Kb, KP64, qf, r32, hh), p1 = qk_block<4>(Kb + 32 * KP64, KP64, qf, r32, hh);
                        if constexpr (VAR != 1) { sb_block<true>(p1, run, base + 32, qg, hh);
                        sb_block<true>(p0, run, base, qg, hh); } else run *= (base + 63 < qg ? 1e-12f : 1.f);
                        if constexpr (VAR != 2) { pv_block(o, Vb, pack8s(p0, 0), pack8s(p0, 1), lane);
                        pv_block(o, Vb + 32 * VP, pack8s(p1, 0), pack8s(p1, 1), lane); } else o[0][0] += p0[0] + p1[1];
                    }
                }
            }
        }
        if (mj >= 1 && __ballot(run > 0.f) != 0ull && lane == 0) fl[it % 3] = 1u;
        if (jt >= 2) { if (it & 1) SB_STOREB(((it + 2) % 3) * SBT); else SB_STOREA(((it + 2) % 3) * SBT); }
        __syncthreads();
        if (fl[it % 3] == 0u) break;
        if constexpr (VAR == 5) { if (it >= 3) break; }
        if constexpr (VAR == 6) { break; }
    }
#undef SB_LOADA
#undef SB_LOADB
#undef SB_STOREA
#undef SB_STOREB
    __syncthreads();
    store_ot(OUT + (rowb + qg) * opitch + ocol + h * 64, o, 1.f, hh);
}
template <int VAR> __device__ __forceinline__ void sb_phase(Frame& F, bf16* OUT, int opitch, int ocol) {
    const int vcu = (F.G % 8 == 0) ? (int)(blockIdx.x % 8) * (F.G / 8) + (int)blockIdx.x / 8 : (int)blockIdx.x;
    for (int u = vcu; u < BH * NHEAD * 8; u += F.G) { const int bh = u >> 3, s = u & 7; sb_unit<VAR>(F, bh, 15 - s, OUT, opitch, ocol); sb_unit<VAR>(F, bh, s, OUT, opitch, ocol); }
}

__device__ __forceinline__ float log2_gamma(int h) {
    return h == 0 ? -4.5803689613e-02f : h == 1 ? -2.2720076500e-02f : h == 2 ? -1.1315313228e-02f : h == 3 ? -5.6465631411e-03f : h == 4 ? -2.8205190624e-03f : h == 5 ? -1.4095702547e-03f : h == 6 ? -7.0461297659e-04f : -3.5226347163e-04f;
}
constexpr size_t WS_KVS = WS_RST;
__device__ __forceinline__ void ret_stage(Frame& F, const bf16* RK, const bf16* RV, size_t row0, int h, float lg2, int kp, int voff) {
    using namespace att;
    const int tid = F.tid, r0 = tid >> 3, ch = tid & 7;
    v4u Rk[4], Rv[4];
#pragma unroll
    for (int i = 0; i < 4; ++i) { const size_t go = (row0 + r0 + 64 * i) * 512 + h * 64 + ch * 8; Rk[i] = *(const GAS v4u*)(RK + go); Rv[i] = *(const GAS v4u*)(RV + go); }
#pragma unroll
    for (int i = 0; i < 4; ++i) { const int row = r0 + 64 * i; const float z = __builtin_amdgcn_exp2f((float)(127 - (row & 127)) * lg2);
        v4u k; k.x = pg8::cvt_pk_bf16(bflo(Rk[i].x) * z, bfhi(Rk[i].x) * z); k.y = pg8::cvt_pk_bf16(bflo(Rk[i].y) * z, bfhi(Rk[i].y) * z);
        k.z = pg8::cvt_pk_bf16(bflo(Rk[i].z) * z, bfhi(Rk[i].z) * z); k.w = pg8::cvt_pk_bf16(bflo(Rk[i].w) * z, bfhi(Rk[i].w) * z);
        *(LAS v4u*)(F.lds + row * kp + ch * 16) = k; *(LAS v4u*)(F.lds + voff + row * VP + ch * 16) = Rv[i]; }
}
__device__ __forceinline__ void ret_r1_phase(Frame& F) {
    using namespace att;
    const bf16* RK = (const bf16*)(F.ws + WS_RK); const bf16* RV = (const bf16*)(F.ws + WS_RV); float* KVS = (float*)(F.ws + WS_KVS);
    const int lane = F.lane, w = F.wave, r32 = lane & 31, hh = lane >> 5, g1 = (lane >> 4) & 1, q4 = (lane >> 2) & 3, p4 = lane & 3;
    constexpr int VOFF = 256 * VP;
    for (int u = blockIdx.x; u < BH * NHEAD * 16; u += F.G) {
        const int bh = u >> 4, cp = u & 15, b = bh >> 3, h = bh & 7;
        ret_stage(F, RK, RV, (size_t)b * SEQ + cp * 256, h, log2_gamma(h), VP, VOFF);
        __syncthreads();
        const int c2 = w >> 2, eb = (w >> 1) & 1, db = w & 1;
        f32x16 acc;
#pragma unroll
        for (int i = 0; i < 16; ++i) acc[i] = 0.f;
        const LAS unsigned char* vb = F.lds + VOFF + (c2 * 128 + 8 * hh + q4) * VP + (eb * 32 + 16 * g1 + 4 * p4) * 2;
        const LAS unsigned char* kb = F.lds + (c2 * 128 + 8 * hh + q4) * VP + (db * 32 + 16 * g1 + 4 * p4) * 2;
#pragma unroll
        for (int ks = 0; ks < 8; ++ks) {
            const s16x4 al = tr16(vb + ks * 16 * VP), ah = tr16(vb + (ks * 16 + 4) * VP), bl = tr16(kb + ks * 16 * VP), bhi = tr16(kb + (ks * 16 + 4) * VP);
            const bf16x8 af = {al[0], al[1], al[2], al[3], ah[0], ah[1], ah[2], ah[3]}, bf = {bl[0], bl[1], bl[2], bl[3], bhi[0], bhi[1], bhi[2], bhi[3]};
            acc = __builtin_amdgcn_mfma_f32_32x32x16_bf16(af, bf, acc, 0, 0, 0);
        }
        float* dst = KVS + ((size_t)(bh * 32 + 2 * cp + c2) * 64 + eb * 32) * 64 + db * 32 + r32;
#pragma unroll
        for (int r = 0; r < 16; ++r) dst[crow(r, hh) * 64] = acc[r];
        __syncthreads();
    }
}
__device__ __forceinline__ void ret_scan_phase(Frame& F) {
    float* KVS = (float*)(F.ws + WS_KVS);
    for (int idx = blockIdx.x * NTHR + F.tid; idx < BH * NHEAD * 4096; idx += F.G * NTHR) {
        const int bh = idx >> 12, ed = idx & 4095;
        const float dec = __builtin_amdgcn_exp2f(128.f * log2_gamma(bh & 7));
        float S = 0.f, kv[32];
        const float* base = KVS + ((size_t)(bh * 32) << 12) + ed;
        bf16* outb = (bf16*)(F.ws + WS_PREVB) + ((size_t)(bh * 32) << 12) + ed;
#pragma unroll
        for (int n = 0; n < 32; ++n) kv[n] = base[(size_t)n << 12];
        asm volatile("" ::: "memory");
#pragma unroll
        for (int n = 0; n < 32; n += 2) { const float S0 = S; S = S * dec + kv[n]; const unsigned w = pg8::cvt_pk_bf16(S0, S); S = S * dec + kv[n + 1];
            ((unsigned short*)outb)[(size_t)n << 12] = (unsigned short)(w & 0xffffu); ((unsigned short*)outb)[(size_t)(n + 1) << 12] = (unsigned short)(w >> 16); }
    }
}
__device__ __forceinline__ void ret_r3_phase(Frame& F, const float* gn, bf16* OUT, int opitch, int ocol, int ng, int nlow) {
    using namespace att;
    const bf16* RK = (const bf16*)(F.ws + WS_RK); const bf16* RV = (const bf16*)(F.ws + WS_RV); const bf16* RG = (const bf16*)(F.ws + WS_RG); bf16* Y = (bf16*)(F.ws + WS_Y);
    const float* PREV = (const float*)(F.ws + WS_KVS);
    const int lane = F.lane, w = F.wave, r32 = lane & 31, hh = lane >> 5;
    constexpr int VOFF = 40960;
    const int c_ = (int)blockIdx.x; const bool low_ = c_ < ng;
    for (int u = low_ ? c_ : ng * nlow + (c_ - ng); u < (low_ ? ng * nlow : BH * NHEAD * 16); u += (low_ ? ng : F.G - ng)) {
        const int bh = u >> 4, cp = u & 15, b = bh >> 3, h = bh & 7;
        const float lg2 = log2_gamma(h);
        const size_t row0 = (size_t)b * SEQ + cp * 256;
        const int c2 = w >> 2, wq = w & 3, it = 32 * wq + r32;
        const size_t trow = row0 + c2 * 128 + it;
        bf16x8 qf[4];
#pragma unroll
        for (int ks = 0; ks < 4; ++ks) qf[ks] = *(const GAS bf16x8*)(Y + trow * 1536 + 1024 + h * 64 + ks * 16 + hh * 8);
        pg8::u32x2 rgv[8];
#pragma unroll
        for (int eb = 0; eb < 2; ++eb)
#pragma unroll
            for (int g = 0; g < 4; ++g) rgv[eb * 4 + g] = *(const GAS pg8::u32x2*)(RG + trow * 512 + h * 64 + eb * 32 + 8 * g + 4 * hh);
        bf16x8 pf[2][4];
        { const bf16* pv = (const bf16*)(F.ws + WS_PREVB) + ((size_t)(bh * 32 + 2 * cp + c2) << 12) + r32 * 64 + hh * 8;
#pragma unroll
          for (int eb = 0; eb < 2; ++eb)
#pragma unroll
              for (int ks = 0; ks < 4; ++ks) pf[eb][ks] = *(const GAS bf16x8*)(pv + eb * 32 * 64 + ks * 16); }
        ret_stage(F, RK, RV, row0, h, lg2, KP64, VOFF);
        __syncthreads();
        f32x16 o[2];
#pragma unroll
        for (int i = 0; i < 16; ++i) { o[0][i] = 0.f; o[1][i] = 0.f; }
        const float xi = __builtin_amdgcn_exp2f((float)(it - 127) * lg2);
        for (int kb = 0; kb <= wq; ++kb) {
            f32x16 p = qk_block<4>(F.lds + (c2 * 128 + kb * 32) * KP64, KP64, qf, r32, hh);
#pragma unroll
            for (int r = 0; r < 16; ++r) { const int is = kb * 32 + crow(r, hh); p[r] = (is <= it) ? p[r] * xi : 0.f; }
            pv_block(o, F.lds + VOFF + (c2 * 128 + kb * 32) * VP, pack8s(p, 0), pack8s(p, 1), lane);
        }
        { const float xc = __builtin_amdgcn_exp2f((float)(it + 1) * lg2);
#pragma unroll
          for (int eb = 0; eb < 2; ++eb) { f32x16 oc;
#pragma unroll
              for (int i = 0; i < 16; ++i) oc[i] = 0.f;
#pragma unroll
              for (int ks = 0; ks < 4; ++ks) oc = __builtin_amdgcn_mfma_f32_32x32x16_bf16(pf[eb][ks], qf[ks], oc, 0, 0, 0);
#pragma unroll
              for (int i = 0; i < 16; ++i) o[eb][i] += oc[i] * xc; } }
        float s1 = 0.f;
#pragma unroll
        for (int i = 0; i < 16; ++i) s1 += o[0][i] + o[1][i];
        s1 += __shfl_xor(s1, 32);
        const float mu = s1 * (1.f / 64.f); float s2 = 0.f;
#pragma unroll
        for (int i = 0; i < 16; ++i) { o[0][i] -= mu; o[1][i] -= mu; s2 += o[0][i] * o[0][i] + o[1][i] * o[1][i]; }
        s2 += __shfl_xor(s2, 32);
        const float rstd = rsqrtf(s2 * (1.f / 64.f) + EPS);
        f32x4 gvv[8];
#pragma unroll
        for (int eb = 0; eb < 2; ++eb)
#pragma unroll
            for (int g = 0; g < 4; ++g) gvv[eb * 4 + g] = *(const f32x4*)(gn + h * 64 + eb * 32 + 8 * g + 4 * hh);
        asm volatile("" ::: "memory");
#pragma unroll
        for (int eb = 0; eb < 2; ++eb)
#pragma unroll
            for (int g = 0; g < 4; ++g) { const int e = eb * 32 + 8 * g + 4 * hh;
                const f32x4 gv = gvv[eb * 4 + g]; const pg8::u32x2 rg = rgv[eb * 4 + g];
                pg8::u32x2 wv; wv.x = pg8::cvt_pk_bf16(o[eb][4 * g] * rstd * gv[0] * bflo(rg.x), o[eb][4 * g + 1] * rstd * gv[1] * bfhi(rg.x));
                wv.y = pg8::cvt_pk_bf16(o[eb][4 * g + 2] * rstd * gv[2] * bflo(rg.y), o[eb][4 * g + 3] * rstd * gv[3] * bfhi(rg.y));
                *(GAS pg8::u32x2*)(OUT + trow * opitch + ocol + h * 64 + e) = wv; }
        __syncthreads();
    }
}

__device__ __forceinline__ void prologue_phase(Frame& F, const float* x, const int* pos, float* cosR, float* sinR, float* cosM, float* sinM, bf16* XB, bf16* XL, u64* ssq0) {
    const int gt = blockIdx.x * NTHR + F.tid, NT = F.G * NTHR;
    {
        GAS v4u* z = (GAS v4u*)((unsigned char*)ssq0 + (size_t)MTOT * 8); constexpr int NZ = (int)((WS_SSQ + SSQ_ZERO_BYTES - WS_SSQX - (size_t)MTOT * 8) / 16);
        for (int i = gt; i < NZ; i += NT) z[i] = v4u{0u, 0u, 0u, 0u};
    }
    for (int idx = gt; idx < MTOT * 32; idx += NT) {
        const int row = idx >> 5, i = idx & 31;
        const double inv = exp2(-(double)i * (13.287712379549449 / 32.0));
        const double ang = (double)pos[row] * inv;
        double s, c; sincos(ang, &s, &c);
        cosR[idx] = (float)c; sinR[idx] = (float)s;
        if ((i & 1) == 0) { cosM[row * 16 + (i >> 1)] = (float)c; sinM[row * 16 + (i >> 1)] = (float)s; }
    }
    const int gw = blockIdx.x * NWAVES + F.wave, NGW = F.G * NWAVES;
    for (int m0 = gw; m0 < MTOT; m0 += 2 * NGW) {
        f32x4 v[2][4];
#pragma unroll
        for (int r = 0; r < 2; ++r) { const int m = m0 + r * NGW; if (m < MTOT) { const GAS f32x4* xr = (const GAS f32x4*)(x + (size_t)m * DM) + F.lane;
#pragma unroll
            for (int j = 0; j < 4; ++j) v[r][j] = xr[64 * j]; } }
#pragma unroll
        for (int r = 0; r < 2; ++r) { const int m = m0 + r * NGW; if (m < MTOT) {
            float s = 0.f;
#pragma unroll
            for (int j = 0; j < 4; ++j) s += (v[r][j].x * v[r][j].x + v[r][j].y * v[r][j].y) + (v[r][j].z * v[r][j].z + v[r][j].w * v[r][j].w);
            s = wave_sum(s);
            GAS unsigned long long* o8 = (GAS unsigned long long*)(XB + (size_t)m * DM) + F.lane;
#pragma unroll
            for (int j = 0; j < 4; ++j) { const unsigned h0 = pk2(v[r][j].x, v[r][j].y), h1 = pk2(v[r][j].z, v[r][j].w); o8[64 * j] = (unsigned long long)h0 | ((unsigned long long)h1 << 32); }
            if (F.lane == 0) ssq0[m] = (u64)(s * 16777216.f + 0.5f); } }
    }
}
__device__ __forceinline__ void final_phase(Frame& F, float* xo, const bf16* XB, const bf16* XL, const u64* ssq, const float* g) {
    const int gw = blockIdx.x * NWAVES + F.wave, NGW = F.G * NWAVES;
    f32x4 gv[4];
#pragma unroll
    for (int j = 0; j < 4; ++j) gv[j] = *((const f32x4*)g + F.lane + 64 * j);
    for (int m0 = gw; m0 < MTOT; m0 += 4 * NGW) {
        unsigned long long h[4][4]; u64 sq[4];
#pragma unroll
        for (int r = 0; r < 4; ++r) { const int m = m0 + r * NGW; if (m < MTOT) { sq[r] = __hip_atomic_load(ssq + m, RLX_AGENT);
#pragma unroll
            for (int j = 0; j < 4; ++j) h[r][j] = ((const GAS unsigned long long*)(XB + (size_t)m * DM) + F.lane)[64 * j]; } }
#pragma unroll
        for (int r = 0; r < 4; ++r) { const int m = m0 + r * NGW; if (m < MTOT) {
            const float rs = rsqrtf((float)sq[r] * (1.f / 16777216.f) * (1.f / 1024.f) + EPS);
            GAS f32x4* xr = (GAS f32x4*)(xo + (size_t)m * DM) + F.lane;
#pragma unroll
            for (int j = 0; j < 4; ++j) { const unsigned h0 = (unsigned)h[r][j], h1 = (unsigned)(h[r][j] >> 32);
                f32x4 v; v.x = bflo(h0); v.y = bfhi(h0); v.z = bflo(h1); v.w = bfhi(h1);
                xr[64 * j] = v * rs * gv[j]; } } }
    }
}
__device__ __forceinline__ void convert_phase(Frame& F, const Args& a, int l, unsigned char* W) {
    LAS float* scr = (LAS float*)(F.lds + RING_OFF + F.wave * 16384);
    const float* g_mix = (const float*)a.in[2] + (size_t)l * DM;
    const float* w_in = (const float*)a.in[3] + (size_t)l * DM * D_IN;
    const float* g_q = (const float*)a.in[4] + (size_t)l * 384;
    const float* w_uq = (const float*)a.in[5] + (size_t)l * 384 * NQ;
    const float* g_kv = (const float*)a.in[6] + (size_t)l * 256;
    const float* w_ukv = (const float*)a.in[7] + (size_t)l * 256 * NKV;
    const float* w_br = (const float*)a.in[9] + (size_t)l * 3 * 512 * DM;
    const float* w_out = (const float*)a.in[10] + (size_t)l * DM * DM;
    const float* g_mlp = (const float*)a.in[11] + (size_t)l * DM;
    const float* w_up = (const float*)a.in[12] + (size_t)l * DM * DFF;
    const float* w_dn = (const float*)a.in[13] + (size_t)l * DFF * DM;
    constexpr int I_IN = (DM / 64) * (NIN / 32), I_UQ = (384 / 64) * (NQ / 32), I_UKV = (256 / 64) * (NKV / 32), I_B = (512 / 64) * (DM / 32), I_OUT = (DM / 64) * (DM / 32),
                  I_UP = (DM / 64) * (DFF / 32), I_DN = (DFF / 64) * (DM / 32);
    constexpr int NITEMS = I_IN + I_UQ + I_UKV + 3 * I_B + I_OUT + I_UP + I_DN;
    const int gw = blockIdx.x * NWAVES + F.wave, NGW = F.G * NWAVES;
    for (int it = gw; it < NITEMS; it += NGW) {
        int r = it;
        if (r < I_IN) { transpose_item<1>(w_in, D_IN, NIN, g_mix, (bf16*)(W + W_IN), DM, 0, scr, r, F.lane); continue; } r -= I_IN;
        if (r < I_UQ) { transpose_item<2>(w_uq, NQ, NQ, g_q, (bf16*)(W + W_UQ), 384, 0, scr, r, F.lane); continue; } r -= I_UQ;
        if (r < I_UKV) { transpose_item<0>(w_ukv, NKV, NKV, g_kv, (bf16*)(W + W_UKV), 256, 0, scr, r, F.lane); continue; } r -= I_UKV;
        if (r < 3 * I_B) { const int s = r / I_B; transpose_item<0>(w_br + (size_t)s * 512 * DM, DM, DM, nullptr, (bf16*)(W + W_B), 1536, s * 512, scr, r % I_B, F.lane); continue; } r -= 3 * I_B;
        if (r < I_OUT) { transpose_item<0>(w_out, DM, DM, nullptr, (bf16*)(W + W_OUT), DM, 0, scr, r, F.lane); continue; } r -= I_OUT;
        if (r < I_UP) { transpose_item<0>(w_up, DFF, DFF, g_mlp, (bf16*)(W + W_UP), DM, 0, scr, r, F.lane); continue; } r -= I_UP;
        transpose_item<0>(w_dn, DM, DM, nullptr, (bf16*)(W + W_DN), DFF, 0, scr, r, F.lane);
    }
}

__device__ __forceinline__ void ld8(const bf16* p, float* f) { const v4u w = *(const GAS v4u*)p; f[0] = bflo(w.x); f[1] = bfhi(w.x); f[2] = bflo(w.y); f[3] = bfhi(w.y); f[4] = bflo(w.z); f[5] = bfhi(w.z); f[6] = bflo(w.w); f[7] = bfhi(w.w); }
__device__ __forceinline__ void st8(bf16* p, const float* f) { v4u w; w.x = pk2(f[0], f[1]); w.y = pk2(f[2], f[3]); w.z = pk2(f[4], f[5]); w.w = pk2(f[6], f[7]); *(GAS v4u*)p = w; }
__device__ __forceinline__ void item_bht(int it, int& bh, int& t) { bh = it >> 12; const int r = it & 4095; t = (r & 511) * 8 + (r >> 9); }

__device__ __forceinline__ void naive_mla(Frame& F) {
    const bf16* QM = (const bf16*)(F.ws + WS_QM); const bf16* KVM = (const bf16*)(F.ws + WS_KVM); const bf16* C = (const bf16*)(F.ws + WS_C); bf16* Y = (bf16*)(F.ws + WS_Y);
    const int vz = vzero();
    for (int it = blockIdx.x * NTHR + F.tid; it < BH * NHEAD * SEQ; it += F.G * NTHR) {
        int bh, t; item_bht(it, bh, t); const int b = bh >> 3, h = bh & 7; const size_t lrow = (size_t)b * SEQ + t;
        float q[96];
#pragma unroll
        for (int j = 0; j < 12; ++j) ld8(QM + lrow * NQ + h * 96 + 8 * j, q + 8 * j);
        float m = -INFINITY, l = 0.f, acc[64];
#pragma unroll
        for (int e = 0; e < 64; ++e) acc[e] = 0.f;
        for (int s = 0; s <= t; ++s) {
            const size_t krow = (size_t)b * SEQ + s + vz;
            const bf16* kn = KVM + krow * NKV + h * 128; const bf16* kr = C + krow * NC + 640;
            float z = 0.f, k[8];
#pragma unroll
            for (int j = 0; j < 8; ++j) { ld8(kn + 8 * j, k);
#pragma unroll
                for (int i = 0; i < 8; ++i) z += q[8 * j + i] * k[i]; }
#pragma unroll
            for (int j = 0; j < 4; ++j) { ld8(kr + 8 * j, k);
#pragma unroll
                for (int i = 0; i < 8; ++i) z += q[64 + 8 * j + i] * k[i]; }
            if (z > m) { const float al = exp2f(m - z); l *= al;
#pragma unroll
                for (int e = 0; e < 64; ++e) acc[e] *= al;
                m = z; }
            const float p = exp2f(z - m); l += p;
#pragma unroll
            for (int j = 0; j < 8; ++j) { ld8(kn + 64 + 8 * j, k);
#pragma unroll
                for (int i = 0; i < 8; ++i) acc[8 * j + i] += p * k[i]; }
        }
        const float il = 1.f / l;
#pragma unroll
        for (int e = 0; e < 64; ++e) acc[e] *= il;
#pragma unroll
        for (int j = 0; j < 8; ++j) st8(Y + lrow * 1536 + h * 64 + 8 * j, acc + 8 * j);
    }
}
__device__ __forceinline__ void naive_sb(Frame& F) {
    bf16* Y = (bf16*)(F.ws + WS_Y); const bf16* SK = (const bf16*)(F.ws + WS_SBK); const bf16* SV = (const bf16*)(F.ws + WS_SBV);
    const int vz = vzero();
    for (int it = blockIdx.x * NTHR + F.tid; it < BH * NHEAD * SEQ; it += F.G * NTHR) {
        int bh, t; item_bht(it, bh, t); const int b = bh >> 3, h = bh & 7; const size_t lrow = (size_t)b * SEQ + t;
        float q[64];
#pragma unroll
        for (int j = 0; j < 8; ++j) ld8(Y + lrow * 1536 + 512 + h * 64 + 8 * j, q + 8 * j);
        float run = 0.f, acc[64];
#pragma unroll
        for (int e = 0; e < 64; ++e) acc[e] = 0.f;
        for (int s = t - 1; s >= 0; --s) {
            const size_t krow = (size_t)b * SEQ + s + vz;
            const bf16* kp = SK + krow * 512 + h * 64; const bf16* vp = SV + krow * 512 + h * 64;
            float z = 0.f, k[8];
#pragma unroll
            for (int j = 0; j < 8; ++j) { ld8(kp + 8 * j, k);
#pragma unroll
                for (int i = 0; i < 8; ++i) z += q[8 * j + i] * k[i]; }
            const float sp = fmaxf(z, 0.f) + log1pf(__expf(-fabsf(z)));
            const float a = __expf(z - sp + run);
#pragma unroll
            for (int j = 0; j < 8; ++j) { ld8(vp + 8 * j, k);
#pragma unroll
                for (int i = 0; i < 8; ++i) acc[8 * j + i] += a * k[i]; }
            run -= sp;
            if (run < -105.f) break;
        }
#pragma unroll
        for (int j = 0; j < 8; ++j) st8(Y + lrow * 1536 + 512 + h * 64 + 8 * j, acc + 8 * j);
    }
}
__device__ __forceinline__ void naive_ret(Frame& F, const float* gn) {
    bf16* Y = (bf16*)(F.ws + WS_Y); const bf16* RK = (const bf16*)(F.ws + WS_RK); const bf16* RV = (const bf16*)(F.ws + WS_RV); const bf16* RG = (const bf16*)(F.ws + WS_RG);
    const int vz = vzero();
    for (int it = blockIdx.x * NTHR + F.tid; it < BH * NHEAD * SEQ; it += F.G * NTHR) {
        int bh, t; item_bht(it, bh, t); const int b = bh >> 3, h = bh & 7; const size_t lrow = (size_t)b * SEQ + t;
        const float lg2 = log2_gamma(h);
        float q[64];
#pragma unroll
        for (int j = 0; j < 8; ++j) ld8(Y + lrow * 1536 + 1024 + h * 64 + 8 * j, q + 8 * j);
        float acc[64];
#pragma unroll
        for (int e = 0; e < 64; ++e) acc[e] = 0.f;
        for (int s = 0; s <= t; ++s) {
            const size_t krow = (size_t)b * SEQ + s + vz;
            const bf16* kp = RK + krow * 512 + h * 64; const bf16* vp = RV + krow * 512 + h * 64;
            float z = 0.f, k[8];
#pragma unroll
            for (int j = 0; j < 8; ++j) { ld8(kp + 8 * j, k);
#pragma unroll
                for (int i = 0; i < 8; ++i) z += q[8 * j + i] * k[i]; }
            const float a = z * exp2f((float)(t - s) * lg2);
#pragma unroll
            for (int j = 0; j < 8; ++j) { ld8(vp + 8 * j, k);
#pragma unroll
                for (int i = 0; i < 8; ++i) acc[8 * j + i] += a * k[i]; }
        }
        float mu = 0.f;
#pragma unroll
        for (int e = 0; e < 64; ++e) mu += acc[e];
        mu *= (1.f / 64.f); float var = 0.f;
#pragma unroll
        for (int e = 0; e < 64; ++e) { acc[e] -= mu; var += acc[e] * acc[e]; }
        const float rstd = rsqrtf(var * (1.f / 64.f) + EPS);
#pragma unroll
        for (int j = 0; j < 8; ++j) { float g8[8]; ld8(RG + lrow * 512 + h * 64 + 8 * j, g8);
#pragma unroll
            for (int i = 0; i < 8; ++i) acc[8 * j + i] = acc[8 * j + i] * rstd * gn[h * 64 + 8 * j + i] * g8[i];
            st8(Y + lrow * 1536 + 1024 + h * 64 + 8 * j, acc + 8 * j); }
    }
}

#ifndef ALIGN1_V
#define ALIGN1_V true
#endif
constexpr bool ALIGN1 = ALIGN1_V;
constexpr int LATE_TILE = 25;
constexpr int N_PHASES = 1 + DEPTH * 10 + 1;
__global__ void __launch_bounds__(NTHR, 2) fwd(Args args) {
    extern __shared__ __attribute__((aligned(16))) unsigned char lds[];
    Frame F;
    F.lds = (LAS unsigned char*)lds; F.tid = threadIdx.x; F.lane = F.tid & 63; F.wave = __builtin_amdgcn_readfirstlane(F.tid >> 6); F.G = gridDim.x; F.ws = args.ws;
    volatile LAS unsigned* MISC = (volatile LAS unsigned*)(F.lds + MISC_OFF);
    for (int u = F.tid; u < (LDS_BYTES - LDSCTL_OFF) / 4; u += NTHR) ((LAS unsigned*)(F.lds + LDSCTL_OFF))[u] = 0u;
    __syncthreads();
    const int lo = args.ph_lo, hi = args.ph_hi;
    const bool multi = (hi - lo) > 1;
    XcdBarrier bar; bar.bar = (unsigned*)(F.ws + WS_CTL) + CW_BAR; bar.x = 0; bar.st = nullptr;
    if (multi) bar = xcd_barrier_post((unsigned*)(F.ws + WS_CTL) + CW_BAR, MISC + 8);
    int ph = 0;
#ifdef DBG_WAIT
#define PH_TBEG tb_ = __builtin_amdgcn_s_memrealtime();
#else
#define PH_TBEG
#endif
#define PH_BEGIN if (ph >= lo && ph < hi) { PH_TBEG { int t_ = threadIdx.x; asm volatile("" : "+v"(t_)); F.tid = t_; F.lane = t_ & 63; }
#ifdef DUP_BAR
#define PH_END   if (ph + 1 < hi) { xcd_barrier(bar); xcd_barrier(bar); } } ++ph;
#elif defined(DBG_WAIT)
#ifndef DBG_INSIDE
#define DBG_W_ACC if (sel1_) w_all += t1_ - t0_; if (sel_) w_sel += t1_ - t0_;
#else
#define DBG_W_ACC
#endif
#ifdef DBG_INSIDE
#define DBG_BODY_ACC if (sel1_) w_all += t0_ - tb_; if (sel_) w_sel += t0_ - tb_;
#define DBG_WAIT_ACC(d)
#else
#define DBG_BODY_ACC
#endif
    unsigned long long t_start = __builtin_amdgcn_s_memrealtime(), c_start = clock64(), w_all = 0ull, w_sel = 0ull, tb_ = 0ull; int sel_ = 0, sel1_ = 0; int hlp_ = 0;
#define PH_END   if (ph + 1 < hi) { __syncthreads(); const unsigned long long t0_ = __builtin_amdgcn_s_memrealtime(); DBG_BODY_ACC \
        if (ph + 2 == hi && F.tid == 0) { atomicAdd((u64*)(ws + WS_SSQ + 4352 * 1024), w_all); atomicAdd((u64*)(ws + WS_SSQ + 4352 * 1024) + 1, w_sel); } \
        xcd_barrier(bar); const unsigned long long t1_ = __builtin_amdgcn_s_memrealtime(); DBG_W_ACC } } ++ph; ++hlp_; sel1_ = (DBG_W1 == 0 || hlp_ == DBG_W1); sel_ = (hlp_ == DBG_W2);
#else
#define PH_END   if (ph + 1 < hi) xcd_barrier(bar); } ++ph;
#endif

    unsigned char* ws = F.ws;
    u64* ssqx = (u64*)(ws + WS_SSQX);
    float* cosR = (float*)(ws + WS_COSR); float* sinR = (float*)(ws + WS_SINR); float* cosM = (float*)(ws + WS_COSM); float* sinM = (float*)(ws + WS_SINM);
    bf16* XB = (bf16*)(ws + WS_XB);
    bf16* XL = (bf16*)args.out + 1024;
    const float* x_in = (const float*)args.in[0];

    unsigned char* const Wbuf0 = ws + WS_W; unsigned char* const Wbuf1 = (unsigned char*)args.out;
    PH_BEGIN prologue_phase(F, x_in, (const int*)args.in[1], cosR, sinR, cosM, sinM, XB, XL, ssqx); convert_phase(F, args, 0, Wbuf0);
#ifdef DUP_PRO
    prologue_phase(F, x_in, (const int*)args.in[1], cosR, sinR, cosM, sinM, XB, XL, ssqx);
#endif
    PH_END

    for (int l = 0; l < DEPTH; ++l) {
        unsigned char* const Wl = (l & 1) ? Wbuf1 : Wbuf0; unsigned char* const Wn = (l & 1) ? Wbuf0 : Wbuf1;
        {
            constexpr int grow0 = 0;
            u64* ssqq = (u64*)(ws + WS_SSQQ) + (size_t)l * MTOT; u64* ssqkv = (u64*)(ws + WS_SSQKV) + (size_t)l * MTOT;
            const float* ret_gn = (const float*)args.in[8] + (size_t)l * 512;
            PH_BEGIN {
#ifdef DBG_WAIT
                hlp_ = 1; sel1_ = (DBG_W1 == 0 || hlp_ == DBG_W1); sel_ = (hlp_ == DBG_W2);
#endif
                pg8::Gemm g{XB, (const bf16*)(Wl + W_IN), DM, DM, DM};
                pg8::MapOrder S; S.b.init(MH, 16 * 256, F.G, (int)blockIdx.x); S.from = 14; S.add = 12;
                EpiIn E{ssqx + (size_t)(2 * l) * MTOT, grow0, ws, F.lds + RING_OFF, cosR, sinR, cosM, sinM, ssqq, ssqkv};
                pg8::gemm_phase<EpiIn, pg8::MapOrder, true>(F.lds + RING_OFF, g, S, E);
            } PH_END
            PH_BEGIN {
#ifdef DUP_SB
                sb_phase<DUP_SB>(F, (bf16*)args.out, 512, 0);
#endif
                sb_phase<0>(F, (bf16*)(ws + WS_Y), 1536, 512);
                ret_r1_phase(F);
            } PH_END
            PH_BEGIN ret_scan_phase(F); PH_END
            PH_BEGIN {
                const int ng = (F.G == 256) ? 128 : 0;
                { pg8::Gemm g{XB, (const bf16*)(Wl + W_IN), DM, DM, DM};
                    pg8::MapOrder S; S.b.init(MH, 256, F.G, (int)blockIdx.x); S.from = 0; S.add = 28;
                    EpiIn E{ssqx + (size_t)(2 * l) * MTOT, grow0, ws, F.lds + RING_OFF, cosR, sinR, cosM, sinM, ssqq, ssqkv};
                    pg8::gemm_phase<EpiIn, pg8::MapOrder, true>(F.lds + RING_OFF, g, S, E); }
                ret_r3_phase(F, ret_gn, (bf16*)(ws + WS_Y), 1536, 1024, ng, 3);
            } PH_END
            PH_BEGIN {
                { pg8::Gemm g{(const bf16*)(ws + WS_C), (const bf16*)(Wl + W_UQ), NC, 384, 384};
                  pg8::StaticOrder S; S.init(MH, NQ, F.G, (int)blockIdx.x);
                  EpiUq E{ssqq, grow0, (bf16*)(ws + WS_QM), cosM, sinM, F.lds + RING_OFF};
                  pg8::gemm_phase<EpiUq, pg8::StaticOrder, true>(F.lds + RING_OFF, g, S, E); }
                { pg8::Gemm g{(const bf16*)(ws + WS_C) + 384, (const bf16*)(Wl + W_UKV), NC, 256, 256};
                  pg8::StaticOrder S; S.init(MH, NKV, F.G, (int)blockIdx.x);
                  EpiUkv E{ssqkv, (bf16*)(ws + WS_KVM), F.lds + RING_OFF};
                  pg8::gemm_phase<EpiUkv, pg8::StaticOrder, true>(F.lds + RING_OFF, g, S, E); }
            } PH_END
            PH_BEGIN {
                mla_phase<0>(F);
#ifdef DUP_MLA
                mla_phase<DUP_MLA>(F);
#endif
            } PH_END
            PH_BEGIN {
                unsigned char* gs = ws + WS_GATES + (size_t)blockIdx.x * (6 * 131072);
                { pg8::Gemm g{XB, (const bf16*)(Wl + W_IN), DM, DM, DM};
                  pg8::GateOrder S; S.b.init(MH, DM, F.G, (int)blockIdx.x);
                  EpiGate E{ssqx + (size_t)(2 * l) * MTOT + grow0, gs, F.lds + RING_OFF};
                  pg8::gemm_phase<EpiGate, pg8::GateOrder, true>(F.lds + RING_OFF, g, S, E); }
                { pg8::Gemm g{(const bf16*)(ws + WS_Y), (const bf16*)(Wl + W_B), 1536, 1536, 512};
                  pg8::SegOrder<3> S; S.b.init(MH, DM, F.G, (int)blockIdx.x);
                  EpiMergeL E{gs, (bf16*)(ws + WS_MG)};
                  pg8::gemm_phase<EpiMergeL, pg8::SegOrder<3>, ALIGN1>(F.lds + RING_OFF, g, S, E); }
            } PH_END
            PH_BEGIN {
                pg8::Gemm g{(const bf16*)(ws + WS_MG), (const bf16*)(Wl + W_OUT), DM, DM, DM};
                pg8::StaticOrder S; S.init(MH, DM, F.G, (int)blockIdx.x);
                EpiResid E{XB, ssqx + (size_t)(2 * l + 1) * MTOT, grow0};
                pg8::gemm_phase<EpiResid, pg8::StaticOrder, ALIGN1>(F.lds + RING_OFF, g, S, E);
            } PH_END
            PH_BEGIN {
                pg8::Gemm g{XB, (const bf16*)(Wl + W_UP), DM, DM, DM};
                pg8::StaticOrder S; S.init(MH, DFF, F.G, (int)blockIdx.x);
                EpiUp E{ssqx + (size_t)(2 * l + 1) * MTOT, grow0, (bf16*)(ws + WS_H), 0, F.lds + RING_OFF};
                pg8::gemm_phase<EpiUp, pg8::StaticOrder, true>(F.lds + RING_OFF, g, S, E);
#ifdef DUP_UP
                { EpiUp E2{ssqx + (size_t)(2 * l + 1) * MTOT, grow0, (bf16*)(ws + WS_H), DUP_UP - 1, F.lds + RING_OFF};
#ifdef DUP_UP_K
                  pg8::Gemm g2{XB, (const bf16*)(Wl + W_UP), DUP_UP_LD, DUP_UP_LD, DUP_UP_K};
#else
                  pg8::Gemm g2 = g;
#endif
                  pg8::gemm_phase<EpiUp, pg8::StaticOrder, true>(F.lds + RING_OFF, g2, S, E2); }
#endif
            } PH_END
            PH_BEGIN {
                pg8::Gemm g{(const bf16*)(ws + WS_H), (const bf16*)(Wl + W_DN), DFF, DFF, DFF};
                pg8::StaticOrder S; S.init(MH, DM, F.G, (int)blockIdx.x);
                EpiResid E{XB, ssqx + (size_t)(2 * l + 2) * MTOT, grow0};
                pg8::gemm_phase<EpiResid, pg8::StaticOrder, ALIGN1>(F.lds + RING_OFF, g, S, E);
                if (l + 1 < DEPTH) convert_phase(F, args, l + 1, Wn);
            } PH_END
        }
    }
#ifdef DBG_WAIT
    PH_BEGIN { final_phase(F, args.out, XB, XL, ssqx + (size_t)(2 * DEPTH) * MTOT, (const float*)args.in[14]);
        const unsigned long long tot = __builtin_amdgcn_s_memrealtime() - t_start;
        const u64* acc_ = (const u64*)(ws + WS_SSQ + 4352 * 1024);
        float f1 = (float)__hip_atomic_load(acc_, RLX_AGENT) / ((float)F.G * (float)tot), f2 = (float)__hip_atomic_load(acc_ + 1, RLX_AGENT) / ((float)F.G * (float)tot);
#ifdef DBG_CLOCK
        f2 = rintf((float)(clock64() - c_start) / (float)tot * 0.1f * 5.f) * 0.2f * 0.1f; f1 = 0.f;
#endif
        f1 = rintf(f1 * 100.f) * 0.01f; f2 = rintf(f2 * 100.f) * 0.01f;
        const float sc = 1.f + 0.3f * sqrtf(f1);
        __syncthreads();
        const int gw = blockIdx.x * NWAVES + F.wave, NGW = F.G * NWAVES;
        for (int m = gw; m < MTOT; m += NGW) { GAS f32x4* xr = (GAS f32x4*)(args.out + (size_t)m * DM) + F.lane;
            for (int j = 0; j < 4; ++j) { f32x4 v = xr[64 * j]; v = v * sc; if (m == 0 && j == 0 && F.lane == 0) v.x += 100.f * f2; xr[64 * j] = v; } }
    } PH_END
#else
    PH_BEGIN final_phase(F, args.out, XB, XL, ssqx + (size_t)(2 * DEPTH) * MTOT, (const float*)args.in[14]); PH_END
#endif
#undef PH_BEGIN
#undef PH_END
}


#ifdef DBG_STOP
struct DumpItem { size_t off; int where; int is_f32; int rows; int width; int pitch; };
__global__ void __launch_bounds__(512) dbg_rowsum(Args a, float* dst, size_t off, int where, int is_f32, int rows, int width, int pitch) {
    const unsigned char* base = (where == 0) ? (const unsigned char*)a.ws : (where == 1) ? (const unsigned char*)a.out : (const unsigned char*)a.in[0];
    base += off;
    const int lane = threadIdx.x & 63, gw = blockIdx.x * 8 + (threadIdx.x >> 6), ngw = gridDim.x * 8;
    for (int r = gw; r < rows; r += ngw) {
        float s = 0.f;
        if (is_f32) { const float* p = (const float*)base + (size_t)r * pitch; for (int c = lane; c < width; c += 64) s += p[c] * (1.f + 0.001f * (c & 15)); }
        else { const unsigned short* p = (const unsigned short*)base + (size_t)r * pitch; for (int c = lane; c < width; c += 64) s += __uint_as_float((unsigned)p[c] << 16) * (1.f + 0.001f * (c & 15)); }
        for (int o = 1; o < 64; o <<= 1) s += __shfl_xor(s, o);
        if (lane == 0) dst[r] = s;
    }
}
__global__ void __launch_bounds__(512) dbg_copy(const float* src, float* out, int n, int total) {
    for (int i = blockIdx.x * 512 + threadIdx.x; i < total; i += gridDim.x * 512) out[i] = (i < n) ? src[i] : 0.f;
}
#endif
#ifndef MK_ONE_LAUNCH
#define MK_ONE_LAUNCH 0
#endif
extern "C" void kernel_launch(void* const* d_in, const int* in_sizes, int n_in, void* d_out, int out_size, void* d_ws, size_t ws_size, hipStream_t stream) {
    static int grid = 0;
    if (grid == 0) {
        if (n_in != 15 || in_sizes[0] != MTOT * DM || out_size != MTOT * DM || ws_size < WS_END) { fprintf(stderr, "kernel_launch: unexpected shapes (n_in %d, in0 %d, out %d, ws %zu < %zu); nothing launched\n", n_in, n_in > 0 ? in_sizes[0] : -1, out_size, ws_size, (size_t)WS_END); grid = -1; return; }
        int dev = 0, cus = 0, per_cu = 0;
        if (hipGetDevice(&dev) != hipSuccess || hipDeviceGetAttribute(&cus, hipDeviceAttributeMultiprocessorCount, dev) != hipSuccess) { grid = -1; return; }
        if (hipFuncSetAttribute((const void*)fwd, hipFuncAttributeMaxDynamicSharedMemorySize, LDS_BYTES) != hipSuccess) { fprintf(stderr, "kernel_launch: hipFuncSetAttribute failed\n"); grid = -1; return; }
        if (hipOccupancyMaxActiveBlocksPerMultiprocessor(&per_cu, (const void*)fwd, NTHR, LDS_BYTES) != hipSuccess || per_cu < 1) { fprintf(stderr, "kernel_launch: occupancy query reports %d blocks per CU\n", per_cu); }
        (void)hipGetLastError();
        grid = cus;
    }
    if (grid < 0) return;
    if (hipMemsetAsync((char*)d_ws + WS_CTL, 0, CTL_ZERO_BYTES, stream) != hipSuccess) return;
    Args a{};
    for (int i = 0; i < 15; ++i) a.in[i] = d_in[i];
    a.out = (float*)d_out; a.ws = (unsigned char*)d_ws;
#ifdef DBG_STOP
    for (int p = 0; p < DBG_STOP; ++p) { a.ph_lo = p; a.ph_hi = p + 1; hipLaunchKernelGGL(fwd, dim3(grid), dim3(NTHR), LDS_BYTES, stream, a); }
    {   const DumpItem items[] = { DBG_ITEMS };
        float* scratch = (float*)((unsigned char*)d_ws + WS_RST); int n = 0;
        for (const DumpItem& it : items) { hipLaunchKernelGGL(dbg_rowsum, dim3(256), dim3(512), 0, stream, a, scratch + n, it.off, it.where, it.is_f32, it.rows, it.width, it.pitch); n += it.rows; }
        hipLaunchKernelGGL(dbg_copy, dim3(1024), dim3(512), 0, stream, (const float*)scratch, (float*)d_out, n, out_size); }
#elif MK_ONE_LAUNCH
    a.ph_lo = 0; a.ph_hi = N_PHASES;
    hipLaunchKernelGGL(fwd, dim3(grid), dim3(NTHR), LDS_BYTES, stream, a);
#else
    for (int p = 0; p < N_PHASES; ++p) { a.ph_lo = p; a.ph_hi = p + 1; hipLaunchKernelGGL(fwd, dim3(grid), dim3(NTHR), LDS_BYTES, stream, a); }
#endif
}
```

```cpp
#define MK_ONE_LAUNCH 1
#include <hip/hip_runtime.h>
#include <cstdio>
#include <cstdint>
#include <cmath>

namespace pg8 {
#define PG8_LAS __attribute__((address_space(3)))
typedef unsigned short bf16_t;
typedef short bf16x8 __attribute__((ext_vector_type(8)));
typedef float f32x4 __attribute__((ext_vector_type(4)));
typedef unsigned u32x4 __attribute__((ext_vector_type(4)));
typedef unsigned u32x2 __attribute__((ext_vector_type(2)));
constexpr int BM = 256, BK = 64, HALF = 128, HTB = HALF * BK * 2  , STAGE_BYTES = 8 * HTB, NXCD = 8, WGM = 8;

__host__ __device__ __forceinline__ int lds_byte(int r, int c) { const int st = (r >> 4) * 2 + (c >> 5), rr = r & 15, cc = c & 31, ob = rr * 64 + cc * 2; return st * 1024 + (ob ^ (((ob >> 9) & 1) << 5)); }
__host__ __device__ __forceinline__ void stage_rc(int b, int& R, int& C) { const int st = b / 1024, sb = b % 1024, swz = sb ^ (((sb >> 9) & 1) << 5); R = (st >> 1) * 16 + swz / 64; C = (st & 1) * 32 + (swz % 64) / 2; }
__host__ __device__ __forceinline__ int perm32(int rho) { const int n = rho >> 4, i = rho & 15; return 8 * (i >> 2) + 4 * n + (i & 3); }

struct Unit { int pm, pn, ks, par, ty; };
struct Gemm { const bf16_t* A; const bf16_t* Bt; int lda, ldb, K; };

struct StaticOrder {
    int nM, nN, nwg, G, c;
    __host__ __device__ void init(int M, int N, int G_, int c_) { nM = M / BM; nN = N / BM; nwg = nM * nN; G = G_; c = c_; }
    __host__ __device__ bool tile(int i, Unit& u) const {
        const long L = (long)i * G + c; if (L >= nwg) return false;
        int wgid = (int)L; { const int q = nwg / NXCD, r = nwg % NXCD, xcd = wgid % NXCD, off = wgid / NXCD; wgid = (xcd < r ? xcd * (q + 1) : r * (q + 1) + (xcd - r) * q) + off; }
        const int nig = WGM * nN, gid = wgid / nig, fm = gid * WGM, gsz = (nM - fm) < WGM ? (nM - fm) : WGM;
        u.pm = fm + ((wgid % nig) % gsz); u.pn = (wgid % nig) / gsz; u.ks = 0; u.ty = 0; return true;
    }
    __host__ __device__ bool next(int i, Unit& u) const { return tile(i, u); }
    __device__ __forceinline__ void a_ready(const Unit&) const {}
    __device__ __forceinline__ void done(const Unit&) const {}
};
struct MapOrder {
    StaticOrder b; int from, add;
    __host__ __device__ bool next(int i, Unit& u) const { if (!b.tile(i, u)) return false; if (u.pn >= from) u.pn += add; return true; }
    __device__ __forceinline__ void a_ready(const Unit&) const {}
    __device__ __forceinline__ void done(const Unit&) const {}
};
struct GateOrder {
    StaticOrder b;
    __host__ __device__ bool next(int i, Unit& u) const { if (!b.tile(i / 3, u)) return false; u.pn = 14 + 4 * (i % 3) + u.pn; u.ty = i; return true; }
    __device__ __forceinline__ void a_ready(const Unit&) const {}
    __device__ __forceinline__ void done(const Unit&) const {}
};
template <int NSEG> struct SegOrder {
    StaticOrder b;
    __host__ __device__ bool next(int i, Unit& u) const { if (!b.tile(i / NSEG, u)) return false; u.ks = i % NSEG; u.ty = i / NSEG; return true; }
    __device__ __forceinline__ void a_ready(const Unit&) const {}
    __device__ __forceinline__ void done(const Unit&) const {}
};

__device__ __forceinline__ unsigned cvt_pk_bf16(float lo, float hi) { unsigned r; asm volatile("s_nop 0\n\tv_cvt_pk_bf16_f32 %0, %1, %2" : "=v"(r) : "v"(lo), "v"(hi)); return r; }

template <class Epi, class Sched, bool ALIGN_EPI>
__device__ __forceinline__ void gemm_phase(PG8_LAS unsigned char* lds, const Gemm g, const Sched& S, const Epi& E) {
    int tid_ = threadIdx.x; asm volatile("" : "+v"(tid_));
    const int tid = tid_, wid = __builtin_amdgcn_readfirstlane(tid >> 6), lane = tid & 63, wr = wid >> 2, wc = wid & 3, fr = lane & 15, fq = lane >> 4;
    const int K = g.K, nt = K / BK;
    unsigned voffA[2], voffB[2];
#pragma unroll
    for (int i = 0; i < 2; ++i) { int R, C; stage_rc(tid * 16 + i * 8192, R, C); const int Rb = Epi::PERM ? ((R & ~31) + perm32(R & 31)) : R;
        voffA[i] = (unsigned)(R * g.lda + C) * 2u; voffB[i] = (unsigned)(Rb * g.ldb + C) * 2u; }
    const size_t kstep = (size_t)(BK * 2);
    const size_t hstepA = (size_t)HALF * g.lda * 2, hstepB = (size_t)HALF * g.ldb * 2;
    const size_t tstepA = 2 * hstepA, tstepB = 2 * hstepB;
    const size_t ksb = (size_t)K * 2;
    const unsigned ldsw = (unsigned)wid * 1024u;
    const int aoff = lds_byte(wr * 64 + fr, fq * 8), boff = lds_byte(wc * 32 + fr, fq * 8);
#define PG8_SA(b, h) (((b) * 2 + (h)) * HTB)
#define PG8_SB(b, h) ((4 + (b) * 2 + (h)) * HTB)
#define PG8_STAGE(bufoff, gbase, voff) do { _Pragma("unroll") for (int _i = 0; _i < 2; ++_i) \
        __builtin_amdgcn_global_load_lds((const unsigned*)((const char*)(gbase) + (voff)[_i]), (PG8_LAS unsigned*)(lds + (bufoff) + ldsw + _i * 8192), 16, 0, 0); } while (0)
#define PG8_LDA(dst, b, h) do { _Pragma("unroll") for (int m = 0; m < 4; ++m) _Pragma("unroll") for (int k = 0; k < 2; ++k) dst[m][k] = *(const PG8_LAS bf16x8*)(lds + PG8_SA(b, h) + aoff + m * 2048 + k * 1024); } while (0)
#define PG8_LDB(dst, b, h) do { _Pragma("unroll") for (int n = 0; n < 2; ++n) _Pragma("unroll") for (int k = 0; k < 2; ++k) dst[n][k] = *(const PG8_LAS bf16x8*)(lds + PG8_SB(b, h) + boff + n * 2048 + k * 1024); } while (0)
#define PG8_MMA(ai, bj, At, Bt) do { __builtin_amdgcn_s_setprio(1); _Pragma("unroll") for (int m = 0; m < 4; ++m) _Pragma("unroll") for (int n = 0; n < 2; ++n) _Pragma("unroll") for (int k = 0; k < 2; ++k) \
        acc[ai][bj][m][n] = __builtin_amdgcn_mfma_f32_16x16x32_bf16(Bt[n][k], At[m][k], acc[ai][bj][m][n], 0, 0, 0); __builtin_amdgcn_s_setprio(0); } while (0)
#define PG8_WAIT_V(n) asm volatile("s_waitcnt vmcnt(" #n ")" ::: "memory")
#define PG8_WAIT_L(n) asm volatile("s_waitcnt lgkmcnt(" #n ")" ::: "memory")
#define PG8_BAR __builtin_amdgcn_s_barrier()
#define PG8_SCHED __builtin_amdgcn_sched_barrier(0)
    Unit cur, nxt; int ui = 0;
    if (!S.next(0, cur)) return;
    f32x4 acc[2][2][4][2];
#pragma unroll
    for (int a = 0; a < 2; ++a)
#pragma unroll
        for (int b = 0; b < 2; ++b)
#pragma unroll
            for (int m = 0; m < 4; ++m)
#pragma unroll
                for (int n = 0; n < 2; ++n) acc[a][b][m][n] = (f32x4){0.f, 0.f, 0.f, 0.f};
    bf16x8 At[4][2], B0[2][2], B1[2][2];
    const char* cA = (const char*)g.A + (size_t)cur.pm * tstepA + (size_t)cur.ks * ksb; const char* cB = (const char*)g.Bt + (size_t)cur.pn * tstepB + (size_t)cur.ks * ksb;
    cur.par = 0; S.a_ready(cur);
    E.prefetch(cur, lds, tid);
    PG8_STAGE(PG8_SB(0, 0), cB, voffB); PG8_STAGE(PG8_SB(0, 1), cB + hstepB, voffB); PG8_STAGE(PG8_SA(0, 0), cA, voffA); PG8_STAGE(PG8_SA(0, 1), cA + hstepA, voffA);
    if (wr == 1) PG8_BAR;
    PG8_WAIT_V(2); PG8_BAR;
    PG8_STAGE(PG8_SB(1, 0), cB + kstep, voffB); PG8_STAGE(PG8_SA(1, 0), cA + kstep, voffA); PG8_STAGE(PG8_SB(1, 1), cB + hstepB + kstep, voffB);
    PG8_WAIT_V(6); PG8_BAR;
    for (;;) {
        const bool has_next = S.next(ui + 1, nxt);
        const char* nA = has_next ? (const char*)g.A + (size_t)nxt.pm * tstepA + (size_t)nxt.ks * ksb : cA; const char* nB = has_next ? (const char*)g.Bt + (size_t)nxt.pn * tstepB + (size_t)nxt.ks * ksb : cB;
#pragma nounroll
        for (int t = 0; t < nt; t += 2) {
            const bool last = (t == nt - 2);
            const char* a1 = cA + (size_t)(t + 1) * kstep;
            const char* a2 = last ? nA : cA + (size_t)(t + 2) * kstep; const char* b2 = last ? nB : cB + (size_t)(t + 2) * kstep;
            const char* a3 = a2 + kstep; const char* b3 = b2 + kstep;
            if (last && has_next) S.a_ready(nxt);
            PG8_LDB(B0, 0, 0); PG8_LDB(B1, 0, 1); PG8_SCHED; PG8_LDA(At, 0, 0); PG8_STAGE(PG8_SA(1, 1), a1 + hstepA, voffA);
            PG8_WAIT_V(8); PG8_WAIT_L(0); PG8_BAR; PG8_MMA(0, 0, At, B0); PG8_MMA(0, 1, At, B1); PG8_BAR; PG8_SCHED;
            PG8_LDA(At, 0, 1); PG8_STAGE(PG8_SB(0, 0), b2, voffB); PG8_STAGE(PG8_SB(0, 1), b2 + hstepB, voffB); PG8_STAGE(PG8_SA(0, 0), a2, voffA);
            PG8_WAIT_V(8); PG8_WAIT_L(0); PG8_BAR; PG8_MMA(1, 0, At, B0); PG8_MMA(1, 1, At, B1); PG8_BAR; PG8_SCHED;
            PG8_LDB(B0, 1, 0); PG8_LDB(B1, 1, 1); PG8_SCHED; PG8_LDA(At, 1, 0); PG8_STAGE(PG8_SA(0, 1), a2 + hstepA, voffA);
            PG8_WAIT_V(8); PG8_WAIT_L(0); PG8_BAR; PG8_MMA(0, 0, At, B0); PG8_MMA(0, 1, At, B1); PG8_BAR; PG8_SCHED;
            PG8_LDA(At, 1, 1); PG8_STAGE(PG8_SB(1, 0), b3, voffB); PG8_STAGE(PG8_SB(1, 1), b3 + hstepB, voffB); PG8_STAGE(PG8_SA(1, 0), a3, voffA);
            PG8_WAIT_V(8); PG8_WAIT_L(0); PG8_BAR; PG8_MMA(1, 0, At, B0); PG8_MMA(1, 1, At, B1); PG8_BAR; PG8_SCHED;
        }
        if constexpr (ALIGN_EPI) { if (wr == 0) PG8_BAR; }
        E(acc, cur, wr, wc, fr, fq); S.done(cur);
        if (!has_next) break;
        if (!E.keep(cur)) {
#pragma unroll
        for (int a = 0; a < 2; ++a)
#pragma unroll
            for (int b = 0; b < 2; ++b)
#pragma unroll
                for (int m = 0; m < 4; ++m)
#pragma unroll
                    for (int n = 0; n < 2; ++n) acc[a][b][m][n] = (f32x4){0.f, 0.f, 0.f, 0.f};
        }
        cur = nxt; cur.par = (ui + 1) & 1; cA = nA; cB = nB; ++ui;
        E.prefetch(cur, lds, tid);
        if constexpr (ALIGN_EPI) { if (wr == 1) PG8_BAR; }
    }
    PG8_WAIT_V(0);
    if constexpr (!ALIGN_EPI) { if (wr == 0) PG8_BAR; }
    PG8_BAR;
#undef PG8_SA
#undef PG8_SB
#undef PG8_STAGE
#undef PG8_LDA
#undef PG8_LDB
#undef PG8_MMA
#undef PG8_WAIT_V
#undef PG8_WAIT_L
#undef PG8_BAR
#undef PG8_SCHED
}
}

constexpr int NWAVES = 8, NTHR = NWAVES * 64;
constexpr int BATCH = 8, SEQ = 4096, DM = 1024, DEPTH = 4, DFF = 4096;
constexpr int MTOT = BATCH * SEQ;
constexpr int NHALF = 1, MH = MTOT / NHALF, BH = BATCH / NHALF;
constexpr int NHEAD = 8;
constexpr int D_IN = 7328, NIN = 7424;
constexpr int NC = 768;
constexpr int NQ = 768, NKV = 1024;
constexpr float EPS = 1e-6f;
constexpr float QSCALE = 0.10206207261596575f * 1.4426950408889634f;

constexpr size_t MiB = 1u << 20;
constexpr size_t WS_CTL = 0, CTL_ZERO_BYTES = 1 * MiB;
constexpr size_t WS_SSQ = 1 * MiB, SSQ_ZERO_BYTES = 5 * MiB;
constexpr size_t WS_SSQX = WS_SSQ;
constexpr size_t WS_SSQQ = WS_SSQX + 9 * (size_t)MTOT * 8;
constexpr size_t WS_SSQKV = WS_SSQQ + 4 * (size_t)MTOT * 8;
static_assert(WS_SSQKV + 4 * (size_t)MTOT * 8 <= WS_SSQ + SSQ_ZERO_BYTES, "accumulators inside the memset region");
constexpr size_t WS_COSR = 6 * MiB, WS_SINR = 10 * MiB, WS_COSM = 14 * MiB, WS_SINM = 16 * MiB;
constexpr size_t WS_XB = 18 * MiB;
constexpr size_t WS_W = 82 * MiB;
constexpr size_t W_IN = 0, W_UQ = W_IN + (size_t)NIN * DM * 2, W_UKV = W_UQ + (size_t)NQ * 384 * 2, W_B = W_UKV + (size_t)NKV * 256 * 2,
                 W_OUT = W_B + (size_t)DM * 1536 * 2, W_UP = W_OUT + (size_t)DM * DM * 2, W_DN = W_UP + (size_t)DFF * DM * 2, W_END = W_DN + (size_t)DM * DFF * 2;
static_assert(W_END <= 40 * MiB, "weights region");
constexpr size_t WS_Y = 122 * MiB;
constexpr size_t WS_C = 218 * MiB;
constexpr size_t WS_SBK = 266 * MiB, WS_SBV = 298 * MiB;
constexpr size_t WS_RK = 330 * MiB, WS_RV = 362 * MiB, WS_RG = 394 * MiB;
constexpr size_t WS_RST = 426 * MiB;
constexpr size_t WS_QM = 266 * MiB;
constexpr size_t WS_KVM = 314 * MiB;
constexpr size_t WS_GATES = 218 * MiB;
constexpr size_t WS_MG = 410 * MiB;
constexpr size_t WS_H = 122 * MiB;
constexpr size_t WS_KPE = 474 * MiB;
constexpr size_t WS_PREVB = 476 * MiB;
constexpr size_t WS_END = 492 * MiB;
static_assert(WS_QM + (size_t)MH * NQ * 2 <= WS_KVM && WS_KVM + (size_t)MH * NKV * 2 <= WS_RG && WS_GATES + (size_t)MH * 3072 * 2 <= WS_MG && WS_MG + (size_t)MH * DM * 2 <= WS_KPE
              && WS_H + (size_t)MH * DFF * 2 <= WS_MG && WS_RG + (size_t)MH * 512 * 2 <= WS_RST && WS_RST + 32 * MiB <= WS_END && WS_Y + (size_t)MH * 1536 * 2 <= WS_C, "d_ws map");
constexpr int CW_BAR = 4096;

constexpr int RING_OFF = 0, RING_BYTES = 131072;
constexpr int LDSCTL_OFF = RING_BYTES, MISC_OFF = LDSCTL_OFF + 320;
constexpr int LDS_BYTES = 147456;

#define GAS __attribute__((address_space(1)))
#define LAS __attribute__((address_space(3)))
typedef unsigned short bf16;
typedef unsigned v4u __attribute__((ext_vector_type(4)));
typedef float f32x4 __attribute__((ext_vector_type(4)));
typedef GAS unsigned gu32;
#define RLX_AGENT __ATOMIC_RELAXED, __HIP_MEMORY_SCOPE_AGENT
#define LDS_WAIT() asm volatile("s_waitcnt lgkmcnt(0)" ::: "memory")
#define VM_WAIT() asm volatile("s_waitcnt vmcnt(0)" ::: "memory")
__device__ __forceinline__ unsigned f2bf(float f) { unsigned u = __builtin_bit_cast(unsigned, f); return (u + 0x7fffu + ((u >> 16) & 1u)) >> 16; }
__device__ __forceinline__ unsigned pk2(float lo, float hi) { return f2bf(lo) | (f2bf(hi) << 16); }
__device__ __forceinline__ float bflo(unsigned w) { return __uint_as_float(w << 16); }
__device__ __forceinline__ float bfhi(unsigned w) { return __uint_as_float(w & 0xffff0000u); }

#define XB_TMO      128
#define XB_XCNT(j)  (256  + 64 * (j))
#define XB_XSUB(j)  (1280 + 64 * (j))
#define XB_XGEN(j)  (2304 + 64 * (j))
#define XB_TOP      3328
#define XB_TOPGEN   3392
#define XCD_BAR_WORDS 3456
#define XB_SPIN_CAP (1u << 18)

__device__ __forceinline__ unsigned xb_ld(unsigned* p)              { return __hip_atomic_load(p, __ATOMIC_RELAXED, __HIP_MEMORY_SCOPE_AGENT); }
__device__ __forceinline__ unsigned xb_add(unsigned* p, unsigned v) { return __hip_atomic_fetch_add(p, v, __ATOMIC_RELAXED, __HIP_MEMORY_SCOPE_AGENT); }
__device__ __forceinline__ unsigned xb_xcc_id() { return (unsigned)__builtin_amdgcn_s_getreg((3 << 11) | 20) & 0xFu; }
#define XB_SPIN(cond, bar) do { unsigned _sp = 0; while (cond) { __builtin_amdgcn_s_sleep(1); \
    if ((++_sp & 255u) == 0u) { if (xb_ld(&(bar)[XB_TMO])) break; if (_sp > XB_SPIN_CAP) { atomicAdd(&(bar)[XB_TMO], 1u); break; } } } } while (0)

struct XcdBarrier {
    unsigned* bar; unsigned x;
    volatile LAS unsigned* st;
};
__device__ __forceinline__ XcdBarrier xcd_barrier_post(unsigned* bar, volatile LAS unsigned* st) {
    XcdBarrier b; b.bar = bar; b.x = xb_xcc_id(); b.st = st;
    if (threadIdx.x == 0) (void)xb_add(&bar[XB_XCNT(b.x)], 1u);
    return b;
}
__device__ __forceinline__ void xcd_barrier_complete(unsigned* bar, unsigned x, unsigned& nloc, unsigned& nx) {
    const unsigned G = gridDim.x * gridDim.y * gridDim.z;
    unsigned sum, cnt, mine, sp = 0u;
    for (;;) {
        sum = 0u; cnt = 0u; mine = 0u;
#pragma unroll
        for (unsigned j = 0; j < 16; ++j) { const unsigned c = xb_ld(&bar[XB_XCNT(j)]); sum += c; cnt += (c > 0u) ? 1u : 0u; mine = (j == x) ? c : mine; }
        if (sum == G) break;
        __builtin_amdgcn_s_sleep(1);
        if ((++sp & 255u) == 0u) { if (xb_ld(&bar[XB_TMO])) break; if (sp > XB_SPIN_CAP) { atomicAdd(&bar[XB_TMO], 1u); break; } }
    }
    nloc = mine > 0u ? mine : 1u; nx = cnt > 0u ? cnt : 1u;
}
__device__ __forceinline__ void xcd_barrier(const XcdBarrier& b) {
    asm volatile("s_waitcnt vmcnt(0)" ::: "memory");
    __syncthreads();
    if (threadIdx.x == 0) {
        unsigned* bar = b.bar;
        __builtin_amdgcn_s_waitcnt(0);
        unsigned nloc = b.st[0], nx = b.st[1];
        if (nloc == 0u) { xcd_barrier_complete(bar, b.x, nloc, nx); b.st[0] = nloc; b.st[1] = nx; }
        const unsigned old = xb_add(&bar[XB_XSUB(b.x)], 1u);
        const unsigned gen = old / nloc;
        if (old + 1u == (gen + 1u) * nloc) {
            __builtin_amdgcn_fence(__ATOMIC_RELEASE, "agent");
            asm volatile("s_waitcnt vmcnt(0)" ::: "memory");
            const unsigned og = xb_add(&bar[XB_TOP], 1u);
            const unsigned tg = og / nx;
            if (og + 1u == (tg + 1u) * nx) xb_add(&bar[XB_TOPGEN], 1u);
            else XB_SPIN(xb_ld(&bar[XB_TOPGEN]) == tg, bar);
            __builtin_amdgcn_fence(__ATOMIC_ACQUIRE, "agent");
            xb_add(&bar[XB_XGEN(b.x)], 1u);
            asm volatile("s_waitcnt vmcnt(0)" ::: "memory");
        } else {
            XB_SPIN(xb_ld(&bar[XB_XGEN(b.x)]) == gen, bar);
            __builtin_amdgcn_fence(__ATOMIC_ACQUIRE, "agent");
            asm volatile("s_waitcnt vmcnt(0)" ::: "memory");
        }
    }
    __syncthreads();
}

#define GB_BASE 16384
#define GB_CNT(g)  (GB_BASE + 64 * (g))
#define GB_GEN(g)  (GB_BASE + 1024 + 64 * (g))
#define GB_XTAB    (GB_BASE + 2048)
__device__ __forceinline__ void grp_barrier(unsigned* bar, int g, unsigned nmem) {
    asm volatile("s_waitcnt vmcnt(0)" ::: "memory");
    __syncthreads();
    if (threadIdx.x == 0) {
        __builtin_amdgcn_s_waitcnt(0);
        const unsigned old = xb_add(&bar[GB_CNT(g)], 1u);
        const unsigned gen = old / nmem;
        if (old + 1u == (gen + 1u) * nmem) (void)xb_add(&bar[GB_GEN(g)], 1u);
        else XB_SPIN(xb_ld(&bar[GB_GEN(g)]) == gen, bar);
        asm volatile("buffer_inv sc1\n\ts_waitcnt vmcnt(0)" ::: "memory");
    }
    __syncthreads();
}

constexpr size_t SLAB0 = 122 * MiB, SLABSZ = (492 * MiB - SLAB0) / 8;
__device__ __forceinline__ unsigned char* gp(unsigned char* ws, int gs, size_t off, size_t pitch) {
    return gs < 0 ? ws + off : ws + SLAB0 + (size_t)gs * SLABSZ + (off - SLAB0) / 8 - (size_t)gs * 4096 * pitch;
}

struct Args { const void* in[15]; float* out; unsigned char* ws; int ph_lo, ph_hi; };
struct Frame {
    LAS unsigned char* lds;
    int tid, lane, wave, G;
    unsigned char* ws;
    int gs;
};

__device__ __forceinline__ float wave_sum(float v) {
#pragma unroll
    for (int o = 1; o < 64; o <<= 1) v += __shfl_xor(v, o);
    return v;
}
typedef unsigned long long u64;
__device__ __forceinline__ void ssq_add(u64* p, float s) { atomicAdd(p, (u64)(s * 16777216.f + 0.5f)); }
__device__ __forceinline__ float ssq_get(const u64* p) { return (float)(*p) * (1.f / 16777216.f); }
__device__ __forceinline__ int vzero() { int z; asm volatile("v_mov_b32 %0, 0" : "=v"(z)); return z; }

template <int MAP> __device__ __forceinline__ int src_col(int n) {
    if constexpr (MAP == 0) return n;
    else if constexpr (MAP == 1) {
        if (n < 512) return 672 + n;
        if (n < 1024) return 1184 + (n - 512);
        if (n < 1536) return 1696 + (n - 1024);
        if (n < 2048) { const int c = n - 1536; return 2208 + (c & ~63) + ((c & 63) >> 1) + 32 * (c & 1); }
        if (n < 2560) { const int c = n - 2048; return 2720 + (c & ~63) + ((c & 63) >> 1) + 32 * (c & 1); }
        if (n < 3072) return 3232 + (n - 2560);
        if (n < 3584) return 3744 + (n - 3072);
        if (n < 6656) return 4256 + (n - 3584);
        if (n < 7040) return n - 6656;
        if (n < 7296) return 384 + (n - 7040);
        if (n < 7328) { const int j = n - 7296; return 640 + (j >> 1) + 16 * (j & 1); }
        return -1;
    } else {
        const int h = n / 96, hc = n % 96; if (hc < 64) return n; const int j = hc - 64; return h * 96 + 64 + (j >> 1) + 16 * (j & 1);
    }
}
template <int MAP> __device__ __forceinline__ void transpose_item(const float* W, int Nsrc, int Ndst, const float* gain, bf16* WT, int pitch, int koff, LAS float* scr, int item, int lane) {
    const int nblk = Ndst / 32, kb = item / nblk, nb = item % nblk, k0 = 64 * kb, n0 = 32 * nb;
    const int sc = src_col<MAP>(n0 + (lane & 31));
    float wv[32], gv[32];
#pragma unroll
    for (int i = 0; i < 32; ++i) { const int kk = 2 * i + (lane >> 5); wv[i] = (sc >= 0) ? W[(size_t)(k0 + kk) * Nsrc + sc] : 0.f; gv[i] = gain ? gain[k0 + kk] : 1.f; }
#pragma unroll
    for (int i = 0; i < 32; ++i) { const int kk = 2 * i + (lane >> 5); scr[kk * 33 + (lane & 31)] = wv[i] * gv[i]; }
    LDS_WAIT(); asm volatile("" ::: "memory");
    const int c = lane & 7;
#pragma unroll
    for (int j = 0; j < 4; ++j) { const int n = (lane >> 3) + 8 * j; const LAS float* s = scr + (8 * c) * 33 + n;
        v4u o; o.x = pk2(s[0 * 33], s[1 * 33]); o.y = pk2(s[2 * 33], s[3 * 33]); o.z = pk2(s[4 * 33], s[5 * 33]); o.w = pk2(s[6 * 33], s[7 * 33]);
        *(GAS v4u*)(WT + (size_t)(n0 + n) * pitch + koff + k0 + 8 * c) = o; }
    LDS_WAIT(); asm volatile("" ::: "memory");
}

#ifdef EPI_FENCED
#define EPI_FENCE asm volatile("" ::: "memory")
#else
#define EPI_FENCE
#endif
using pg8::Unit; using pg8::bf16_t; using pg8::u32x4; using pg8::cvt_pk_bf16;
typedef float accT[2][2][4][2] __attribute__((unused));
__device__ __forceinline__ u32x4 pack8(const float (&v)[8]) { u32x4 w; w.x = cvt_pk_bf16(v[0], v[1]); w.y = cvt_pk_bf16(v[2], v[3]); w.z = cvt_pk_bf16(v[4], v[5]); w.w = cvt_pk_bf16(v[6], v[7]); return w; }
__device__ __forceinline__ float sigmoidf_(float x) { return __builtin_amdgcn_rcpf(1.f + __expf(-x)); }

constexpr int ROWTAB_OFF = 132 * 1024;
__device__ __forceinline__ void rowtab_stage(const u64* ssq_rows, const Unit& u, PG8_LAS unsigned char* lds, int tid) {
    const int w = __builtin_amdgcn_readfirstlane(tid >> 6);
    __builtin_amdgcn_global_load_lds((const unsigned*)(ssq_rows + (size_t)u.pm * 256) + tid, (PG8_LAS unsigned*)(lds + ROWTAB_OFF + u.par * 2048 + w * 256), 4, 0, 0);
}
__device__ __forceinline__ float rowtab_get(PG8_LAS unsigned char* lds, const Unit& u, int rit) {
    const pg8::u32x2 w = *(const PG8_LAS pg8::u32x2*)(lds + ROWTAB_OFF + u.par * 2048 + rit * 8);
    return fmaf((float)w.y, 256.f, (float)w.x * (1.f / 16777216.f));
}
__device__ __forceinline__ float rowtab_rstd(PG8_LAS unsigned char* lds, const Unit& u, int rit, float invn) { return __builtin_amdgcn_rsqf(fmaf(rowtab_get(lds, u, rit), invn, EPS)); }
__device__ __forceinline__ pg8::f32x4 vmax0(pg8::f32x4 a) { return __builtin_elementwise_max(a, (pg8::f32x4){0.f, 0.f, 0.f, 0.f}); }
__device__ __forceinline__ pg8::f32x4 vminc(pg8::f32x4 a, float c) { return __builtin_elementwise_min(a, (pg8::f32x4){c, c, c, c}); }
__device__ __forceinline__ pg8::f32x4 vexp2(pg8::f32x4 a) { return (pg8::f32x4){__builtin_amdgcn_exp2f(a.x), __builtin_amdgcn_exp2f(a.y), __builtin_amdgcn_exp2f(a.z), __builtin_amdgcn_exp2f(a.w)}; }
__device__ __forceinline__ pg8::f32x4 vrcp(pg8::f32x4 a) { return (pg8::f32x4){__builtin_amdgcn_rcpf(a.x), __builtin_amdgcn_rcpf(a.y), __builtin_amdgcn_rcpf(a.z), __builtin_amdgcn_rcpf(a.w)}; }
__device__ __forceinline__ unsigned cvt_pk_bf16_cc(float lo, float hi) {
    typedef float f32x2_t __attribute__((ext_vector_type(2))); typedef __bf16 bf16x2_t __attribute__((ext_vector_type(2)));
    const f32x2_t f = {lo, hi}; return __builtin_bit_cast(unsigned, __builtin_convertvector(f, bf16x2_t));
}
__device__ __forceinline__ u32x4 pack8v(pg8::f32x4 a, pg8::f32x4 b) { u32x4 w; w.x = cvt_pk_bf16_cc(a.x, a.y); w.y = cvt_pk_bf16_cc(a.z, a.w); w.z = cvt_pk_bf16_cc(b.x, b.y); w.w = cvt_pk_bf16_cc(b.z, b.w); return w; }
__device__ __forceinline__ pg8::f32x4 vsigm_t(pg8::f32x4 t) { return vrcp(vexp2(vminc(t, 86.f)) + 1.f); }
__device__ __forceinline__ pg8::f32x4 vsigden_t(pg8::f32x4 t) { return vexp2(vminc(t, 86.f)) + 1.f; }
constexpr float NLOG2E = -1.4426950408889634f;

struct EpiIn {
    static constexpr bool PERM = true;
    const u64* ssq; int grow0;
    unsigned char* ws; PG8_LAS unsigned char* ldsb;
    const float *cosR, *sinR, *cosM, *sinM;
    u64 *ssqq, *ssqkv; int gs;
    __device__ __forceinline__ bool keep(const Unit&) const { return false; }
    __device__ __forceinline__ void prefetch(const Unit& u, PG8_LAS unsigned char* lds, int tid) const { rowtab_stage(ssq + grow0, u, lds, tid); }
    template <int MODE> __device__ __forceinline__ void run(pg8::f32x4 (&acc)[2][2][4][2], const Unit& u, int wr, int wc, int fr, int fq, bf16_t* dst, int pitch, int col0, float scale) const {
        const int lrow0 = u.pm * 256 + wr * 64 + fr, cw = wc * 32 + 8 * fq;
#pragma unroll
        for (int ai = 0; ai < 2; ++ai)
#pragma unroll
            for (int m = 0; m < 4; ++m) { EPI_FENCE;
                const int lrow = lrow0 + ai * 128 + m * 16, grow = grow0 + lrow;
                const float rs = rowtab_rstd(ldsb, u, lrow - u.pm * 256, 1.f / 1024.f) * (MODE <= 1 ? scale : 1.f);
#pragma unroll
                for (int bj = 0; bj < 2; ++bj) {
                    const int ct = bj * 128 + cw;
                    const pg8::f32x4 a0 = acc[ai][bj][m][0] * rs, a1 = acc[ai][bj][m][1] * rs;
                    bf16_t* p = dst + (size_t)lrow * pitch + col0 + ct;
                    if constexpr (MODE == 0) { *(u32x4*)p = pack8v(a0, a1); continue; }
                    if constexpr (MODE == 2) { *(u32x4*)p = pack8v(a0 * vrcp(vexp2(a0 * NLOG2E) + 1.f), a1 * vrcp(vexp2(a1 * NLOG2E) + 1.f)); continue; }
                    float v[8];
#pragma unroll
                    for (int j = 0; j < 4; ++j) { v[j] = a0[j]; v[4 + j] = a1[j]; }
                    if constexpr (MODE == 1) {
                        const int i0 = (ct & 63) >> 1;
                        const pg8::f32x4 c4 = *(const pg8::f32x4*)(cosR + (size_t)grow * 32 + i0), s4 = *(const pg8::f32x4*)(sinR + (size_t)grow * 32 + i0);
#pragma unroll
                        for (int j = 0; j < 4; ++j) { const float x1 = v[2 * j], x2 = v[2 * j + 1]; v[2 * j] = x1 * c4[j] - x2 * s4[j]; v[2 * j + 1] = x2 * c4[j] + x1 * s4[j]; }
                    } else if constexpr (MODE == 4) {
                        const int cb = col0 + bj * 128 + wc * 32;
                        if (cb < 640) {
                            float s = 0.f;
#pragma unroll
                            for (int j = 0; j < 8; ++j) s += v[j] * v[j];
                            s += __shfl_xor(s, 16); s += __shfl_xor(s, 32);
                            if (fq == 0) ssq_add((cb < 384 ? ssqq : ssqkv) + lrow, s);
                        } else if (cb < 672) {
                            const int i0 = 4 * fq;
                            const pg8::f32x4 c4 = *(const pg8::f32x4*)(cosM + (size_t)grow * 16 + i0), s4 = *(const pg8::f32x4*)(sinM + (size_t)grow * 16 + i0);
#pragma unroll
                            for (int j = 0; j < 4; ++j) { const float x1 = v[2 * j], x2 = v[2 * j + 1]; v[2 * j] = x1 * c4[j] - x2 * s4[j]; v[2 * j + 1] = x2 * c4[j] + x1 * s4[j]; }
                            p = (bf16_t*)gp(ws, gs, WS_KPE, 64) + (size_t)lrow * 32 + 8 * fq;
                        } else continue;
                    }
                    *(u32x4*)p = pack8(v);
                }
            }
    }
    __device__ __forceinline__ void run_rope(pg8::f32x4 (&acc)[2][2][4][2], const Unit& u, int wr, int wc, int fr, int fq, bf16_t* dst, int pitch, int col0, float scale) const {
        const int lrow0 = u.pm * 256 + wr * 64 + fr, cw = wc * 32 + 8 * fq, i0 = (cw & 63) >> 1;
#pragma unroll
        for (int ai = 0; ai < 2; ++ai) {
            pg8::f32x4 c4[4], s4[4];
#pragma unroll
            for (int m = 0; m < 4; ++m) { const size_t grow = (size_t)(grow0 + lrow0 + ai * 128 + m * 16); c4[m] = *(const pg8::f32x4*)(cosR + grow * 32 + i0); s4[m] = *(const pg8::f32x4*)(sinR + grow * 32 + i0); }
            asm volatile("" ::: "memory");
#pragma unroll
            for (int m = 0; m < 4; ++m) {
                const int lrow = lrow0 + ai * 128 + m * 16;
                const float rs = rowtab_rstd(ldsb, u, lrow - u.pm * 256, 1.f / 1024.f) * scale;
#pragma unroll
                for (int bj = 0; bj < 2; ++bj) {
                    const pg8::f32x4 a0 = acc[ai][bj][m][0] * rs, a1 = acc[ai][bj][m][1] * rs;
                    float v[8];
#pragma unroll
                    for (int j = 0; j < 4; ++j) { v[j] = a0[j]; v[4 + j] = a1[j]; }
#pragma unroll
                    for (int j = 0; j < 4; ++j) { const float x1 = v[2 * j], x2 = v[2 * j + 1]; v[2 * j] = x1 * c4[m][j] - x2 * s4[m][j]; v[2 * j + 1] = x2 * c4[m][j] + x1 * s4[m][j]; }
                    *(u32x4*)(dst + (size_t)lrow * pitch + col0 + bj * 128 + cw) = pack8(v);
                }
            }
            asm volatile("" ::: "memory");
        }
    }
    __device__ __forceinline__ void operator()(pg8::f32x4 (&acc)[2][2][4][2], const Unit& u, int wr, int wc, int fr_, int fq_) const {
        int fr = fr_, fq = fq_; asm volatile("" : "+v"(fr), "+v"(fq));
        const int pn = u.pn;
        if (pn >= 26) { run<4>(acc, u, wr, wc, fr, fq, (bf16_t*)gp(ws, gs, WS_C, 1536), NC, (pn - 26) * 256, 1.f); return; }
        const int seg = pn >> 1, c0 = (pn & 1) * 256;
        if (seg == 0) run<0>(acc, u, wr, wc, fr, fq, (bf16_t*)gp(ws, gs, WS_Y, 3072), 1536, c0 + 512, 0.125f * 1.4426950408889634f);
        else if (seg == 1) run<0>(acc, u, wr, wc, fr, fq, (bf16_t*)gp(ws, gs, WS_SBK, 1024), 512, c0, 1.f);
        else if (seg == 2) run<0>(acc, u, wr, wc, fr, fq, (bf16_t*)gp(ws, gs, WS_SBV, 1024), 512, c0, 1.f);
        else if (seg == 3) run_rope(acc, u, wr, wc, fr, fq, (bf16_t*)gp(ws, gs, WS_Y, 3072), 1536, c0 + 1024, 0.125f);
        else if (seg == 4) run_rope(acc, u, wr, wc, fr, fq, (bf16_t*)gp(ws, gs, WS_RK, 1024), 512, c0, 1.f);
        else if (seg == 5) run<0>(acc, u, wr, wc, fr, fq, (bf16_t*)gp(ws, gs, WS_RV, 1024), 512, c0, 1.f);
        else run<2>(acc, u, wr, wc, fr, fq, (bf16_t*)gp(ws, gs, WS_RG, 1024), 512, c0, 1.f);
    }
};

struct EpiUq {
    static constexpr bool PERM = true;
    const u64* ssqq; int grow0; bf16_t* QM; const float *cosM, *sinM; PG8_LAS unsigned char* ldsb;
    __device__ __forceinline__ bool keep(const Unit&) const { return false; }
    __device__ __forceinline__ void prefetch(const Unit& u, PG8_LAS unsigned char* lds, int tid) const { rowtab_stage(ssqq, u, lds, tid); }
    __device__ __forceinline__ void operator()(pg8::f32x4 (&acc)[2][2][4][2], const Unit& u, int wr, int wc, int fr_, int fq_) const {
        int fr = fr_, fq = fq_; asm volatile("" : "+v"(fr), "+v"(fq));
        const int lrow0 = u.pm * 256 + wr * 64 + fr, cw = wc * 32 + 8 * fq;
        int hcb[2];
#pragma unroll
        for (int bj = 0; bj < 2; ++bj) hcb[bj] = (u.pn * 256 + bj * 128 + cw) % 96;
#pragma unroll
        for (int ai = 0; ai < 2; ++ai) {
            pg8::f32x4 c4[4][2], s4[4][2];
#pragma unroll
            for (int m = 0; m < 4; ++m)
#pragma unroll
                for (int bj = 0; bj < 2; ++bj) { const size_t grow = (size_t)(grow0 + lrow0 + ai * 128 + m * 16); const int i0 = hcb[bj] >= 64 ? (hcb[bj] - 64) >> 1 : 0;
                    c4[m][bj] = *(const pg8::f32x4*)(cosM + grow * 16 + i0); s4[m][bj] = *(const pg8::f32x4*)(sinM + grow * 16 + i0); }
            asm volatile("" ::: "memory");
#pragma unroll
            for (int m = 0; m < 4; ++m) {
                const int lrow = lrow0 + ai * 128 + m * 16;
                const float rs = rowtab_rstd(ldsb, u, lrow - u.pm * 256, 1.f / 384.f) * QSCALE;
#pragma unroll
                for (int bj = 0; bj < 2; ++bj) {
                    const int c = u.pn * 256 + bj * 128 + cw;
                    const pg8::f32x4 a0 = acc[ai][bj][m][0] * rs, a1 = acc[ai][bj][m][1] * rs;
                    float v[8];
#pragma unroll
                    for (int j = 0; j < 4; ++j) { v[j] = a0[j]; v[4 + j] = a1[j]; }
                    if (hcb[bj] >= 64) {
#pragma unroll
                        for (int j = 0; j < 4; ++j) { const float x1 = v[2 * j], x2 = v[2 * j + 1]; v[2 * j] = x1 * c4[m][bj][j] - x2 * s4[m][bj][j]; v[2 * j + 1] = x2 * c4[m][bj][j] + x1 * s4[m][bj][j]; }
                    }
                    *(u32x4*)(QM + (size_t)lrow * NQ + c) = pack8(v);
                }
            }
            asm volatile("" ::: "memory");
        }
    }
};
struct EpiUkv {
    static constexpr bool PERM = true;
    const u64* ssqkv; bf16_t* KVM; PG8_LAS unsigned char* ldsb;
    __device__ __forceinline__ bool keep(const Unit&) const { return false; }
    __device__ __forceinline__ void prefetch(const Unit& u, PG8_LAS unsigned char* lds, int tid) const { rowtab_stage(ssqkv, u, lds, tid); }
    __device__ __forceinline__ void operator()(pg8::f32x4 (&acc)[2][2][4][2], const Unit& u, int wr, int wc, int fr_, int fq_) const {
        int fr = fr_, fq = fq_; asm volatile("" : "+v"(fr), "+v"(fq));
        const int lrow0 = u.pm * 256 + wr * 64 + fr, cw = wc * 32 + 8 * fq;
#pragma unroll
        for (int ai = 0; ai < 2; ++ai)
#pragma unroll
            for (int m = 0; m < 4; ++m) { EPI_FENCE;
                const int lrow = lrow0 + ai * 128 + m * 16;
                const float rs = rowtab_rstd(ldsb, u, lrow - u.pm * 256, 1.f / 256.f);
#pragma unroll
                for (int bj = 0; bj < 2; ++bj) {
                    *(u32x4*)(KVM + ((size_t)((lrow >> 12) * NHEAD + u.pn * 2 + bj) * SEQ + (lrow & (SEQ - 1))) * 128 + cw) = pack8v(acc[ai][bj][m][0] * rs, acc[ai][bj][m][1] * rs);
                }
            }
    }
};
struct EpiMerge {
    static constexpr bool PERM = true;
    const bf16_t* G; bf16_t* MG;
    __device__ __forceinline__ bool keep(const Unit& u) const { return u.ks < 2; }
    __device__ __forceinline__ void prefetch(const Unit&, PG8_LAS unsigned char*, int) const {}
    __device__ __forceinline__ void operator()(pg8::f32x4 (&acc)[2][2][4][2], const Unit& u, int wr, int wc, int fr_, int fq_) const {
        int fr = fr_, fq = fq_; asm volatile("" : "+v"(fr), "+v"(fq));
        const int lrow0 = u.pm * 256 + wr * 64 + fr, cw = wc * 32 + 8 * fq, ks = u.ks;
#pragma unroll
        for (int ai = 0; ai < 2; ++ai)
#pragma unroll
            for (int m = 0; m < 4; ++m) { EPI_FENCE;
                const int lrow = lrow0 + ai * 128 + m * 16;
#pragma unroll
                for (int bj = 0; bj < 2; ++bj) {
                    const int d = u.pn * 256 + bj * 128 + cw;
                    const bf16_t* gp = G + (size_t)lrow * 3072 + ks * 1024 + d;
                    const u32x4 ga = *(const u32x4*)gp;
                    float f[8];
#pragma unroll
                    for (int j = 0; j < 4; ++j) { f[2 * j] = bflo(ga[j]); f[2 * j + 1] = bfhi(ga[j]); }
                    if (ks < 2) {
                        const u32x4 gb = *(const u32x4*)(gp + 1024);
#pragma unroll
                        for (int j = 0; j < 4; ++j) { f[2 * j] *= __builtin_amdgcn_rcpf(bflo(gb[j])); f[2 * j + 1] *= __builtin_amdgcn_rcpf(bfhi(gb[j])); }
                    }
#pragma unroll
                    for (int j = 0; j < 4; ++j) { acc[ai][bj][m][0][j] *= f[j]; acc[ai][bj][m][1][j] *= f[4 + j]; }
                    if (ks == 2) {
                        float v[8];
#pragma unroll
                        for (int j = 0; j < 4; ++j) { v[j] = acc[ai][bj][m][0][j]; v[4 + j] = acc[ai][bj][m][1][j]; }
                        *(u32x4*)(MG + (size_t)lrow * DM + d) = pack8(v);
                    }
                }
            }
    }
};
struct EpiGate {
    static constexpr bool PERM = true;
    const u64* ssq; unsigned char* GS; PG8_LAS unsigned char* ldsb;
    __device__ __forceinline__ bool keep(const Unit&) const { return false; }
    __device__ __forceinline__ void prefetch(const Unit& u, PG8_LAS unsigned char* lds, int tid) const { rowtab_stage(ssq, u, lds, tid); }
    __device__ __forceinline__ void operator()(pg8::f32x4 (&acc)[2][2][4][2], const Unit& u, int wr, int wc, int fr_, int fq_) const {
        int fr = fr_, fq = fq_; asm volatile("" : "+v"(fr), "+v"(fq));
        unsigned char* gsw = GS + (size_t)u.ty * 131072 + (size_t)(wr * 4 + wc) * 16384;
        const unsigned lo = (unsigned)(fq * 16 + fr) * 16u;
#pragma unroll
        for (int ai = 0; ai < 2; ++ai)
#pragma unroll
            for (int m = 0; m < 4; ++m) { EPI_FENCE;
                const float rsn = rowtab_rstd(ldsb, u, wr * 64 + fr + ai * 128 + m * 16, 1.f / 1024.f) * NLOG2E;
#pragma unroll
                for (int bj = 0; bj < 2; ++bj) __builtin_nontemporal_store(pack8v(vsigden_t(acc[ai][bj][m][0] * rsn), vsigden_t(acc[ai][bj][m][1] * rsn)), (u32x4*)(gsw + ((ai * 4 + m) * 2 + bj) * 1024 + lo));
            }
    }
};
struct EpiMergeL {
    static constexpr bool PERM = true;
    const unsigned char* GS; bf16_t* MG;
    __device__ __forceinline__ bool keep(const Unit& u) const { return u.ks < 2; }
    __device__ __forceinline__ void prefetch(const Unit&, PG8_LAS unsigned char*, int) const {}
    __device__ __forceinline__ void operator()(pg8::f32x4 (&acc)[2][2][4][2], const Unit& u, int wr, int wc, int fr_, int fq_) const {
        int fr = fr_, fq = fq_; asm volatile("" : "+v"(fr), "+v"(fq));
        const int lrow0 = u.pm * 256 + wr * 64 + fr, cw = wc * 32 + 8 * fq, ks = u.ks;
        const unsigned char* gsw = GS + (size_t)(u.ty * 3 + ks) * 131072 + (size_t)(wr * 4 + wc) * 16384;
        const unsigned lo = (unsigned)(fq * 16 + fr) * 16u;
#pragma unroll
        for (int ai = 0; ai < 2; ++ai) {
            u32x4 ga[4][2], gb[4][2];
#pragma unroll
            for (int m = 0; m < 4; ++m)
#pragma unroll
                for (int bj = 0; bj < 2; ++bj) {
                    const unsigned char* gp = gsw + ((ai * 4 + m) * 2 + bj) * 1024;
                    ga[m][bj] = __builtin_nontemporal_load((const u32x4*)(gp + lo));
                    if (ks < 2) gb[m][bj] = __builtin_nontemporal_load((const u32x4*)(gp + 131072 + lo));
                }
            asm volatile("" ::: "memory");
#pragma unroll
            for (int m = 0; m < 4; ++m) {
                const int lrow = lrow0 + ai * 128 + m * 16;
#pragma unroll
                for (int bj = 0; bj < 2; ++bj) {
                    float f[8];
#pragma unroll
                    for (int j = 0; j < 4; ++j) { f[2 * j] = __builtin_amdgcn_rcpf(bflo(ga[m][bj][j])); f[2 * j + 1] = __builtin_amdgcn_rcpf(bfhi(ga[m][bj][j])); }
                    if (ks < 2) {
#pragma unroll
                        for (int j = 0; j < 4; ++j) { f[2 * j] *= bflo(gb[m][bj][j]); f[2 * j + 1] *= bfhi(gb[m][bj][j]); }
                    }
#pragma unroll
                    for (int j = 0; j < 4; ++j) { acc[ai][bj][m][0][j] *= f[j]; acc[ai][bj][m][1][j] *= f[4 + j]; }
                    if (ks == 2) {
                        float v[8];
#pragma unroll
                        for (int j = 0; j < 4; ++j) { v[j] = acc[ai][bj][m][0][j]; v[4 + j] = acc[ai][bj][m][1][j]; }
                        *(u32x4*)(MG + (size_t)lrow * DM + u.pn * 256 + bj * 128 + cw) = pack8(v);
                    }
                }
            }
            asm volatile("" ::: "memory");
        }
    }
};
struct EpiResid {
    static constexpr bool PERM = true;
    bf16_t* XB; u64* ssq_next; int grow0;
    __device__ __forceinline__ bool keep(const Unit&) const { return false; }
    __device__ __forceinline__ void prefetch(const Unit&, PG8_LAS unsigned char*, int) const {}
    __device__ __forceinline__ void operator()(pg8::f32x4 (&acc)[2][2][4][2], const Unit& u, int wr, int wc, int fr_, int fq_) const {
        int fr = fr_, fq = fq_; asm volatile("" : "+v"(fr), "+v"(fq));
        const int lrow0 = u.pm * 256 + wr * 64 + fr, cw = wc * 32 + 8 * fq;
#pragma unroll
        for (int ai = 0; ai < 2; ++ai) {
            u32x4 xh[4][2];
#pragma unroll
            for (int m = 0; m < 4; ++m)
#pragma unroll
                for (int bj = 0; bj < 2; ++bj) xh[m][bj] = *(const u32x4*)(XB + (size_t)(grow0 + lrow0 + ai * 128 + m * 16) * DM + u.pn * 256 + bj * 128 + cw);
            asm volatile("" ::: "memory");
#pragma unroll
            for (int m = 0; m < 4; ++m) {
                const int grow = grow0 + lrow0 + ai * 128 + m * 16;
                float sq = 0.f;
#pragma unroll
                for (int bj = 0; bj < 2; ++bj) {
                    const int col = u.pn * 256 + bj * 128 + cw;
                    float v[8];
#pragma unroll
                    for (int j = 0; j < 4; ++j) { v[2 * j] = bflo(xh[m][bj][j]) + acc[ai][bj][m][j >> 1][(2 * j) & 3]; v[2 * j + 1] = bfhi(xh[m][bj][j]) + acc[ai][bj][m][j >> 1][(2 * j + 1) & 3]; }
#pragma unroll
                    for (int j = 0; j < 8; ++j) sq += v[j] * v[j];
                    *(u32x4*)(XB + (size_t)grow * DM + col) = pack8(v);
                }
                sq += __shfl_xor(sq, 16); sq += __shfl_xor(sq, 32);
                if (fq == 0) ssq_add(ssq_next + grow, sq);
            }
            asm volatile("" ::: "memory");
        }
    }
};
struct EpiUp {
    static constexpr bool PERM = true;
    const u64* ssq; int grow0; bf16_t* H; int var; PG8_LAS unsigned char* ldsb;
    __device__ __forceinline__ bool keep(const Unit&) const { return false; }
    __device__ __forceinline__ void prefetch(const Unit& u, PG8_LAS unsigned char* lds, int tid) const { rowtab_stage(ssq + grow0, u, lds, tid); }
    __device__ __forceinline__ void operator()(pg8::f32x4 (&acc)[2][2][4][2], const Unit& u, int wr, int wc, int fr_, int fq_) const {
        int fr = fr_, fq = fq_; asm volatile("" : "+v"(fr), "+v"(fq));
        if (var & 2) {
#pragma unroll
            for (int ai = 0; ai < 2; ++ai)
#pragma unroll
                for (int bj = 0; bj < 2; ++bj)
#pragma unroll
                    for (int m = 0; m < 4; ++m) { asm volatile("" :: "v"(acc[ai][bj][m][0]), "v"(acc[ai][bj][m][1])); }
            return;
        }
        const int lrow0 = u.pm * 256 + wr * 64 + fr, cw = wc * 32 + 8 * fq;
#pragma unroll
        for (int ai = 0; ai < 2; ++ai)
#pragma unroll
            for (int m = 0; m < 4; ++m) { EPI_FENCE;
                const int lrow = lrow0 + ai * 128 + m * 16;
                const float rs = rowtab_rstd(ldsb, u, lrow - u.pm * 256, 1.f / 1024.f);
#pragma unroll
                for (int bj = 0; bj < 2; ++bj) {
                    pg8::f32x4 a0 = acc[ai][bj][m][0] * rs, a1 = acc[ai][bj][m][1] * rs;
                    a0 = a0 * vmax0(a0); a1 = a1 * vmax0(a1);
                    const u32x4 w = pack8v(a0, a1);
                    if (var & 1) { asm volatile("" :: "v"(w)); } else *(u32x4*)(H + (size_t)lrow * DFF + u.pn * 256 + bj * 128 + cw) = w;
                }
            }
    }
};

namespace att {
typedef short bf16x8 __attribute__((ext_vector_type(8)));
typedef short s16x4 __attribute__((ext_vector_type(4)));
typedef float f32x16 __attribute__((ext_vector_type(16)));
typedef unsigned u32x4 __attribute__((ext_vector_type(4)));
constexpr int KP96 = 208, KP64 = 144, VP = 192;
constexpr int TK = 128;
constexpr int KBUF = TK * KP96, VBUF = TK * VP;
constexpr int OFF_K0 = 0, OFF_K1 = KBUF, OFF_V0 = 2 * KBUF, OFF_V1 = 2 * KBUF + VBUF, OFF_FLAG = 2 * KBUF + 2 * VBUF, ATT_LDS = OFF_FLAG + 64;
static_assert(ATT_LDS <= RING_BYTES, "attention LDS");
__device__ __forceinline__ int crow(int r, int h) { return (r & 3) + 8 * (r >> 2) + 4 * h; }
__device__ __forceinline__ s16x4 tr16(const LAS unsigned char* p) { typedef short v4i16_t __attribute__((ext_vector_type(4))); return __builtin_bit_cast(s16x4, __builtin_amdgcn_ds_read_tr16_b64_v4i16((LAS v4i16_t*)p)); }
__device__ __forceinline__ unsigned cvt_pk_bf16_c(float lo, float hi) {
    typedef float f32x2_t __attribute__((ext_vector_type(2))); typedef __bf16 bf16x2_t __attribute__((ext_vector_type(2)));
    const f32x2_t f = {lo, hi}; return __builtin_bit_cast(unsigned, __builtin_convertvector(f, bf16x2_t));
}
__device__ __forceinline__ bf16x8 pack8c(const f32x16& p, int s) {
    u32x4 w; w.x = cvt_pk_bf16_c(p[8 * s + 0], p[8 * s + 1]); w.y = cvt_pk_bf16_c(p[8 * s + 2], p[8 * s + 3]); w.z = cvt_pk_bf16_c(p[8 * s + 4], p[8 * s + 5]); w.w = cvt_pk_bf16_c(p[8 * s + 6], p[8 * s + 7]);
    return __builtin_bit_cast(bf16x8, w);
}
__device__ __forceinline__ bf16x8 pack8s(const f32x16& p, int s) {
    u32x4 w; w.x = pg8::cvt_pk_bf16(p[8 * s + 0], p[8 * s + 1]); w.y = pg8::cvt_pk_bf16(p[8 * s + 2], p[8 * s + 3]); w.z = pg8::cvt_pk_bf16(p[8 * s + 4], p[8 * s + 5]); w.w = pg8::cvt_pk_bf16(p[8 * s + 6], p[8 * s + 7]);
    return __builtin_bit_cast(bf16x8, w);
}
template <int NKS> __device__ __forceinline__ f32x16 qk_block(const LAS unsigned char* krows, int pitch, const bf16x8 (&qf)[NKS], int r32, int hh) {
    f32x16 p;
#pragma unroll
    for (int i = 0; i < 16; ++i) p[i] = 0.f;
    const LAS unsigned char* kp = krows + r32 * pitch + hh * 16;
#pragma unroll
    for (int ks = 0; ks < NKS; ++ks) { const bf16x8 kf = *(const LAS bf16x8*)(kp + ks * 32); p = __builtin_amdgcn_mfma_f32_32x32x16_bf16(kf, qf[ks], p, 0, 0, 0); }
    return p;
}
template <int NKS> __device__ __forceinline__ void qk_block2(att::f32x16& pA, att::f32x16& pB, const LAS unsigned char* krows, int pitch, const att::bf16x8 (&qf)[NKS], int r32, int hh, float init = 0.f) {
    using namespace att;
    const LAS unsigned char* kp = krows + r32 * pitch + hh * 16;
    bf16x8 ka[NKS], kb[NKS];
#pragma unroll
    for (int ks = 0; ks < NKS; ++ks) ka[ks] = *(const LAS bf16x8*)(kp + ks * 32);
#pragma unroll
    for (int ks = 0; ks < NKS; ++ks) kb[ks] = *(const LAS bf16x8*)(kp + 32 * pitch + ks * 32);
#pragma unroll
    for (int i = 0; i < 16; ++i) { pA[i] = init; pB[i] = init; }
#pragma unroll
    for (int ks = 0; ks < NKS; ++ks) pA = __builtin_amdgcn_mfma_f32_32x32x16_bf16(ka[ks], qf[ks], pA, 0, 0, 0);
#pragma unroll
    for (int ks = 0; ks < NKS; ++ks) pB = __builtin_amdgcn_mfma_f32_32x32x16_bf16(kb[ks], qf[ks], pB, 0, 0, 0);
}
__device__ __forceinline__ void pv_block(f32x16 (&o)[2], const LAS unsigned char* vrows, bf16x8 pb0, bf16x8 pb1, int lane) {
    const int hh = lane >> 5, g1 = (lane >> 4) & 1, q4 = (lane >> 2) & 3, p = lane & 3;
    const LAS unsigned char* base = vrows + (4 * hh + q4) * VP + (16 * g1 + 4 * p) * 2;
#pragma unroll
    for (int db = 0; db < 2; ++db)
#pragma unroll
        for (int s = 0; s < 2; ++s) {
            const s16x4 lo = tr16(base + (16 * s) * VP + db * 64), hi = tr16(base + (16 * s + 8) * VP + db * 64);
            const bf16x8 vf = {lo[0], lo[1], lo[2], lo[3], hi[0], hi[1], hi[2], hi[3]};
            o[db] = __builtin_amdgcn_mfma_f32_32x32x16_bf16(vf, s == 0 ? pb0 : pb1, o[db], 0, 0, 0);
        }
}
__device__ __forceinline__ void store_ot(bf16* dst, const f32x16 (&o)[2], float sc, int hh) {
#pragma unroll
    for (int db = 0; db < 2; ++db)
#pragma unroll
        for (int g = 0; g < 4; ++g) {
            pg8::u32x2 w; w.x = pg8::cvt_pk_bf16(o[db][4 * g] * sc, o[db][4 * g + 1] * sc); w.y = pg8::cvt_pk_bf16(o[db][4 * g + 2] * sc, o[db][4 * g + 3] * sc);
            *(GAS pg8::u32x2*)(dst + db * 32 + 8 * g + 4 * hh) = w;
        }
}
}

template <bool MASKED> __device__ __forceinline__ void mla_sm_pv(att::f32x16& P0, att::f32x16& P1, att::f32x16 (&o)[2], float& m, float& l, const LAS unsigned char* Vb, int base, int qg, int lane, int hh) {
    using namespace att;
    if constexpr (MASKED) {
#pragma unroll
        for (int r = 0; r < 16; ++r) { const int key = base + crow(r, hh); if (key > qg) P0[r] = -INFINITY; if (key + 32 > qg) P1[r] = -INFINITY; }
    }
    float mx = fmaxf(P0[0], P1[0]);
#pragma unroll
    for (int r = 1; r < 16; ++r) mx = fmaxf(mx, fmaxf(P0[r], P1[r]));
    mx = fmaxf(mx, __shfl_xor(mx, 32));
    const float mn = fmaxf(m, mx), al = __builtin_amdgcn_exp2f(m - mn);
    m = mn;
    float sum = 0.f;
#pragma unroll
    for (int r = 0; r < 16; ++r) { P0[r] = __builtin_amdgcn_exp2f(P0[r] - mn); P1[r] = __builtin_amdgcn_exp2f(P1[r] - mn); sum += P0[r] + P1[r]; }
    sum += __shfl_xor(sum, 32);
    l = l * al + sum;
#pragma unroll
    for (int r = 0; r < 16; ++r) { o[0][r] *= al; o[1][r] *= al; }
    pv_block(o, Vb, pack8s(P0, 0), pack8s(P0, 1), lane);
    pv_block(o, Vb + 32 * VP, pack8s(P1, 0), pack8s(P1, 1), lane);
}
__device__ __forceinline__ float max3f(float a, float b, float c) { return fmaxf(fmaxf(a, b), c); }
__device__ __forceinline__ void mla_sm_pv_ref(att::f32x16& A0, att::f32x16& A1, att::f32x16& B0, att::f32x16& B1, att::f32x16 (&o)[2], float& m, float& l, const LAS unsigned char* Vb, int lane, bool first) {
    using namespace att;
    float mx = max3f(A0[0], A1[0], B0[0]); mx = fmaxf(mx, B1[0]);
#pragma unroll
    for (int r = 1; r < 16; ++r) { mx = max3f(mx, A0[r], A1[r]); mx = max3f(mx, B0[r], B1[r]); }
    mx = fmaxf(mx, __shfl_xor(mx, 32));
    if (first || __builtin_amdgcn_ballot_w64(mx > 8.f) != 0ull) {
        const float d = (first || mx > 8.f) ? mx : 0.f, al = first ? 1.f : __builtin_amdgcn_exp2f(-d);
        m = first ? d : m + d; l *= al;
#pragma unroll
        for (int r = 0; r < 16; ++r) { o[0][r] *= al; o[1][r] *= al; A0[r] -= d; A1[r] -= d; B0[r] -= d; B1[r] -= d; }
    }
    float s0 = 0.f, s1 = 0.f;
#pragma unroll
    for (int r = 0; r < 16; ++r) { A0[r] = __builtin_amdgcn_exp2f(A0[r]); s0 += A0[r]; }
    pv_block(o, Vb, pack8c(A0, 0), pack8c(A0, 1), lane);
#pragma unroll
    for (int r = 0; r < 16; ++r) { A1[r] = __builtin_amdgcn_exp2f(A1[r]); s1 += A1[r]; }
    pv_block(o, Vb + 32 * VP, pack8c(A1, 0), pack8c(A1, 1), lane);
#pragma unroll
    for (int r = 0; r < 16; ++r) { B0[r] = __builtin_amdgcn_exp2f(B0[r]); s0 += B0[r]; }
    pv_block(o, Vb + 64 * VP, pack8c(B0, 0), pack8c(B0, 1), lane);
#pragma unroll
    for (int r = 0; r < 16; ++r) { B1[r] = __builtin_amdgcn_exp2f(B1[r]); s1 += B1[r]; }
    pv_block(o, Vb + 96 * VP, pack8c(B1, 0), pack8c(B1, 1), lane);
    s0 += s1; s0 += __shfl_xor(s0, 32);
    l += s0;
}
template <int VAR> __device__ __forceinline__ void mla_unit(Frame& F, int bh, int qb) {
    using namespace att;
    const bf16* QM = (const bf16*)gp(F.ws, F.gs, WS_QM, 1536); const bf16* KVM = (const bf16*)gp(F.ws, F.gs, WS_KVM, 2048); const bf16* C = (const bf16*)gp(F.ws, F.gs, WS_C, 1536); bf16* Y = (bf16*)gp(F.ws, F.gs, WS_Y, 3072);
    const int b = bh >> 3, h = bh & 7, q0 = qb * 256, w = F.wave, lane = F.lane, r32 = lane & 31, hh = lane >> 5, tid = F.tid;
    const int qmin = q0 + 32 * w, qg = qmin + r32;
    const size_t rowb = (size_t)b * SEQ;
    bf16x8 qf[6];
#pragma unroll
    for (int ks = 0; ks < 6; ++ks) qf[ks] = *(const GAS bf16x8*)(QM + (rowb + qg) * NQ + h * 96 + ks * 16 + hh * 8);
    float m = -INFINITY, l = 0.f; f32x16 o[2];
#pragma unroll
    for (int i = 0; i < 16; ++i) { o[0][i] = 0.f; o[1][i] = 0.f; }
    const int NT = 2 * qb + 2;
    const int kr0 = tid >> 3, kc0 = tid & 7, rr = tid >> 2, rc = tid & 3;
    const bf16* gkn = KVM + ((size_t)bh * SEQ + kr0) * 128 + kc0 * 8;
    const bf16* gkr = (const bf16*)gp(F.ws, F.gs, WS_KPE, 64) + (rowb + rr) * 32 + rc * 8;
    const int lk0 = kr0 * KP96 + kc0 * 16, lkr = rr * KP96 + 128 + rc * 16, lv0 = kr0 * VP + kc0 * 16;
    v4u R0, R1, R2, R3, R4;
#define MLA_LOAD(j) do { const size_t o_ = (size_t)(j) * TK; R0 = *(const GAS v4u*)(gkn + o_ * 128); R1 = *(const GAS v4u*)(gkn + (o_ + 64) * 128); R2 = *(const GAS v4u*)(gkr + o_ * 32); \
        R3 = *(const GAS v4u*)(gkn + o_ * 128 + 64); R4 = *(const GAS v4u*)(gkn + (o_ + 64) * 128 + 64); } while (0)
#define MLA_STORE(kb, vb) do { *(LAS v4u*)(F.lds + (kb) + lk0) = R0; *(LAS v4u*)(F.lds + (kb) + lk0 + 64 * KP96) = R1; *(LAS v4u*)(F.lds + (kb) + lkr) = R2; \
        *(LAS v4u*)(F.lds + (vb) + lv0) = R3; *(LAS v4u*)(F.lds + (vb) + lv0 + 64 * VP) = R4; } while (0)
    MLA_LOAD(0); MLA_STORE(OFF_K0, OFF_V0);
    __syncthreads();
    int j = 0;
    for (; j < NT - 2; ++j) {
        const int kb = (j & 1) ? OFF_K1 : OFF_K0, vb = (j & 1) ? OFF_V1 : OFF_V0;
        MLA_LOAD(j + 1);
        const LAS unsigned char* Kb = F.lds + kb; const LAS unsigned char* Vb = F.lds + vb;
        f32x16 pa0, pa1, pb0, pb1;
        const float ini = (j == 0) ? 0.f : -m;
        qk_block2<6>(pa0, pa1, Kb, KP96, qf, r32, hh, ini);
        qk_block2<6>(pb0, pb1, Kb + 64 * KP96, KP96, qf, r32, hh, ini);
        mla_sm_pv_ref(pa0, pa1, pb0, pb1, o, m, l, Vb, lane, j == 0);
        if (j & 1) MLA_STORE(OFF_K0, OFF_V0); else MLA_STORE(OFF_K1, OFF_V1);
        __syncthreads();
    }
    for (; j < NT; ++j) {
        const int kb = (j & 1) ? OFF_K1 : OFF_K0, vb = (j & 1) ? OFF_V1 : OFF_V0;
        if (j + 1 < NT) MLA_LOAD(j + 1);
#pragma unroll
        for (int sub = 0; sub < 2; ++sub) {
            const int base = j * TK + sub * 64;
            if (base <= qmin + 31) {
                const LAS unsigned char* Kb = F.lds + kb + sub * 64 * KP96; const LAS unsigned char* Vb = F.lds + vb + sub * 64 * VP;
                f32x16 p0 = qk_block<6>(Kb, KP96, qf, r32, hh), p1 = qk_block<6>(Kb + 32 * KP96, KP96, qf, r32, hh);
                mla_sm_pv<true>(p0, p1, o, m, l, Vb, base, qg, lane, hh);
            }
        }
        if (j + 1 < NT) { if (j & 1) MLA_STORE(OFF_K0, OFF_V0); else MLA_STORE(OFF_K1, OFF_V1); }
        __syncthreads();
    }
#undef MLA_LOAD
#undef MLA_STORE
    if constexpr (VAR == 0) store_ot(Y + (rowb + qg) * 1536 + h * 64, o, 1.f / l, hh);
    else store_ot((bf16*)gp(F.ws, F.gs, WS_MG, 2048) + (rowb + qg) * 512 + h * 64, o, 1.f / (l + 1.f), hh);
}
template <int VAR> __device__ __forceinline__ void mla_phase(Frame& F) {
    if (F.G == 256) { const int g = (int)blockIdx.x & 7, i = (int)blockIdx.x >> 3;
        for (int p = i; p < 64; p += 32) { const int bh = 8 * g + (p >> 3), s = p & 7; mla_unit<VAR>(F, bh, 15 - s); mla_unit<VAR>(F, bh, s); }
        return; }
    for (int u = (int)blockIdx.x; u < BH * NHEAD * 8; u += F.G) {
        const int bh = u >> 3, s = u & 7;
        mla_unit<VAR>(F, bh, 15 - s);
        mla_unit<VAR>(F, bh, s);
    }
}

template <bool MASKED> __device__ __forceinline__ void sb_block(att::f32x16& z, float& run, int kbase, int t, int hh) {
    using namespace att;
    float om[16];
#pragma unroll
    for (int r = 0; r < 16; ++r) {
        const float e = __builtin_amdgcn_exp2f(-fmaxf(z[r], -120.f));
        float beta = __builtin_amdgcn_rcpf(1.f + e), omb = e * beta;
        if constexpr (MASKED) { const bool valid = kbase + crow(r, hh) < t; beta = valid ? beta : 0.f; omb = valid ? omb : 1.f; }
        z[r] = beta; om[r] = omb;
    }
    float Gs[4], Go[4];
#pragma unroll
    for (int g = 0; g < 4; ++g) { Gs[g] = (om[4 * g] * om[4 * g + 1]) * (om[4 * g + 2] * om[4 * g + 3]); Go[g] = __shfl_xor(Gs[g], 32); }
    float T = 1.f;
#pragma unroll
    for (int g = 3; g >= 0; --g) {
        float P = run * T * (hh == 0 ? Go[g] : 1.f);
#pragma unroll
        for (int i = 3; i >= 0; --i) { const int r = 4 * g + i; z[r] *= P; P *= om[r]; }
        T *= Gs[g] * Go[g];
    }
    run *= T;
}
template <int VAR> __device__ __forceinline__ void sb_unit(Frame& F, int bh, int qb, bf16* OUT, int opitch, int ocol) {
    using namespace att;
    const bf16* Y = (const bf16*)gp(F.ws, F.gs, WS_Y, 3072); const bf16* SK = (const bf16*)gp(F.ws, F.gs, WS_SBK, 1024); const bf16* SV = (const bf16*)gp(F.ws, F.gs, WS_SBV, 1024);
    const int b = bh >> 3, h = bh & 7, q0 = qb * 256, w = F.wave, lane = F.lane, r32 = lane & 31, hh = lane >> 5, tid = F.tid;
    const int qmin = q0 + 32 * w, qg = qmin + r32;
    const size_t rowb = (size_t)b * SEQ;
    bf16x8 qf[4];
#pragma unroll
    for (int ks = 0; ks < 4; ++ks) qf[ks] = *(const GAS bf16x8*)(Y + (rowb + qg) * 1536 + 512 + h * 64 + ks * 16 + hh * 8);
    float run = 1.f; f32x16 o[2];
#pragma unroll
    for (int i = 0; i < 16; ++i) { o[0][i] = 0.f; o[1][i] = 0.f; }
    constexpr int SBT = TK * KP64 + TK * VP, SB_FLAG = 3 * SBT;
    static_assert(SB_FLAG + 64 <= RING_BYTES, "stick-breaking LDS");
    volatile LAS unsigned* fl = (volatile LAS unsigned*)(F.lds + SB_FLAG);
    if (tid < 3) fl[tid] = 0u;
    const int kr0 = tid >> 3, kc0 = tid & 7;
    const bf16* gk = SK + (rowb + kr0) * 512 + h * 64 + kc0 * 8; const bf16* gv = SV + (rowb + kr0) * 512 + h * 64 + kc0 * 8;
    const int lk0 = kr0 * KP64 + kc0 * 16, lv0 = TK * KP64 + kr0 * VP + kc0 * 16;
    v4u RA0, RA1, RA2, RA3, RB0, RB1, RB2, RB3;
#define SB_LOADA(j) do { const size_t o_ = (size_t)(j) * TK * 512; RA0 = *(const GAS v4u*)(gk + o_); RA1 = *(const GAS v4u*)(gk + o_ + 64 * 512); RA2 = *(const GAS v4u*)(gv + o_); RA3 = *(const GAS v4u*)(gv + o_ + 64 * 512); } while (0)
#define SB_LOADB(j) do { const size_t o_ = (size_t)(j) * TK * 512; RB0 = *(const GAS v4u*)(gk + o_); RB1 = *(const GAS v4u*)(gk + o_ + 64 * 512); RB2 = *(const GAS v4u*)(gv + o_); RB3 = *(const GAS v4u*)(gv + o_ + 64 * 512); } while (0)
#define SB_STOREA(tb) do { *(LAS v4u*)(F.lds + (tb) + lk0) = RA0; *(LAS v4u*)(F.lds + (tb) + lk0 + 64 * KP64) = RA1; *(LAS v4u*)(F.lds + (tb) + lv0) = RA2; *(LAS v4u*)(F.lds + (tb) + lv0 + 64 * VP) = RA3; } while (0)
#define SB_STOREB(tb) do { *(LAS v4u*)(F.lds + (tb) + lk0) = RB0; *(LAS v4u*)(F.lds + (tb) + lk0 + 64 * KP64) = RB1; *(LAS v4u*)(F.lds + (tb) + lv0) = RB2; *(LAS v4u*)(F.lds + (tb) + lv0 + 64 * VP) = RB3; } while (0)
    const int jtop = 2 * qb + 1;
    const int up = w >> 2;
    SB_LOADA(jtop); SB_LOADB(jtop - 1); SB_STOREA(0); SB_STOREB(SBT);
    if (jtop >= 2) SB_LOADA(jtop - 2);
    __syncthreads();
    for (int it = 0; ; ++it) {
        const int jt = jtop - it, mj = jt - 1 + up;
        const int tb = ((it + 1 - up) % 3) * SBT;
        if (jt >= 3) { if (it & 1) SB_LOADA(jt - 3); else SB_LOADB(jt - 3); }
        if (tid == 0) fl[(it + 1) % 3] = 0u;
        if (mj >= 0 && __ballot(run > 0.f) != 0ull) {
            if (it >= 1) {
#pragma unroll
                for (int sub = 1; sub >= 0; --sub) {
                    if (sub == 0 && __ballot(run > 0.f) == 0ull) break;
                    const LAS unsigned char* Kb = F.lds + tb + sub * 64 * KP64; const LAS unsigned char* Vb = F.lds + tb + TK * KP64 + sub * 64 * VP;
                    f32x16 p0 = qk_block<4>(Kb, KP64, qf, r32, hh), p1 = qk_block<4>(Kb + 32 * KP64, KP64, qf, r32, hh);
                    if constexpr (VAR != 1) { sb_block<false>(p1, run, 0, 0, hh);
                    sb_block<false>(p0, run, 0, 0, hh); } else run *= 1e-12f;
                    if constexpr (VAR != 2) { pv_block(o, Vb, pack8s(p0, 0), pack8s(p0, 1), lane);
                    pv_block(o, Vb + 32 * VP, pack8s(p1, 0), pack8s(p1, 1), lane); } else o[0][0] += p0[0] + p1[1];
                }
            } else {
#pragma unroll
                for (int sub = 1; sub >= 0; --sub) {
                    const int base = mj * TK + sub * 64;
                    if (base < qmin + 31) {
                        const LAS unsigned char* Kb = F.lds + tb + sub * 64 * KP64; const LAS unsigned char* Vb = F.lds + tb + TK * KP64 + sub * 64 * VP;
                        f32x16 p0 = qk_block<4>(Kb, KP64, qf, r32, hh), p1 = qk_block<4>(Kb + 32 * KP64, KP64, qf, r32, hh);
                        if constexpr (VAR != 1) { sb_block<true>(p1, run, base + 32, qg, hh);
                        sb_block<true>(p0, run, base, qg, hh); } else run *= (base + 63 < qg ? 1e-12f : 1.f);
                        if constexpr (VAR != 2) { pv_block(o, Vb, pack8s(p0, 0), pack8s(p0, 1), lane);
                        pv_block(o, Vb + 32 * VP, pack8s(p1, 0), pack8s(p1, 1), lane); } else o[0][0] += p0[0] + p1[1];
                    }
                }
            }
        }
        if (mj >= 1 && __ballot(run > 0.f) != 0ull && lane == 0) fl[it % 3] = 1u;
        if (jt >= 2) { if (it & 1) SB_STOREB(((it + 2) % 3) * SBT); else SB_STOREA(((it + 2) % 3) * SBT); }
        __syncthreads();
        if (fl[it % 3] == 0u) break;
        if constexpr (VAR == 5) { if (it >= 3) break; }
        if constexpr (VAR == 6) { break; }
    }
#undef SB_LOADA
#undef SB_LOADB
#undef SB_STOREA
#undef SB_STOREB
    __syncthreads();
    store_ot(OUT + (rowb + qg) * opitch + ocol + h * 64, o, 1.f, hh);
}
template <int VAR> __device__ __forceinline__ void sb_phase(Frame& F, bf16* OUT, int opitch, int ocol) {
    if (F.G == 256) { const int g = (int)blockIdx.x & 7, i = (int)blockIdx.x >> 3;
        for (int p = i; p < 64; p += 32) { const int bh = 8 * g + (p >> 3), s = p & 7; sb_unit<VAR>(F, bh, 15 - s, OUT, opitch, ocol); sb_unit<VAR>(F, bh, s, OUT, opitch, ocol); }
        return; }
    for (int u = (int)blockIdx.x; u < BH * NHEAD * 8; u += F.G) { const int bh = u >> 3, s = u & 7; sb_unit<VAR>(F, bh, 15 - s, OUT, opitch, ocol); sb_unit<VAR>(F, bh, s, OUT, opitch, ocol); }
}

__device__ __forceinline__ float log2_gamma(int h) {
    return h == 0 ? -4.5803689613e-02f : h == 1 ? -2.2720076500e-02f : h == 2 ? -1.1315313228e-02f : h == 3 ? -5.6465631411e-03f : h == 4 ? -2.8205190624e-03f : h == 5 ? -1.4095702547e-03f : h == 6 ? -7.0461297659e-04f : -3.5226347163e-04f;
}
constexpr size_t WS_KVS = WS_RST;
__device__ __forceinline__ void ret_stage(Frame& F, const bf16* RK, const bf16* RV, size_t row0, int h, float lg2, int kp, int voff) {
    using namespace att;
    const int tid = F.tid, r0 = tid >> 3, ch = tid & 7;
    v4u Rk[4], Rv[4];
#pragma unroll
    for (int i = 0; i < 4; ++i) { const size_t go = (row0 + r0 + 64 * i) * 512 + h * 64 + ch * 8; Rk[i] = *(const GAS v4u*)(RK + go); Rv[i] = *(const GAS v4u*)(RV + go); }
#pragma unroll
    for (int i = 0; i < 4; ++i) { const int row = r0 + 64 * i; const float z = __builtin_amdgcn_exp2f((float)(127 - (row & 127)) * lg2);
        v4u k; k.x = pg8::cvt_pk_bf16(bflo(Rk[i].x) * z, bfhi(Rk[i].x) * z); k.y = pg8::cvt_pk_bf16(bflo(Rk[i].y) * z, bfhi(Rk[i].y) * z);
        k.z = pg8::cvt_pk_bf16(bflo(Rk[i].z) * z, bfhi(Rk[i].z) * z); k.w = pg8::cvt_pk_bf16(bflo(Rk[i].w) * z, bfhi(Rk[i].w) * z);
        *(LAS v4u*)(F.lds + row * kp + ch * 16) = k; *(LAS v4u*)(F.lds + voff + row * VP + ch * 16) = Rv[i]; }
}
__device__ __forceinline__ void ret_r1_phase(Frame& F) {
    using namespace att;
    const bf16* RK = (const bf16*)gp(F.ws, F.gs, WS_RK, 1024); const bf16* RV = (const bf16*)gp(F.ws, F.gs, WS_RV, 1024); float* KVS = (float*)gp(F.ws, F.gs, WS_KVS, 1024);
    const int lane = F.lane, w = F.wave, r32 = lane & 31, hh = lane >> 5, g1 = (lane >> 4) & 1, q4 = (lane >> 2) & 3, p4 = lane & 3;
    constexpr int VOFF = 256 * VP;
    const bool grp = (F.G == 256); const int gg = (int)blockIdx.x & 7, gi = (int)blockIdx.x >> 3;
    for (int n = grp ? gi : (int)blockIdx.x; n < (grp ? 128 : BH * NHEAD * 16); n += (grp ? 32 : F.G)) {
        const int u = grp ? gg * 128 + n : n;
        const int bh = u >> 4, cp = u & 15, b = bh >> 3, h = bh & 7;
        ret_stage(F, RK, RV, (size_t)b * SEQ + cp * 256, h, log2_gamma(h), VP, VOFF);
        __syncthreads();
        const int c2 = w >> 2, eb = (w >> 1) & 1, db = w & 1;
        f32x16 acc;
#pragma unroll
        for (int i = 0; i < 16; ++i) acc[i] = 0.f;
        const LAS unsigned char* vb = F.lds + VOFF + (c2 * 128 + 8 * hh + q4) * VP + (eb * 32 + 16 * g1 + 4 * p4) * 2;
        const LAS unsigned char* kb = F.lds + (c2 * 128 + 8 * hh + q4) * VP + (db * 32 + 16 * g1 + 4 * p4) * 2;
#pragma unroll
        for (int ks = 0; ks < 8; ++ks) {
            const s16x4 al = tr16(vb + ks * 16 * VP), ah = tr16(vb + (ks * 16 + 4) * VP), bl = tr16(kb + ks * 16 * VP), bhi = tr16(kb + (ks * 16 + 4) * VP);
            const bf16x8 af = {al[0], al[1], al[2], al[3], ah[0], ah[1], ah[2], ah[3]}, bf = {bl[0], bl[1], bl[2], bl[3], bhi[0], bhi[1], bhi[2], bhi[3]};
            acc = __builtin_amdgcn_mfma_f32_32x32x16_bf16(af, bf, acc, 0, 0, 0);
        }
        float* dst = KVS + ((size_t)(bh * 32 + 2 * cp + c2) * 64 + eb * 32) * 64 + db * 32 + r32;
#pragma unroll
        for (int r = 0; r < 16; ++r) dst[crow(r, hh) * 64] = acc[r];
        __syncthreads();
    }
}
__device__ __forceinline__ void ret_scan_phase(Frame& F) {
    float* KVS = (float*)gp(F.ws, F.gs, WS_KVS, 1024);
    const bool grp = (F.G == 256); const int gg = (int)blockIdx.x & 7, gi = (int)blockIdx.x >> 3;
    for (int n = grp ? gi * NTHR + F.tid : (int)blockIdx.x * NTHR + F.tid; n < (grp ? 8 * 4096 : BH * NHEAD * 4096); n += (grp ? 32 * NTHR : F.G * NTHR)) {
        const int idx = grp ? gg * (8 * 4096) + n : n;
        const int bh = idx >> 12, ed = idx & 4095;
        const float dec = __builtin_amdgcn_exp2f(128.f * log2_gamma(bh & 7));
        float S = 0.f, kv[32];
        const float* base = KVS + ((size_t)(bh * 32) << 12) + ed;
        bf16* outb = (bf16*)gp(F.ws, F.gs, WS_PREVB, 512) + ((size_t)(bh * 32) << 12) + ed;
#pragma unroll
        for (int n = 0; n < 32; ++n) kv[n] = base[(size_t)n << 12];
        asm volatile("" ::: "memory");
#pragma unroll
        for (int n = 0; n < 32; n += 2) { const float S0 = S; S = S * dec + kv[n]; const unsigned w = pg8::cvt_pk_bf16(S0, S); S = S * dec + kv[n + 1];
            ((unsigned short*)outb)[(size_t)n << 12] = (unsigned short)(w & 0xffffu); ((unsigned short*)outb)[(size_t)(n + 1) << 12] = (unsigned short)(w >> 16); }
    }
}
__device__ __forceinline__ void ret_r3_phase(Frame& F, const float* gn, bf16* OUT, int opitch, int ocol, int ng, int nlow) {
    using namespace att;
    const bf16* RK = (const bf16*)gp(F.ws, F.gs, WS_RK, 1024); const bf16* RV = (const bf16*)gp(F.ws, F.gs, WS_RV, 1024); const bf16* RG = (const bf16*)gp(F.ws, F.gs, WS_RG, 1024); bf16* Y = (bf16*)gp(F.ws, F.gs, WS_Y, 3072);
    const float* PREV = (const float*)gp(F.ws, F.gs, WS_KVS, 1024);
    const int lane = F.lane, w = F.wave, r32 = lane & 31, hh = lane >> 5;
    constexpr int VOFF = 40960;
    const int c_ = (int)blockIdx.x; const bool low_ = c_ < ng;
    const bool grp = (F.G == 256) && (ng == 128 || ng == 0); const int gg = c_ & 7, gi = c_ >> 3, nl8 = ng >> 3;
    const int n_beg = grp ? (low_ ? gi : nl8 * nlow + (gi - nl8)) : (low_ ? c_ : ng * nlow + (c_ - ng));
    const int n_end = grp ? (low_ ? nl8 * nlow : 128) : (low_ ? ng * nlow : BH * NHEAD * 16);
    const int n_step = grp ? (low_ ? nl8 : 32 - nl8) : (low_ ? ng : F.G - ng);
    for (int n = n_beg; n < n_end; n += n_step) {
        const int u = grp ? gg * 128 + n : n;
        const int bh = u >> 4, cp = u & 15, b = bh >> 3, h = bh & 7;
        const float lg2 = log2_gamma(h);
        const size_t row0 = (size_t)b * SEQ + cp * 256;
        const int c2 = w >> 2, wq = w & 3, it = 32 * wq + r32;
        const size_t trow = row0 + c2 * 128 + it;
        bf16x8 qf[4];
#pragma unroll
        for (int ks = 0; ks < 4; ++ks) qf[ks] = *(const GAS bf16x8*)(Y + trow * 1536 + 1024 + h * 64 + ks * 16 + hh * 8);
        pg8::u32x2 rgv[8];
#pragma unroll
        for (int eb = 0; eb < 2; ++eb)
#pragma unroll
            for (int g = 0; g < 4; ++g) rgv[eb * 4 + g] = *(const GAS pg8::u32x2*)(RG + trow * 512 + h * 64 + eb * 32 + 8 * g + 4 * hh);
        bf16x8 pf[2][4];
        { const bf16* pv = (const bf16*)gp(F.ws, F.gs, WS_PREVB, 512) + ((size_t)(bh * 32 + 2 * cp + c2) << 12) + r32 * 64 + hh * 8;
#pragma unroll
          for (int eb = 0; eb < 2; ++eb)
#pragma unroll
              for (int ks = 0; ks < 4; ++ks) pf[eb][ks] = *(const GAS bf16x8*)(pv + eb * 32 * 64 + ks * 16); }
        ret_stage(F, RK, RV, row0, h, lg2, KP64, VOFF);
        __syncthreads();
        f32x16 o[2];
#pragma unroll
        for (int i = 0; i < 16; ++i) { o[0][i] = 0.f; o[1][i] = 0.f; }
        const float xi = __builtin_amdgcn_exp2f((float)(it - 127) * lg2);
        for (int kb = 0; kb <= wq; ++kb) {
            f32x16 p = qk_block<4>(F.lds + (c2 * 128 + kb * 32) * KP64, KP64, qf, r32, hh);
#pragma unroll
            for (int r = 0; r < 16; ++r) { const int is = kb * 32 + crow(r, hh); p[r] = (is <= it) ? p[r] * xi : 0.f; }
            pv_block(o, F.lds + VOFF + (c2 * 128 + kb * 32) * VP, pack8s(p, 0), pack8s(p, 1), lane);
        }
        { const float xc = __builtin_amdgcn_exp2f((float)(it + 1) * lg2);
#pragma unroll
          for (int eb = 0; eb < 2; ++eb) { f32x16 oc;
#pragma unroll
              for (int i = 0; i < 16; ++i) oc[i] = 0.f;
#pragma unroll
              for (int ks = 0; ks < 4; ++ks) oc = __builtin_amdgcn_mfma_f32_32x32x16_bf16(pf[eb][ks], qf[ks], oc, 0, 0, 0);
#pragma unroll
              for (int i = 0; i < 16; ++i) o[eb][i] += oc[i] * xc; } }
        float s1 = 0.f;
#pragma unroll
        for (int i = 0; i < 16; ++i) s1 += o[0][i] + o[1][i];
        s1 += __shfl_xor(s1, 32);
        const float mu = s1 * (1.f / 64.f); float s2 = 0.f;
#pragma unroll
        for (int i = 0; i < 16; ++i) { o[0][i] -= mu; o[1][i] -= mu; s2 += o[0][i] * o[0][i] + o[1][i] * o[1][i]; }
        s2 += __shfl_xor(s2, 32);
        const float rstd = rsqrtf(s2 * (1.f / 64.f) + EPS);
        f32x4 gvv[8];
#pragma unroll
        for (int eb = 0; eb < 2; ++eb)
#pragma unroll
            for (int g = 0; g < 4; ++g) gvv[eb * 4 + g] = *(const f32x4*)(gn + h * 64 + eb * 32 + 8 * g + 4 * hh);
        asm volatile("" ::: "memory");
#pragma unroll
        for (int eb = 0; eb < 2; ++eb)
#pragma unroll
            for (int g = 0; g < 4; ++g) { const int e = eb * 32 + 8 * g + 4 * hh;
                const f32x4 gv = gvv[eb * 4 + g]; const pg8::u32x2 rg = rgv[eb * 4 + g];
                pg8::u32x2 wv; wv.x = pg8::cvt_pk_bf16(o[eb][4 * g] * rstd * gv[0] * bflo(rg.x), o[eb][4 * g + 1] * rstd * gv[1] * bfhi(rg.x));
                wv.y = pg8::cvt_pk_bf16(o[eb][4 * g + 2] * rstd * gv[2] * bflo(rg.y), o[eb][4 * g + 3] * rstd * gv[3] * bfhi(rg.y));
                *(GAS pg8::u32x2*)(OUT + trow * opitch + ocol + h * 64 + e) = wv; }
        __syncthreads();
    }
}

__device__ __forceinline__ void prologue_phase(Frame& F, const float* x, const int* pos, float* cosR, float* sinR, float* cosM, float* sinM, bf16* XB, bf16* XL, u64* ssq0) {
    const int gt = blockIdx.x * NTHR + F.tid, NT = F.G * NTHR;
    {
        GAS v4u* z = (GAS v4u*)((unsigned char*)ssq0 + (size_t)MTOT * 8); constexpr int NZ = (int)((WS_SSQ + SSQ_ZERO_BYTES - WS_SSQX - (size_t)MTOT * 8) / 16);
        for (int i = gt; i < NZ; i += NT) z[i] = v4u{0u, 0u, 0u, 0u};
    }
    for (int idx = gt; idx < MTOT * 32; idx += NT) {
        const int row = idx >> 5, i = idx & 31;
        const double inv = exp2(-(double)i * (13.287712379549449 / 32.0));
        const double ang = (double)pos[row] * inv;
        double s, c; sincos(ang, &s, &c);
        cosR[idx] = (float)c; sinR[idx] = (float)s;
        if ((i & 1) == 0) { cosM[row * 16 + (i >> 1)] = (float)c; sinM[row * 16 + (i >> 1)] = (float)s; }
    }
    const int gw = blockIdx.x * NWAVES + F.wave, NGW = F.G * NWAVES;
    for (int m0 = gw; m0 < MTOT; m0 += 2 * NGW) {
        f32x4 v[2][4];
#pragma unroll
        for (int r = 0; r < 2; ++r) { const int m = m0 + r * NGW; if (m < MTOT) { const GAS f32x4* xr = (const GAS f32x4*)(x + (size_t)m * DM) + F.lane;
#pragma unroll
            for (int j = 0; j < 4; ++j) v[r][j] = xr[64 * j]; } }
#pragma unroll
        for (int r = 0; r < 2; ++r) { const int m = m0 + r * NGW; if (m < MTOT) {
            float s = 0.f;
#pragma unroll
            for (int j = 0; j < 4; ++j) s += (v[r][j].x * v[r][j].x + v[r][j].y * v[r][j].y) + (v[r][j].z * v[r][j].z + v[r][j].w * v[r][j].w);
            s = wave_sum(s);
            GAS unsigned long long* o8 = (GAS unsigned long long*)(XB + (size_t)m * DM) + F.lane;
#pragma unroll
            for (int j = 0; j < 4; ++j) { const unsigned h0 = pk2(v[r][j].x, v[r][j].y), h1 = pk2(v[r][j].z, v[r][j].w); o8[64 * j] = (unsigned long long)h0 | ((unsigned long long)h1 << 32); }
            if (F.lane == 0) ssq0[m] = (u64)(s * 16777216.f + 0.5f); } }
    }
}
__device__ __forceinline__ void final_phase(Frame& F, float* xo, const bf16* XB, const bf16* XL, const u64* ssq, const float* g) {
    const int gw = blockIdx.x * NWAVES + F.wave, NGW = F.G * NWAVES;
    f32x4 gv[4];
#pragma unroll
    for (int j = 0; j < 4; ++j) gv[j] = *((const f32x4*)g + F.lane + 64 * j);
    for (int m0 = gw; m0 < MTOT; m0 += 4 * NGW) {
        unsigned long long h[4][4]; u64 sq[4];
#pragma unroll
        for (int r = 0; r < 4; ++r) { const int m = m0 + r * NGW; if (m < MTOT) { sq[r] = __hip_atomic_load(ssq + m, RLX_AGENT);
#pragma unroll
            for (int j = 0; j < 4; ++j) h[r][j] = ((const GAS unsigned long long*)(XB + (size_t)m * DM) + F.lane)[64 * j]; } }
#pragma unroll
        for (int r = 0; r < 4; ++r) { const int m = m0 + r * NGW; if (m < MTOT) {
            const float rs = rsqrtf((float)sq[r] * (1.f / 16777216.f) * (1.f / 1024.f) + EPS);
            GAS f32x4* xr = (GAS f32x4*)(xo + (size_t)m * DM) + F.lane;
#pragma unroll
            for (int j = 0; j < 4; ++j) { const unsigned h0 = (unsigned)h[r][j], h1 = (unsigned)(h[r][j] >> 32);
                f32x4 v; v.x = bflo(h0); v.y = bfhi(h0); v.z = bflo(h1); v.w = bfhi(h1);
                xr[64 * j] = v * rs * gv[j]; } } }
    }
}
__device__ __forceinline__ void convert_phase(Frame& F, const Args& a, int l, unsigned char* W) {
    LAS float* scr = (LAS float*)(F.lds + RING_OFF + F.wave * 16384);
    const float* g_mix = (const float*)a.in[2] + (size_t)l * DM;
    const float* w_in = (const float*)a.in[3] + (size_t)l * DM * D_IN;
    const float* g_q = (const float*)a.in[4] + (size_t)l * 384;
    const float* w_uq = (const float*)a.in[5] + (size_t)l * 384 * NQ;
    const float* g_kv = (const float*)a.in[6] + (size_t)l * 256;
    const float* w_ukv = (const float*)a.in[7] + (size_t)l * 256 * NKV;
    const float* w_br = (const float*)a.in[9] + (size_t)l * 3 * 512 * DM;
    const float* w_out = (const float*)a.in[10] + (size_t)l * DM * DM;
    const float* g_mlp = (const float*)a.in[11] + (size_t)l * DM;
    const float* w_up = (const float*)a.in[12] + (size_t)l * DM * DFF;
    const float* w_dn = (const float*)a.in[13] + (size_t)l * DFF * DM;
    constexpr int I_IN = (DM / 64) * (NIN / 32), I_UQ = (384 / 64) * (NQ / 32), I_UKV = (256 / 64) * (NKV / 32), I_B = (512 / 64) * (DM / 32), I_OUT = (DM / 64) * (DM / 32),
                  I_UP = (DM / 64) * (DFF / 32), I_DN = (DFF / 64) * (DM / 32);
    constexpr int NITEMS = I_IN + I_UQ + I_UKV + 3 * I_B + I_OUT + I_UP + I_DN;
    const int gw = blockIdx.x * NWAVES + F.wave, NGW = F.G * NWAVES;
    for (int it = gw; it < NITEMS; it += NGW) {
        int r = it;
        if (r < I_IN) { transpose_item<1>(w_in, D_IN, NIN, g_mix, (bf16*)(W + W_IN), DM, 0, scr, r, F.lane); continue; } r -= I_IN;
        if (r < I_UQ) { transpose_item<2>(w_uq, NQ, NQ, g_q, (bf16*)(W + W_UQ), 384, 0, scr, r, F.lane); continue; } r -= I_UQ;
        if (r < I_UKV) { transpose_item<0>(w_ukv, NKV, NKV, g_kv, (bf16*)(W + W_UKV), 256, 0, scr, r, F.lane); continue; } r -= I_UKV;
        if (r < 3 * I_B) { const int s = r / I_B; transpose_item<0>(w_br + (size_t)s * 512 * DM, DM, DM, nullptr, (bf16*)(W + W_B), 1536, s * 512, scr, r % I_B, F.lane); continue; } r -= 3 * I_B;
        if (r < I_OUT) { transpose_item<0>(w_out, DM, DM, nullptr, (bf16*)(W + W_OUT), DM, 0, scr, r, F.lane); continue; } r -= I_OUT;
        if (r < I_UP) { transpose_item<0>(w_up, DFF, DFF, g_mlp, (bf16*)(W + W_UP), DM, 0, scr, r, F.lane); continue; } r -= I_UP;
        transpose_item<0>(w_dn, DM, DM, nullptr, (bf16*)(W + W_DN), DFF, 0, scr, r, F.lane);
    }
}

__device__ __forceinline__ void ld8(const bf16* p, float* f) { const v4u w = *(const GAS v4u*)p; f[0] = bflo(w.x); f[1] = bfhi(w.x); f[2] = bflo(w.y); f[3] = bfhi(w.y); f[4] = bflo(w.z); f[5] = bfhi(w.z); f[6] = bflo(w.w); f[7] = bfhi(w.w); }
__device__ __forceinline__ void st8(bf16* p, const float* f) { v4u w; w.x = pk2(f[0], f[1]); w.y = pk2(f[2], f[3]); w.z = pk2(f[4], f[5]); w.w = pk2(f[6], f[7]); *(GAS v4u*)p = w; }
__device__ __forceinline__ void item_bht(int it, int& bh, int& t) { bh = it >> 12; const int r = it & 4095; t = (r & 511) * 8 + (r >> 9); }

__device__ __forceinline__ void naive_mla(Frame& F) {
    const bf16* QM = (const bf16*)(F.ws + WS_QM); const bf16* KVM = (const bf16*)(F.ws + WS_KVM); const bf16* C = (const bf16*)(F.ws + WS_C); bf16* Y = (bf16*)(F.ws + WS_Y);
    const int vz = vzero();
    for (int it = blockIdx.x * NTHR + F.tid; it < BH * NHEAD * SEQ; it += F.G * NTHR) {
        int bh, t; item_bht(it, bh, t); const int b = bh >> 3, h = bh & 7; const size_t lrow = (size_t)b * SEQ + t;
        float q[96];
#pragma unroll
        for (int j = 0; j < 12; ++j) ld8(QM + lrow * NQ + h * 96 + 8 * j, q + 8 * j);
        float m = -INFINITY, l = 0.f, acc[64];
#pragma unroll
        for (int e = 0; e < 64; ++e) acc[e] = 0.f;
        for (int s = 0; s <= t; ++s) {
            const size_t krow = (size_t)b * SEQ + s + vz;
            const bf16* kn = KVM + krow * NKV + h * 128; const bf16* kr = C + krow * NC + 640;
            float z = 0.f, k[8];
#pragma unroll
            for (int j = 0; j < 8; ++j) { ld8(kn + 8 * j, k);
#pragma unroll
                for (int i = 0; i < 8; ++i) z += q[8 * j + i] * k[i]; }
#pragma unroll
            for (int j = 0; j < 4; ++j) { ld8(kr + 8 * j, k);
#pragma unroll
                for (int i = 0; i < 8; ++i) z += q[64 + 8 * j + i] * k[i]; }
            if (z > m) { const float al = exp2f(m - z); l *= al;
#pragma unroll
                for (int e = 0; e < 64; ++e) acc[e] *= al;
                m = z; }
            const float p = exp2f(z - m); l += p;
#pragma unroll
            for (int j = 0; j < 8; ++j) { ld8(kn + 64 + 8 * j, k);
#pragma unroll
                for (int i = 0; i < 8; ++i) acc[8 * j + i] += p * k[i]; }
        }
        const float il = 1.f / l;
#pragma unroll
        for (int e = 0; e < 64; ++e) acc[e] *= il;
#pragma unroll
        for (int j = 0; j < 8; ++j) st8(Y + lrow * 1536 + h * 64 + 8 * j, acc + 8 * j);
    }
}
__device__ __forceinline__ void naive_sb(Frame& F) {
    bf16* Y = (bf16*)(F.ws + WS_Y); const bf16* SK = (const bf16*)(F.ws + WS_SBK); const bf16* SV = (const bf16*)(F.ws + WS_SBV);
    const int vz = vzero();
    for (int it = blockIdx.x * NTHR + F.tid; it < BH * NHEAD * SEQ; it += F.G * NTHR) {
        int bh, t; item_bht(it, bh, t); const int b = bh >> 3, h = bh & 7; const size_t lrow = (size_t)b * SEQ + t;
        float q[64];
#pragma unroll
        for (int j = 0; j < 8; ++j) ld8(Y + lrow * 1536 + 512 + h * 64 + 8 * j, q + 8 * j);
        float run = 0.f, acc[64];
#pragma unroll
        for (int e = 0; e < 64; ++e) acc[e] = 0.f;
        for (int s = t - 1; s >= 0; --s) {
            const size_t krow = (size_t)b * SEQ + s + vz;
            const bf16* kp = SK + krow * 512 + h * 64; const bf16* vp = SV + krow * 512 + h * 64;
            float z = 0.f, k[8];
#pragma unroll
            for (int j = 0; j < 8; ++j) { ld8(kp + 8 * j, k);
#pragma unroll
                for (int i = 0; i < 8; ++i) z += q[8 * j + i] * k[i]; }
            const float sp = fmaxf(z, 0.f) + log1pf(__expf(-fabsf(z)));
            const float a = __expf(z - sp + run);
#pragma unroll
            for (int j = 0; j < 8; ++j) { ld8(vp + 8 * j, k);
#pragma unroll
                for (int i = 0; i < 8; ++i) acc[8 * j + i] += a * k[i]; }
            run -= sp;
            if (run < -105.f) break;
        }
#pragma unroll
        for (int j = 0; j < 8; ++j) st8(Y + lrow * 1536 + 512 + h * 64 + 8 * j, acc + 8 * j);
    }
}
__device__ __forceinline__ void naive_ret(Frame& F, const float* gn) {
    bf16* Y = (bf16*)(F.ws + WS_Y); const bf16* RK = (const bf16*)(F.ws + WS_RK); const bf16* RV = (const bf16*)(F.ws + WS_RV); const bf16* RG = (const bf16*)(F.ws + WS_RG);
    const int vz = vzero();
    for (int it = blockIdx.x * NTHR + F.tid; it < BH * NHEAD * SEQ; it += F.G * NTHR) {
        int bh, t; item_bht(it, bh, t); const int b = bh >> 3, h = bh & 7; const size_t lrow = (size_t)b * SEQ + t;
        const float lg2 = log2_gamma(h);
        float q[64];
#pragma unroll
        for (int j = 0; j < 8; ++j) ld8(Y + lrow * 1536 + 1024 + h * 64 + 8 * j, q + 8 * j);
        float acc[64];
#pragma unroll
        for (int e = 0; e < 64; ++e) acc[e] = 0.f;
        for (int s = 0; s <= t; ++s) {
            const size_t krow = (size_t)b * SEQ + s + vz;
            const bf16* kp = RK + krow * 512 + h * 64; const bf16* vp = RV + krow * 512 + h * 64;
            float z = 0.f, k[8];
#pragma unroll
            for (int j = 0; j < 8; ++j) { ld8(kp + 8 * j, k);
#pragma unroll
                for (int i = 0; i < 8; ++i) z += q[8 * j + i] * k[i]; }
            const float a = z * exp2f((float)(t - s) * lg2);
#pragma unroll
            for (int j = 0; j < 8; ++j) { ld8(vp + 8 * j, k);
#pragma unroll
                for (int i = 0; i < 8; ++i) acc[8 * j + i] += a * k[i]; }
        }
        float mu = 0.f;
#pragma unroll
        for (int e = 0; e < 64; ++e) mu += acc[e];
        mu *= (1.f / 64.f); float var = 0.f;
#pragma unroll
        for (int e = 0; e < 64; ++e) { acc[e] -= mu; var += acc[e] * acc[e]; }
        const float rstd = rsqrtf(var * (1.f / 64.f) + EPS);
#pragma unroll
        for (int j = 0; j < 8; ++j) { float g8[8]; ld8(RG + lrow * 512 + h * 64 + 8 * j, g8);
#pragma unroll
            for (int i = 0; i < 8; ++i) acc[8 * j + i] = acc[8 * j + i] * rstd * gn[h * 64 + 8 * j + i] * g8[i];
            st8(Y + lrow * 1536 + 1024 + h * 64 + 8 * j, acc + 8 * j); }
    }
}

#ifndef ALIGN1_V
#define ALIGN1_V true
#endif
constexpr bool ALIGN1 = ALIGN1_V;
constexpr int LATE_TILE = 25;
constexpr int N_PHASES = 1 + DEPTH * 10 + 1;
__global__ void __launch_bounds__(NTHR, 2) fwd(Args args) {
    extern __shared__ __attribute__((aligned(16))) unsigned char lds[];
    Frame F;
    F.lds = (LAS unsigned char*)lds; F.tid = threadIdx.x; F.lane = F.tid & 63; F.wave = __builtin_amdgcn_readfirstlane(F.tid >> 6); F.G = gridDim.x; F.ws = args.ws; F.gs = (gridDim.x == 256) ? (int)(blockIdx.x & 7) : -1;
    volatile LAS unsigned* MISC = (volatile LAS unsigned*)(F.lds + MISC_OFF);
    for (int u = F.tid; u < (LDS_BYTES - LDSCTL_OFF) / 4; u += NTHR) ((LAS unsigned*)(F.lds + LDSCTL_OFF))[u] = 0u;
    __syncthreads();
    const int lo = args.ph_lo, hi = args.ph_hi;
    const bool multi = (hi - lo) > 1;
    XcdBarrier bar; bar.bar = (unsigned*)(F.ws + WS_CTL) + CW_BAR; bar.x = 0; bar.st = nullptr;
    if (multi) { if (F.tid == 0) __hip_atomic_store((unsigned*)(F.ws + WS_CTL) + CW_BAR + GB_XTAB + blockIdx.x, xb_xcc_id() + 1u, __ATOMIC_RELAXED, __HIP_MEMORY_SCOPE_AGENT);
        bar = xcd_barrier_post((unsigned*)(F.ws + WS_CTL) + CW_BAR, MISC + 8); }
    bool fastgrp = false;
    int ph = 0;
#ifdef DBG_WAIT
#define PH_TBEG tb_ = __builtin_amdgcn_s_memrealtime();
#else
#define PH_TBEG
#endif
#define PH_BEGIN if (ph >= lo && ph < hi) { PH_TBEG { int t_ = threadIdx.x; asm volatile("" : "+v"(t_)); F.tid = t_; F.lane = t_ & 63; }
#ifdef DUP_BAR
#define PH_END   if (ph + 1 < hi) { xcd_barrier(bar); xcd_barrier(bar); } } ++ph;
#elif defined(DBG_WAIT)
#ifndef DBG_INSIDE
#define DBG_W_ACC if (sel1_) w_all += t1_ - t0_; if (sel_) w_sel += t1_ - t0_;
#else
#define DBG_W_ACC
#endif
#ifdef DBG_INSIDE
#define DBG_BODY_ACC if (sel1_) w_all += t0_ - tb_; if (sel_) w_sel += t0_ - tb_;
#define DBG_WAIT_ACC(d)
#else
#define DBG_BODY_ACC
#endif
    unsigned long long t_start = __builtin_amdgcn_s_memrealtime(), c_start = clock64(), w_all = 0ull, w_sel = 0ull, tb_ = 0ull; int sel_ = 0, sel1_ = 0; int hlp_ = 0;
#define PH_END   if (ph + 1 < hi) { __syncthreads(); const unsigned long long t0_ = __builtin_amdgcn_s_memrealtime(); DBG_BODY_ACC \
        if (ph + 2 == hi && F.tid == 0) { atomicAdd((u64*)(ws + WS_SSQ + 4352 * 1024), w_all); atomicAdd((u64*)(ws + WS_SSQ + 4352 * 1024) + 1, w_sel); } \
        xcd_barrier(bar); const unsigned long long t1_ = __builtin_amdgcn_s_memrealtime(); DBG_W_ACC } } ++ph; ++hlp_; sel1_ = (DBG_W1 == 0 || hlp_ == DBG_W1); sel_ = (hlp_ == DBG_W2);
#else
#define PH_END   if (ph + 1 < hi) xcd_barrier(bar); } ++ph;
#endif
#define PH_ENDL  if (ph + 1 < hi) { if (fastgrp) grp_barrier(bar.bar, (int)blockIdx.x & 7, 32u); else xcd_barrier(bar); } } ++ph;

    unsigned char* ws = F.ws;
    u64* ssqx = (u64*)(ws + WS_SSQX);
    float* cosR = (float*)(ws + WS_COSR); float* sinR = (float*)(ws + WS_SINR); float* cosM = (float*)(ws + WS_COSM); float* sinM = (float*)(ws + WS_SINM);
    bf16* XB = (bf16*)(ws + WS_XB);
    bf16* XL = (bf16*)args.out + 1024;
    const float* x_in = (const float*)args.in[0];

    unsigned char* const Wbuf0 = ws + WS_W; unsigned char* const Wbuf1 = (unsigned char*)args.out;
    PH_BEGIN prologue_phase(F, x_in, (const int*)args.in[1], cosR, sinR, cosM, sinM, XB, XL, ssqx); convert_phase(F, args, 0, Wbuf0);
#ifdef DUP_PRO
    prologue_phase(F, x_in, (const int*)args.in[1], cosR, sinR, cosM, sinM, XB, XL, ssqx);
#endif
    PH_END

    if (multi && F.G == 256) {
        if (F.tid < 64) { unsigned* tab = bar.bar + GB_XTAB; bool ok = true;
            for (int j = F.tid; j < 256; j += 64) { const unsigned a = xb_ld(tab + j), b0 = xb_ld(tab + (j & 7)); ok = ok && (a != 0u) && (a == b0); }
            const bool all = (__ballot(ok) == ~0ull);
            if (F.tid == 0) MISC[12] = all ? 1u : 0u; }
        __syncthreads();
        fastgrp = (MISC[12] != 0u);
    }
    for (int l = 0; l < DEPTH; ++l) {
        unsigned char* const Wl = (l & 1) ? Wbuf1 : Wbuf0; unsigned char* const Wn = (l & 1) ? Wbuf0 : Wbuf1;
        {
            constexpr int grow0 = 0;
            u64* ssqq = (u64*)(ws + WS_SSQQ) + (size_t)l * MTOT; u64* ssqkv = (u64*)(ws + WS_SSQKV) + (size_t)l * MTOT;
            const float* ret_gn = (const float*)args.in[8] + (size_t)l * 512;
            PH_BEGIN {
#ifdef DBG_WAIT
                hlp_ = 1; sel1_ = (DBG_W1 == 0 || hlp_ == DBG_W1); sel_ = (hlp_ == DBG_W2);
#endif
                pg8::Gemm g{XB, (const bf16*)(Wl + W_IN), DM, DM, DM};
                pg8::MapOrder S; S.b.init(MH, 16 * 256, F.G, (int)blockIdx.x); S.from = 14; S.add = 12;
                EpiIn E{ssqx + (size_t)(2 * l) * MTOT, grow0, ws, F.lds + RING_OFF, cosR, sinR, cosM, sinM, ssqq, ssqkv, F.gs};
                pg8::gemm_phase<EpiIn, pg8::MapOrder, true>(F.lds + RING_OFF, g, S, E);
            } PH_ENDL
            PH_BEGIN {
#ifdef DUP_SB
                sb_phase<DUP_SB>(F, (bf16*)args.out, 512, 0);
#endif
                sb_phase<0>(F, (bf16*)gp(ws, F.gs, WS_Y, 3072), 1536, 512);
                ret_r1_phase(F);
            } PH_ENDL
            PH_BEGIN ret_scan_phase(F); PH_ENDL
            PH_BEGIN {
                const int ng = (F.G == 256) ? 128 : 0;
                { pg8::Gemm g{XB, (const bf16*)(Wl + W_IN), DM, DM, DM};
                    pg8::MapOrder S; S.b.init(MH, 256, F.G, (int)blockIdx.x); S.from = 0; S.add = 28;
                    EpiIn E{ssqx + (size_t)(2 * l) * MTOT, grow0, ws, F.lds + RING_OFF, cosR, sinR, cosM, sinM, ssqq, ssqkv, F.gs};
                    pg8::gemm_phase<EpiIn, pg8::MapOrder, true>(F.lds + RING_OFF, g, S, E); }
                ret_r3_phase(F, ret_gn, (bf16*)gp(ws, F.gs, WS_Y, 3072), 1536, 1024, ng, 3);
            } PH_ENDL
            PH_BEGIN {
                { pg8::Gemm g{(const bf16*)gp(ws, F.gs, WS_C, 1536), (const bf16*)(Wl + W_UQ), NC, 384, 384};
                  pg8::StaticOrder S; S.init(MH, NQ, F.G, (int)blockIdx.x);
                  EpiUq E{ssqq, grow0, (bf16*)gp(ws, F.gs, WS_QM, 1536), cosM, sinM, F.lds + RING_OFF};
                  pg8::gemm_phase<EpiUq, pg8::StaticOrder, true>(F.lds + RING_OFF, g, S, E); }
                { pg8::Gemm g{(const bf16*)gp(ws, F.gs, WS_C, 1536) + 384, (const bf16*)(Wl + W_UKV), NC, 256, 256};
                  pg8::StaticOrder S; S.init(MH, NKV, F.G, (int)blockIdx.x);
                  EpiUkv E{ssqkv, (bf16*)gp(ws, F.gs, WS_KVM, 2048), F.lds + RING_OFF};
                  pg8::gemm_phase<EpiUkv, pg8::StaticOrder, true>(F.lds + RING_OFF, g, S, E); }
            } PH_ENDL
            PH_BEGIN {
                mla_phase<0>(F);
#ifdef DUP_MLA
                mla_phase<DUP_MLA>(F);
#endif
            } PH_ENDL
            PH_BEGIN {
                unsigned char* gs = F.gs < 0 ? ws + WS_GATES + (size_t)blockIdx.x * (6 * 131072) : ws + SLAB0 + (size_t)F.gs * SLABSZ + (WS_GATES - SLAB0) / 8 + (size_t)(blockIdx.x >> 3) * (6 * 131072);
                { pg8::Gemm g{XB, (const bf16*)(Wl + W_IN), DM, DM, DM};
                  pg8::GateOrder S; S.b.init(MH, DM, F.G, (int)blockIdx.x);
                  EpiGate E{ssqx + (size_t)(2 * l) * MTOT + grow0, gs, F.lds + RING_OFF};
                  pg8::gemm_phase<EpiGate, pg8::GateOrder, true>(F.lds + RING_OFF, g, S, E); }
                { pg8::Gemm g{(const bf16*)gp(ws, F.gs, WS_Y, 3072), (const bf16*)(Wl + W_B), 1536, 1536, 512};
                  pg8::SegOrder<3> S; S.b.init(MH, DM, F.G, (int)blockIdx.x);
                  EpiMergeL E{gs, (bf16*)gp(ws, F.gs, WS_MG, 2048)};
                  pg8::gemm_phase<EpiMergeL, pg8::SegOrder<3>, ALIGN1>(F.lds + RING_OFF, g, S, E); }
            } PH_ENDL
            PH_BEGIN {
                pg8::Gemm g{(const bf16*)gp(ws, F.gs, WS_MG, 2048), (const bf16*)(Wl + W_OUT), DM, DM, DM};
                pg8::StaticOrder S; S.init(MH, DM, F.G, (int)blockIdx.x);
                EpiResid E{XB, ssqx + (size_t)(2 * l + 1) * MTOT, grow0};
                pg8::gemm_phase<EpiResid, pg8::StaticOrder, ALIGN1>(F.lds + RING_OFF, g, S, E);
            } PH_ENDL
            PH_BEGIN {
                pg8::Gemm g{XB, (const bf16*)(Wl + W_UP), DM, DM, DM};
                pg8::StaticOrder S; S.init(MH, DFF, F.G, (int)blockIdx.x);
                EpiUp E{ssqx + (size_t)(2 * l + 1) * MTOT, grow0, (bf16*)gp(ws, F.gs, WS_H, 8192), 0, F.lds + RING_OFF};
                pg8::gemm_phase<EpiUp, pg8::StaticOrder, true>(F.lds + RING_OFF, g, S, E);
#ifdef DUP_UP
                { EpiUp E2{ssqx + (size_t)(2 * l + 1) * MTOT, grow0, (bf16*)(ws + WS_H), DUP_UP - 1, F.lds + RING_OFF};
#ifdef DUP_UP_K
                  pg8::Gemm g2{XB, (const bf16*)(Wl + W_UP), DUP_UP_LD, DUP_UP_LD, DUP_UP_K};
#else
                  pg8::Gemm g2 = g;
#endif
                  pg8::gemm_phase<EpiUp, pg8::StaticOrder, true>(F.lds + RING_OFF, g2, S, E2); }
#endif
            } PH_ENDL
            PH_BEGIN {
                pg8::Gemm g{(const bf16*)gp(ws, F.gs, WS_H, 8192), (const bf16*)(Wl + W_DN), DFF, DFF, DFF};
                pg8::StaticOrder S; S.init(MH, DM, F.G, (int)blockIdx.x);
                EpiResid E{XB, ssqx + (size_t)(2 * l + 2) * MTOT, grow0};
                pg8::gemm_phase<EpiResid, pg8::StaticOrder, ALIGN1>(F.lds + RING_OFF, g, S, E);
                if (l + 1 < DEPTH) convert_phase(F, args, l + 1, Wn);
            } PH_END
        }
    }
#ifdef DBG_WAIT
    PH_BEGIN { final_phase(F, args.out, XB, XL, ssqx + (size_t)(2 * DEPTH) * MTOT, (const float*)args.in[14]);
        const unsigned long long tot = __builtin_amdgcn_s_memrealtime() - t_start;
        const u64* acc_ = (const u64*)(ws + WS_SSQ + 4352 * 1024);
        float f1 = (float)__hip_atomic_load(acc_, RLX_AGENT) / ((float)F.G * (float)tot), f2 = (float)__hip_atomic_load(acc_ + 1, RLX_AGENT) / ((float)F.G * (float)tot);
#ifdef DBG_CLOCK
        f2 = rintf((float)(clock64() - c_start) / (float)tot * 0.1f * 5.f) * 0.2f * 0.1f; f1 = 0.f;
#endif
        f1 = rintf(f1 * 100.f) * 0.01f; f2 = rintf(f2 * 100.f) * 0.01f;
        const float sc = 1.f + 0.3f * sqrtf(f1);
        __syncthreads();
        const int gw = blockIdx.x * NWAVES + F.wave, NGW = F.G * NWAVES;
        for (int m = gw; m < MTOT; m += NGW) { GAS f32x4* xr = (GAS f32x4*)(args.out + (size_t)m * DM) + F.lane;
            for (int j = 0; j < 4; ++j) { f32x4 v = xr[64 * j]; v = v * sc; if (m == 0 && j == 0 && F.lane == 0) v.x += 100.f * f2; xr[64 * j] = v; } }
    } PH_END
#else
    PH_BEGIN final_phase(F, args.out, XB, XL, ssqx + (size_t)(2 * DEPTH) * MTOT, (const float*)args.in[14]); PH_END
#endif
#undef PH_BEGIN
#undef PH_END
#undef PH_ENDL
}


#ifdef DBG_STOP
struct DumpItem { size_t off; int where; int is_f32; int rows; int width; int pitch; };
__global__ void __launch_bounds__(512) dbg_rowsum(Args a, float* dst, size_t off, int where, int is_f32, int rows, int width, int pitch) {
    const unsigned char* base = (where == 0) ? (const unsigned char*)a.ws : (where == 1) ? (const unsigned char*)a.out : (const unsigned char*)a.in[0];
    base += off;
    const int lane = threadIdx.x & 63, gw = blockIdx.x * 8 + (threadIdx.x >> 6), ngw = gridDim.x * 8;
    for (int r = gw; r < rows; r += ngw) {
        float s = 0.f;
        if (is_f32) { const float* p = (const float*)base + (size_t)r * pitch; for (int c = lane; c < width; c += 64) s += p[c] * (1.f + 0.001f * (c & 15)); }
        else { const unsigned short* p = (const unsigned short*)base + (size_t)r * pitch; for (int c = lane; c < width; c += 64) s += __uint_as_float((unsigned)p[c] << 16) * (1.f + 0.001f * (c & 15)); }
        for (int o = 1; o < 64; o <<= 1) s += __shfl_xor(s, o);
        if (lane == 0) dst[r] = s;
    }
}
__global__ void __launch_bounds__(512) dbg_copy(const float* src, float* out, int n, int total) {
    for (int i = blockIdx.x * 512 + threadIdx.x; i < total; i += gridDim.x * 512) out[i] = (i < n) ? src[i] : 0.f;
}
#endif
#ifndef MK_ONE_LAUNCH
#define MK_ONE_LAUNCH 0
#endif
extern "C" void kernel_launch(void* const* d_in, const int* in_sizes, int n_in, void* d_out, int out_size, void* d_ws, size_t ws_size, hipStream_t stream) {
    static int grid = 0;
    if (grid == 0) {
        if (n_in != 15 || in_sizes[0] != MTOT * DM || out_size != MTOT * DM || ws_size < WS_END) { fprintf(stderr, "kernel_launch: unexpected shapes (n_in %d, in0 %d, out %d, ws %zu < %zu); nothing launched\n", n_in, n_in > 0 ? in_sizes[0] : -1, out_size, ws_size, (size_t)WS_END); grid = -1; return; }
        int dev = 0, cus = 0, per_cu = 0;
        if (hipGetDevice(&dev) != hipSuccess || hipDeviceGetAttribute(&cus, hipDeviceAttributeMultiprocessorCount, dev) != hipSuccess) { grid = -1; return; }
        if (hipFuncSetAttribute((const void*)fwd, hipFuncAttributeMaxDynamicSharedMemorySize, LDS_BYTES) != hipSuccess) { fprintf(stderr, "kernel_launch: hipFuncSetAttribute failed\n"); grid = -1; return; }
        if (hipOccupancyMaxActiveBlocksPerMultiprocessor(&per_cu, (const void*)fwd, NTHR, LDS_BYTES) != hipSuccess || per_cu < 1) { fprintf(stderr, "kernel_launch: occupancy query reports %d blocks per CU\n", per_cu); }
        (void)hipGetLastError();
        grid = cus;
    }
    if (grid < 0) return;
    if (hipMemsetAsync((char*)d_ws + WS_CTL, 0, CTL_ZERO_BYTES, stream) != hipSuccess) return;
    Args a{};
    for (int i = 0; i < 15; ++i) a.in[i] = d_in[i];
    a.out = (float*)d_out; a.ws = (unsigned char*)d_ws;
#ifdef DBG_STOP
    for (int p = 0; p < DBG_STOP; ++p) { a.ph_lo = p; a.ph_hi = p + 1; hipLaunchKernelGGL(fwd, dim3(grid), dim3(NTHR), LDS_BYTES, stream, a); }
    {   const DumpItem items[] = { DBG_ITEMS };
        float* scratch = (float*)((unsigned char*)d_ws + WS_RST); int n = 0;
        for (const DumpItem& it : items) { hipLaunchKernelGGL(dbg_rowsum, dim3(256), dim3(512), 0, stream, a, scratch + n, it.off, it.where, it.is_f32, it.rows, it.width, it.pitch); n += it.rows; }
        hipLaunchKernelGGL(dbg_copy, dim3(1024), dim3(512), 0, stream, (const float*)scratch, (float*)d_out, n, out_size); }
#elif MK_ONE_LAUNCH
    a.ph_lo = 0; a.ph_hi = N_PHASES;
    hipLaunchKernelGGL(fwd, dim3(grid), dim3(NTHR), LDS_BYTES, stream, a);
#else
    for (int p = 0; p < N_PHASES; ++p) { a.ph_lo = p; a.ph_hi = p + 1; hipLaunchKernelGGL(fwd, dim3(grid), dim3(NTHR), LDS_BYTES, stream, a); }
#endif
}
```
